# Optimizing an MI355X kernel written in HIP

```python
import jax, jax.numpy as jnp
from jax import lax
import numpy as np

D_MODEL = 1024
BATCH = 8
SEQ = 2048
DEPTH = 1

MEM_LEN = 256
HD = 64
SB_HEADS = 8
FOX_HEADS = 8
MEM_HEADS = 4
MEM_HD = 128
D_SB = SB_HEADS * HD
D_FOX = FOX_HEADS * HD
D_MEM = MEM_HEADS * MEM_HD
N_BRANCH = 3
D_FF = 4 * D_MODEL
BLOCK_Q = 128
EPS = 1e-6
NEG_INF = -1e30
SPLITS = (D_SB, D_SB, D_SB, D_FOX, D_FOX, D_FOX, FOX_HEADS, D_MEM, N_BRANCH * D_MODEL)
D_IN = sum(SPLITS)

kernel_name = "hybrid_stickbreak_fox_memory_block"


def split_columns(t, sizes):
    pieces = []
    start = 0
    for n in sizes:
        pieces.append(t[..., start:start + n])
        start += n
    return pieces


def rmsnorm(x, g):
    xf = x.astype(jnp.float32)
    y = xf * lax.rsqrt(jnp.mean(xf * xf, axis=-1, keepdims=True) + EPS)
    return (y * g.astype(jnp.float32)).astype(x.dtype)


def to_heads(t, n, d):
    b, s, _ = t.shape
    return t.reshape(b, s, n, d).transpose(0, 2, 1, 3)


def from_heads(t):
    b, h, s, d = t.shape
    return t.transpose(0, 2, 1, 3).reshape(b, s, h * d)


def stick_breaking_attention(q, k, v):
    s_len = q.shape[2]
    scale = HD ** -0.5
    outs = []
    for i in range(s_len // BLOCK_Q):
        q0 = i * BLOCK_Q
        kend = q0 + BLOCK_Q
        z = jnp.einsum('bhtd,bhsd->bhts', q[:, :, q0:kend], k[:, :, :kend]).astype(jnp.float32) * scale
        t_idx = q0 + jnp.arange(BLOCK_Q)[:, None]
        s_idx = jnp.arange(kend)[None, :]
        strict = s_idx < t_idx
        log_rem = jnp.where(strict, jax.nn.log_sigmoid(-z), 0.0)
        after = lax.cumsum(log_rem, axis=3, reverse=True) - log_rem
        w = jnp.where(strict, jnp.exp(jax.nn.log_sigmoid(z) + after), 0.0)
        outs.append(jnp.einsum('bhts,bhsd->bhtd', w.astype(v.dtype), v[:, :, :kend]))
    return jnp.concatenate(outs, axis=2)


def forgetting_attention(q, k, v, log_f):
    s_len = q.shape[2]
    scale = HD ** -0.5
    F = lax.cumsum(log_f.astype(jnp.float32), axis=2)
    outs = []
    for i in range(s_len // BLOCK_Q):
        q0 = i * BLOCK_Q
        kend = q0 + BLOCK_Q
        z = jnp.einsum('bhtd,bhsd->bhts', q[:, :, q0:kend], k[:, :, :kend]).astype(jnp.float32) * scale
        z = z + F[:, :, q0:kend, None] - F[:, :, None, :kend]
        causal = jnp.arange(kend)[None, :] <= (q0 + jnp.arange(BLOCK_Q)[:, None])
        p = jax.nn.softmax(jnp.where(causal, z, NEG_INF), axis=-1)
        outs.append(jnp.einsum('bhts,bhsd->bhtd', p.astype(v.dtype), v[:, :, :kend]))
    return jnp.concatenate(outs, axis=2)


def memory_attention(q, k, v):
    z = jnp.einsum('bhtd,bhmd->bhtm', q, k).astype(jnp.float32) * (MEM_HD ** -0.5)
    p = jax.nn.softmax(z, axis=-1)
    return jnp.einsum('bhtm,bhmd->bhtd', p.astype(v.dtype), v)


def setup_inputs(seed: int = 0) -> dict:
    key = jax.random.key(seed)
    ks = jax.random.split(key, 20)

    def w(k, shape, fan_in):
        return jax.random.normal(k, shape, jnp.float32) * fan_in ** -0.5

    def gain(k, shape):
        return 1.0 + 0.02 * jax.random.normal(k, shape, jnp.float32)

    L = DEPTH
    return {
        "x": jax.random.normal(ks[0], (BATCH, SEQ, D_MODEL), jnp.float32),
        "mem": jax.random.normal(ks[1], (BATCH, MEM_LEN, D_MODEL), jnp.float32),
        "g_mix_norm": gain(ks[2], (L, D_MODEL)),
        "g_mem_norm": gain(ks[3], (L, D_MODEL)),
        "w_in": w(ks[4], (L, D_MODEL, D_IN), D_MODEL),
        "b_forget": 3.0 + 0.5 * jax.random.normal(ks[5], (L, FOX_HEADS), jnp.float32),
        "g_fox_q": gain(ks[6], (L, HD)),
        "g_fox_k": gain(ks[7], (L, HD)),
        "g_mem_q": gain(ks[8], (L, MEM_HD)),
        "g_mem_k": gain(ks[9], (L, MEM_HD)),
        "w_mem_kv": w(ks[10], (L, D_MODEL, 2 * D_MEM), D_MODEL),
        "w_branch_sb": w(ks[11], (L, D_SB, D_MODEL), D_SB),
        "w_branch_fox": w(ks[12], (L, D_FOX, D_MODEL), D_FOX),
        "w_branch_mem": w(ks[13], (L, D_MEM, D_MODEL), D_MEM),
        "w_out": w(ks[14], (L, D_MODEL, D_MODEL), D_MODEL),
        "g_mlp_norm": gain(ks[15], (L, D_MODEL)),
        "w_ff_up": w(ks[16], (L, D_MODEL, D_FF), D_MODEL),
        "w_ff_down": w(ks[17], (L, D_FF, D_MODEL), D_FF),
    }


def reference(x, mem, g_mix_norm, g_mem_norm, w_in, b_forget, g_fox_q, g_fox_k, g_mem_q, g_mem_k,
              w_mem_kv, w_branch_sb, w_branch_fox, w_branch_mem, w_out, g_mlp_norm, w_ff_up, w_ff_down):
    b, s, _ = x.shape
    for l in range(DEPTH):
        h = rmsnorm(x, g_mix_norm[l])
        proj = jnp.einsum('bsd,de->bse', h, w_in[l])
        sb_q, sb_k, sb_v, fx_q, fx_k, fx_v, f_logit, m_q, gate_logit = split_columns(proj, SPLITS)

        o_sb = stick_breaking_attention(to_heads(sb_q, SB_HEADS, HD), to_heads(sb_k, SB_HEADS, HD),
                                        to_heads(sb_v, SB_HEADS, HD))

        fq = rmsnorm(to_heads(fx_q, FOX_HEADS, HD), g_fox_q[l])
        fk = rmsnorm(to_heads(fx_k, FOX_HEADS, HD), g_fox_k[l])
        log_f = jax.nn.log_sigmoid((f_logit + b_forget[l]).astype(jnp.float32)).transpose(0, 2, 1)
        o_fox = forgetting_attention(fq, fk, to_heads(fx_v, FOX_HEADS, HD), log_f)

        mh = rmsnorm(mem, g_mem_norm[l])
        mkv = jnp.einsum('bmd,de->bme', mh, w_mem_kv[l])
        mk, mv = split_columns(mkv, (D_MEM, D_MEM))
        mq = rmsnorm(to_heads(m_q, MEM_HEADS, MEM_HD), g_mem_q[l])
        mk = rmsnorm(to_heads(mk, MEM_HEADS, MEM_HD), g_mem_k[l])
        o_mem = memory_attention(mq, mk, to_heads(mv, MEM_HEADS, MEM_HD))

        gates = jax.nn.sigmoid(gate_logit.reshape(b, s, N_BRANCH, D_MODEL))
        br_sb = jnp.einsum('bse,ed->bsd', from_heads(o_sb), w_branch_sb[l])
        br_fox = jnp.einsum('bse,ed->bsd', from_heads(o_fox), w_branch_fox[l])
        br_mem = jnp.einsum('bse,ed->bsd', from_heads(o_mem), w_branch_mem[l])
        merged = gates[:, :, 0] * br_sb + gates[:, :, 1] * br_fox + gates[:, :, 2] * br_mem
        x = x + jnp.einsum('bsd,de->bse', merged, w_out[l])

        h2 = rmsnorm(x, g_mlp_norm[l])
        u = jax.nn.relu(jnp.einsum('bsd,df->bsf', h2, w_ff_up[l]))
        x = x + jnp.einsum('bsf,fd->bsd', u * u, w_ff_down[l])
    return x
```

```cpp
#include <hip/hip_runtime.h>
#include <cstdio>
#include <cstdint>

#define GAS __attribute__((address_space(1)))
#define LAS __attribute__((address_space(3)))
typedef unsigned short bf16;
typedef short bf16x8 __attribute__((ext_vector_type(8)));
typedef float f32x4 __attribute__((ext_vector_type(4)));
typedef unsigned v4u __attribute__((ext_vector_type(4)));
typedef GAS unsigned gu32;
#define RLX_AGENT __ATOMIC_RELAXED, __HIP_MEMORY_SCOPE_AGENT
#define LDS_WAIT() asm volatile("s_waitcnt lgkmcnt(0)" ::: "memory")
#define VM_WAIT() asm volatile("s_waitcnt vmcnt(0)" ::: "memory")

constexpr int NWAVES = 8, NTHREADS = 512;
constexpr int BATCH = 8, SEQ = 2048, M = BATCH * SEQ, D = 1024, MEMLEN = 256, MROWS = BATCH * MEMLEN;
constexpr int HD = 64, NH = 8, MNH = 4, MHD = 128, DH = 512, FF = 4096;
constexpr int DIN = 6664, NPROJ = 6656;
constexpr float EPS = 1e-6f, LOG2E = 1.4426950408889634f, LN2 = 0.6931471805599453f;
constexpr float C2 = 0.125f * LOG2E;
constexpr float C2M = 0.08838834764831845f * LOG2E;

constexpr size_t MiB = 1u << 20;
constexpr size_t WS_CTL = 0, CTL_ZERO_BYTES = 65536;
constexpr size_t WS_LOGF = 1 * MiB, WS_FC = 1 * MiB + 512 * 1024, WS_SSQ = 2 * MiB;
constexpr size_t WS_WIN = 3 * MiB, WS_WMKV = 16 * MiB, WS_WBR = 18 * MiB, WS_WOUT = 21 * MiB, WS_WUP = 23 * MiB, WS_WDN = 31 * MiB;
constexpr size_t WS_MH = 39 * MiB, WS_MV = 43 * MiB, WS_XN = 48 * MiB;
constexpr size_t WS_SBQ = 80 * MiB, WS_SBK = 96 * MiB, WS_SBV = 112 * MiB, WS_FXQ = 128 * MiB, WS_FXK = 144 * MiB, WS_FXV = 160 * MiB, WS_MQ = 176 * MiB;
constexpr size_t WS_G2 = 192 * MiB, WS_MRG = 224 * MiB, WS_MKF = 224 * MiB, WS_U = 80 * MiB, WS_END = 256 * MiB;
constexpr int CW_BAR = 4096;

constexpr int RING_BYTES = 131072, LDSCTL_OFF = RING_BYTES, MISC_OFF = LDSCTL_OFF + 320, LDS_BYTES = 147456;

__device__ __forceinline__ unsigned f2bf(float f) { unsigned u = __builtin_bit_cast(unsigned, f); return (u + 0x7fffu + ((u >> 16) & 1u)) >> 16; }
__device__ __forceinline__ unsigned pk2(float lo, float hi) { return f2bf(lo) | (f2bf(hi) << 16); }
__device__ __forceinline__ float bf2f(unsigned b) { return __uint_as_float(b << 16); }
__device__ __forceinline__ float bflo(unsigned w) { return __uint_as_float(w << 16); }
__device__ __forceinline__ float bfhi(unsigned w) { return __uint_as_float(w & 0xffff0000u); }
__device__ __forceinline__ float wave_sum(float v) {
#pragma unroll
    for (int o = 1; o < 64; o <<= 1) v += __shfl_xor(v, o);
    return v;
}
__device__ __forceinline__ float log_sigmoid_f(float x) { return fminf(x, 0.f) - log1pf(expf(-fabsf(x))); }

#define XB_TMO      128
#define XB_XCNT(j)  (256  + 64 * (j))
#define XB_XSUB(j)  (1280 + 64 * (j))
#define XB_XGEN(j)  (2304 + 64 * (j))
#define XB_TOP      3328
#define XB_TOPGEN   3392
#define XCD_BAR_WORDS 3456
#define XB_SPIN_CAP (1u << 18)
__device__ __forceinline__ unsigned xb_ld(unsigned* p)              { return __hip_atomic_load(p, __ATOMIC_RELAXED, __HIP_MEMORY_SCOPE_AGENT); }
__device__ __forceinline__ unsigned xb_add(unsigned* p, unsigned v) { return __hip_atomic_fetch_add(p, v, __ATOMIC_RELAXED, __HIP_MEMORY_SCOPE_AGENT); }
__device__ __forceinline__ unsigned xb_xcc_id() { return (unsigned)__builtin_amdgcn_s_getreg((3 << 11) | 20) & 0xFu; }
#define XB_SPIN(cond, bar) do { unsigned _sp = 0; while (cond) { __builtin_amdgcn_s_sleep(1); \
    if ((++_sp & 255u) == 0u) { if (xb_ld(&(bar)[XB_TMO])) break; if (_sp > XB_SPIN_CAP) { atomicAdd(&(bar)[XB_TMO], 1u); break; } } } } while (0)
struct XcdBarrier { unsigned* bar; unsigned x; volatile LAS unsigned* st; };
__device__ __forceinline__ XcdBarrier xcd_barrier_post(unsigned* bar, volatile LAS unsigned* st) {
    XcdBarrier b; b.bar = bar; b.x = xb_xcc_id(); b.st = st;
    if (threadIdx.x == 0) (void)xb_add(&bar[XB_XCNT(b.x)], 1u);
    return b;
}
__device__ __forceinline__ void xcd_barrier_complete(unsigned* bar, unsigned x, unsigned& nloc, unsigned& nx) {
    const unsigned G = gridDim.x * gridDim.y * gridDim.z;
    unsigned sum, cnt, mine, sp = 0u;
    for (;;) {
        sum = 0u; cnt = 0u; mine = 0u;
#pragma unroll
        for (unsigned j = 0; j < 16; ++j) { const unsigned c = xb_ld(&bar[XB_XCNT(j)]); sum += c; cnt += (c > 0u) ? 1u : 0u; mine = (j == x) ? c : mine; }
        if (sum == G) break;
        __builtin_amdgcn_s_sleep(1);
        if ((++sp & 255u) == 0u) { if (xb_ld(&bar[XB_TMO])) break; if (sp > XB_SPIN_CAP) { atomicAdd(&bar[XB_TMO], 1u); break; } }
    }
    nloc = mine > 0u ? mine : 1u; nx = cnt > 0u ? cnt : 1u;
}
__device__ __forceinline__ void xcd_barrier(const XcdBarrier& b) {
    asm volatile("s_waitcnt vmcnt(0)" ::: "memory");
    __syncthreads();
    if (threadIdx.x == 0) {
        unsigned* bar = b.bar;
        __builtin_amdgcn_s_waitcnt(0);
        unsigned nloc = b.st[0], nx = b.st[1];
        if (nloc == 0u) { xcd_barrier_complete(bar, b.x, nloc, nx); b.st[0] = nloc; b.st[1] = nx; }
        const unsigned old = xb_add(&bar[XB_XSUB(b.x)], 1u);
        const unsigned gen = old / nloc;
        if (old + 1u == (gen + 1u) * nloc) {
            __builtin_amdgcn_fence(__ATOMIC_RELEASE, "agent");
            asm volatile("s_waitcnt vmcnt(0)" ::: "memory");
            const unsigned og = xb_add(&bar[XB_TOP], 1u);
            const unsigned tg = og / nx;
            if (og + 1u == (tg + 1u) * nx) xb_add(&bar[XB_TOPGEN], 1u);
            else XB_SPIN(xb_ld(&bar[XB_TOPGEN]) == tg, bar);
            __builtin_amdgcn_fence(__ATOMIC_ACQUIRE, "agent");
            xb_add(&bar[XB_XGEN(b.x)], 1u);
            asm volatile("s_waitcnt vmcnt(0)" ::: "memory");
        } else {
            XB_SPIN(xb_ld(&bar[XB_XGEN(b.x)]) == gen, bar);
            __builtin_amdgcn_fence(__ATOMIC_ACQUIRE, "agent");
            asm volatile("s_waitcnt vmcnt(0)" ::: "memory");
        }
    }
    __syncthreads();
}

struct Frame {
    LAS unsigned char* lds;
    volatile LAS unsigned* MISC;
    gu32* ctl;
    int tid, lane, wave, vcu, G;
    const float *x, *mem, *g_mix, *g_memn, *w_in, *b_forget, *g_fq, *g_fk, *g_mq, *g_mk, *w_mkv, *w_bsb, *w_bfx, *w_bmm, *w_out, *g_mlp, *w_up, *w_dn;
    float* out;
    float *logf, *FC, *ssq, *MKf;
    bf16 *Win_t, *Wmkv_t, *Wbr_t, *Wout_t, *Wup_t, *Wdn_t, *MHb, *MV, *XN, *SBQ, *SBK, *SBV, *FXQ, *FXK, *FXV, *MQ, *G0, *G1, *G2, *MRG, *U;
};

__device__ __forceinline__ void tr_item(const float* W, int ldw, int K, bf16* WT, int src_c0, int dst_r0, int k0, LAS float* scr, int lane) {
#pragma unroll 8
    for (int i = 0; i < 32; ++i) { const int kk = 2 * i + (lane >> 5); scr[kk * 33 + (lane & 31)] = W[(size_t)(k0 + kk) * ldw + src_c0 + (lane & 31)]; }
    LDS_WAIT(); asm volatile("" ::: "memory");
    const int c = lane & 7;
#pragma unroll
    for (int j = 0; j < 4; ++j) { const int n = (lane >> 3) + 8 * j; const LAS float* s = scr + (8 * c) * 33 + n;
        v4u o; o.x = pk2(s[0 * 33], s[1 * 33]); o.y = pk2(s[2 * 33], s[3 * 33]); o.z = pk2(s[4 * 33], s[5 * 33]); o.w = pk2(s[6 * 33], s[7 * 33]);
        *(GAS v4u*)(WT + (size_t)(dst_r0 + n) * K + k0 + 8 * c) = o; }
    LDS_WAIT(); asm volatile("" ::: "memory");
}
__host__ __device__ __forceinline__ int proj_src_col(int n) {
    const int pn = n >> 8, j = n & 255;
    if (pn < 12) { const int T = pn >> 1, bj = j >> 7, wc = (j >> 5) & 3, e = j & 31; return T * 512 + ((pn & 1) * 4 + wc) * 64 + bj * 32 + e; }
    if (pn < 14) return 3080 + (n - 12 * 256);
    return 3592 + (n - 14 * 256);
}
template <bool IS_X>
__device__ __forceinline__ void p0_rows(Frame& F, const float* srcb, const float* g, bf16* dstb, int nrows, LAS float* wf, int gw, int NGW) {
    const GAS f32x4* gr = (const GAS f32x4*)g + F.lane;
    for (int m = gw; m < nrows; m += NGW) {
        const GAS f32x4* xr = (const GAS f32x4*)(srcb + (size_t)m * D) + F.lane;
        f32x4 v[4]; float s = 0.f;
#pragma unroll
        for (int j = 0; j < 4; ++j) { v[j] = xr[64 * j]; s += (v[j].x * v[j].x + v[j].y * v[j].y) + (v[j].z * v[j].z + v[j].w * v[j].w); }
        const float rstd = 1.0f / sqrtf(wave_sum(s) * (1.f / D) + EPS);
#pragma unroll
        for (int j = 0; j < 4; ++j) { const f32x4 gg = gr[64 * j]; v[j] = v[j] * rstd * gg; }
        GAS unsigned long long* o8 = (GAS unsigned long long*)(dstb + (size_t)m * D) + F.lane;
#pragma unroll
        for (int j = 0; j < 4; ++j) o8[64 * j] = (unsigned long long)pk2(v[j].x, v[j].y) | ((unsigned long long)pk2(v[j].z, v[j].w) << 32);
        if (IS_X) {
            float fl[8];
#pragma unroll
            for (int c = 0; c < 8; ++c) fl[c] = 0.f;
#pragma unroll
            for (int j = 0; j < 4; ++j)
#pragma unroll
                for (int e = 0; e < 4; ++e) { const int d = 256 * j + 4 * F.lane + e; const float hv = v[j][e];
                    const f32x4 w0 = *(const LAS f32x4*)(wf + d * 8), w1 = *(const LAS f32x4*)(wf + d * 8 + 4);
                    fl[0] += hv * w0.x; fl[1] += hv * w0.y; fl[2] += hv * w0.z; fl[3] += hv * w0.w; fl[4] += hv * w1.x; fl[5] += hv * w1.y; fl[6] += hv * w1.z; fl[7] += hv * w1.w; }
            float mine = 0.f;
#pragma unroll
            for (int c = 0; c < 8; ++c) { const float t = wave_sum(fl[c]); if (F.lane == c) mine = t; }
            if (F.lane < 8) F.logf[(size_t)m * 8 + F.lane] = log_sigmoid_f(mine + F.b_forget[F.lane]);
        }
    }
}
__device__ __forceinline__ void p0_prologue(Frame& F) {
    LAS float* scr = (LAS float*)(F.lds + F.wave * 8448);
    LAS float* wf = (LAS float*)(F.lds + 8 * 8448);
    for (int i = F.tid; i < D * 8; i += NTHREADS) wf[i] = F.w_in[(size_t)(i >> 3) * DIN + 3072 + (i & 7)];
    const int gw = F.vcu * NWAVES + F.wave, NGW = F.G * NWAVES;
    constexpr int I_IN = 16 * 208, I_MKV = 16 * 32, I_BR = 8 * 32, I_OUT = 16 * 32, I_UP = 16 * 128, I_DN = 64 * 32;
    constexpr int NITEMS = I_IN + I_MKV + 3 * I_BR + I_OUT + I_UP + I_DN;
    for (int it = gw; it < NITEMS; it += NGW) {
        int r = it;
        if (r < I_IN) { const int kb = r / 208, gi = r % 208; tr_item(F.w_in, DIN, D, F.Win_t, proj_src_col(32 * gi), 32 * gi, 64 * kb, scr, F.lane); continue; } r -= I_IN;
        if (r < I_MKV) { const int kb = r / 32, gi = r % 32; tr_item(F.w_mkv, 1024, D, F.Wmkv_t, 32 * gi, 32 * gi, 64 * kb, scr, F.lane); continue; } r -= I_MKV;
        if (r < I_BR) { const int kb = r / 32, gi = r % 32; tr_item(F.w_bsb, D, DH, F.Wbr_t, 32 * gi, 32 * gi, 64 * kb, scr, F.lane); continue; } r -= I_BR;
        if (r < I_BR) { const int kb = r / 32, gi = r % 32; tr_item(F.w_bfx, D, DH, F.Wbr_t + (size_t)D * DH, 32 * gi, 32 * gi, 64 * kb, scr, F.lane); continue; } r -= I_BR;
        if (r < I_BR) { const int kb = r / 32, gi = r % 32; tr_item(F.w_bmm, D, DH, F.Wbr_t + (size_t)2 * D * DH, 32 * gi, 32 * gi, 64 * kb, scr, F.lane); continue; } r -= I_BR;
        if (r < I_OUT) { const int kb = r / 32, gi = r % 32; tr_item(F.w_out, D, D, F.Wout_t, 32 * gi, 32 * gi, 64 * kb, scr, F.lane); continue; } r -= I_OUT;
        if (r < I_UP) { const int kb = r / 128, gi = r % 128; tr_item(F.w_up, FF, D, F.Wup_t, 32 * gi, 32 * gi, 64 * kb, scr, F.lane); continue; } r -= I_UP;
        { const int kb = r / 32, gi = r % 32; tr_item(F.w_dn, D, FF, F.Wdn_t, 32 * gi, 32 * gi, 64 * kb, scr, F.lane); }
    }
    __syncthreads();
    p0_rows<true>(F, F.x, F.g_mix, F.XN, M, wf, gw, NGW);
    p0_rows<false>(F, F.mem, F.g_memn, F.MHb, MROWS, wf, gw, NGW);
}

template <class Epi>
__device__ __forceinline__ void ngemm(const bf16* A, int lda, const bf16* Bt, int ldb, int Mr, int Nc, int K, const Epi& E, int wg, int nwg) {
    const int tid = threadIdx.x, lane = tid & 63, wid = tid >> 6, wm = wid >> 1, wn = wid & 1;
    const int tilesN = Nc / 128, ntiles = (Mr / 128) * tilesN;
    for (int t = wg; t < ntiles; t += nwg) {
        const int tm = t / tilesN, tn = t % tilesN, r0 = tm * 128 + wm * 32, c0 = tn * 128 + wn * 64;
        f32x4 acc[2][4];
#pragma unroll
        for (int m = 0; m < 2; ++m)
#pragma unroll
            for (int n = 0; n < 4; ++n) acc[m][n] = (f32x4){0.f, 0.f, 0.f, 0.f};
        const bf16* ap = A + (size_t)(r0 + (lane & 15)) * lda + 8 * (lane >> 4);
        const bf16* bp = Bt + (size_t)(c0 + (lane & 15)) * ldb + 8 * (lane >> 4);
        for (int k0 = 0; k0 < K; k0 += 32) {
            bf16x8 a[2], b[4];
#pragma unroll
            for (int m = 0; m < 2; ++m) a[m] = *(const bf16x8*)(ap + (size_t)(m * 16) * lda + k0);
#pragma unroll
            for (int n = 0; n < 4; ++n) b[n] = *(const bf16x8*)(bp + (size_t)(n * 16) * ldb + k0);
#pragma unroll
            for (int m = 0; m < 2; ++m)
#pragma unroll
                for (int n = 0; n < 4; ++n) acc[m][n] = __builtin_amdgcn_mfma_f32_16x16x32_bf16(a[m], b[n], acc[m][n], 0, 0, 0);
        }
#pragma unroll
        for (int m = 0; m < 2; ++m)
#pragma unroll
            for (int n = 0; n < 4; ++n)
#pragma unroll
                for (int j = 0; j < 4; ++j) E(r0 + m * 16 + (lane >> 4) * 4 + j, c0 + n * 16 + (lane & 15), acc[m][n][j]);
    }
}

struct EpiProjN {
    bf16 *SBQ, *G0, *G2;
    __device__ __forceinline__ void operator()(int row, int n, float v) const {
        const int pn = n >> 8, j = n & 255;
        if (pn < 12) { const int T = pn >> 1, bj = j >> 7, wc = (j >> 5) & 3, e = j & 31, c = ((pn & 1) * 4 + wc) * 64 + bj * 32 + e;
            if (T == 0) v *= C2;
            (SBQ + (size_t)T * M * DH)[(size_t)row * DH + c] = (bf16)f2bf(v); }
        else if (pn < 14) { (SBQ + (size_t)6 * M * DH)[(size_t)row * DH + (n - 12 * 256)] = (bf16)f2bf(v); }
        else { const int g = (pn - 14) >> 2, c = n - (14 + 4 * g) * 256; bf16* G = g < 2 ? G0 + (size_t)g * M * D : G2;
            G[(size_t)row * D + c] = (bf16)f2bf(1.0f / (1.0f + expf(-v))); }
    }
};
struct EpiMkvN { float* MKf; bf16* MV;
    __device__ __forceinline__ void operator()(int row, int n, float v) const { if (n < DH) MKf[(size_t)row * DH + n] = v; else MV[(size_t)row * DH + (n - DH)] = (bf16)f2bf(v); } };
struct EpiOutN { const float* x; const float* g; float* x1; bf16* A2;
    __device__ __forceinline__ void operator()(int row, int n, float v) const { const size_t o = (size_t)row * D + n; const float r = x[o] + v; x1[o] = r; A2[o] = (bf16)f2bf(r * g[n]); } };
struct EpiUpN { const float* ssq; bf16* U;
    __device__ __forceinline__ void operator()(int row, int n, float v) const {
        const f32x4* p = (const f32x4*)(ssq + (size_t)row * 16); const f32x4 a = p[0], b = p[1], c = p[2], d = p[3];
        const float ss = ((a.x + a.y) + (a.z + a.w)) + ((b.x + b.y) + (b.z + b.w)) + ((c.x + c.y) + (c.z + c.w)) + ((d.x + d.y) + (d.z + d.w));
        const float rstd = 1.0f / sqrtf(ss * (1.f / D) + EPS); const float r = fmaxf(v, 0.f) * rstd; U[(size_t)row * FF + n] = (bf16)f2bf(r * r); } };
struct EpiDnN { float* out;
    __device__ __forceinline__ void operator()(int row, int n, float v) const { const size_t o = (size_t)row * D + n; out[o] = out[o] + v; } };

__device__ __forceinline__ void fcumsum(Frame& F) {
    const int gw = F.vcu * NWAVES + F.wave;
    if (gw >= BATCH * NH) return;
    const int b = gw >> 3, h = gw & 7;
    const float* src = F.logf + ((size_t)b * SEQ + 32 * F.lane) * 8 + h;
    float tot = 0.f;
    for (int i = 0; i < 32; ++i) tot += src[i * 8];
    float incl = tot;
#pragma unroll
    for (int off = 1; off < 64; off <<= 1) { const float y = __shfl_up(incl, off); if (F.lane >= off) incl += y; }
    float run = incl - tot;
    float* dst = F.FC + (size_t)gw * SEQ + 32 * F.lane;
    for (int i = 0; i < 32; ++i) { run += src[i * 8]; dst[i] = run; }
}

__device__ __forceinline__ void headnorm_naive(Frame& F) {
    const int gw = F.vcu * NWAVES + F.wave, NGW = F.G * NWAVES;
    for (int it = gw; it < 2 * M; it += NGW) {
        const int which = it / M, row = it % M;
        bf16* p = F.FXQ + (size_t)which * M * DH + (size_t)row * DH + 8 * F.lane;
        const float* g = (which == 0 ? F.g_fq : F.g_fk) + 8 * (F.lane & 7);
        const v4u w = *(const v4u*)p; float v[8] = {bflo(w.x), bfhi(w.x), bflo(w.y), bfhi(w.y), bflo(w.z), bfhi(w.z), bflo(w.w), bfhi(w.w)};
        float s = 0.f;
#pragma unroll
        for (int i = 0; i < 8; ++i) s += v[i] * v[i];
        s += __shfl_xor(s, 1); s += __shfl_xor(s, 2); s += __shfl_xor(s, 4);
        const float sc = (1.0f / sqrtf(s * (1.f / HD) + EPS)) * (which == 0 ? C2 : 1.0f);
#pragma unroll
        for (int i = 0; i < 8; ++i) v[i] = v[i] * sc * g[i];
        v4u o; o.x = pk2(v[0], v[1]); o.y = pk2(v[2], v[3]); o.z = pk2(v[4], v[5]); o.w = pk2(v[6], v[7]);
        *(v4u*)p = o;
    }
}

template <int MODE>
__device__ __forceinline__ void nattn64(const bf16* Q, const bf16* K, const bf16* V, bf16* O, const float* FC, int wg, int nwg) {
    const int tid = threadIdx.x, half = tid & 1;
    for (int u = wg; u < 512; u += nwg) {
        const int b = u >> 6, h = (u >> 3) & 7, blk = u & 7, t = blk * 256 + (tid >> 1); const size_t row = (size_t)b * SEQ + t;
        float q[32], o[32];
        { const v4u* qp = (const v4u*)(Q + row * DH + h * HD + half * 32);
#pragma unroll
          for (int i = 0; i < 4; ++i) { const v4u w = qp[i]; q[8 * i] = bflo(w.x); q[8 * i + 1] = bfhi(w.x); q[8 * i + 2] = bflo(w.y); q[8 * i + 3] = bfhi(w.y); q[8 * i + 4] = bflo(w.z); q[8 * i + 5] = bfhi(w.z); q[8 * i + 6] = bflo(w.w); q[8 * i + 7] = bfhi(w.w); } }
#pragma unroll
        for (int d = 0; d < 32; ++d) o[d] = 0.f;
        const int kend = blk * 256 + 256;
        const bf16* Kb = K + (size_t)b * SEQ * DH + h * HD + half * 32; const bf16* Vb = V + (size_t)b * SEQ * DH + h * HD + half * 32;
        const float* Fs = FC + (size_t)(b * NH + h) * SEQ;
        float carry = 0.f, mrun = -1e30f, lrun = 0.f;
        for (int i = 0; i < kend; ++i) {
            const int s = MODE == 0 ? kend - 1 - i : i;
            const v4u* kp = (const v4u*)(Kb + (size_t)s * DH); const v4u* vp = (const v4u*)(Vb + (size_t)s * DH);
            float z = 0.f;
#pragma unroll
            for (int c = 0; c < 4; ++c) { const v4u w = kp[c];
                z += q[8 * c] * bflo(w.x) + q[8 * c + 1] * bfhi(w.x) + q[8 * c + 2] * bflo(w.y) + q[8 * c + 3] * bfhi(w.y) + q[8 * c + 4] * bflo(w.z) + q[8 * c + 5] * bfhi(w.z) + q[8 * c + 6] * bflo(w.w) + q[8 * c + 7] * bfhi(w.w); }
            z += __shfl_xor(z, 1);
            float wgt;
            if (MODE == 0) {
                const float zn = z * LN2; const bool strict = s < t;
                const float lr = log_sigmoid_f(-zn), ls = zn + lr;
                wgt = strict ? expf(ls + carry) : 0.f; carry += strict ? lr : 0.f;
            } else {
                const float z2 = (s <= t) ? z - Fs[s] * LOG2E : -1e30f;
                const float mn = fmaxf(mrun, z2), al = exp2f(mrun - mn); wgt = (s <= t) ? exp2f(z2 - mn) : 0.f;
                lrun = lrun * al + wgt; mrun = mn;
#pragma unroll
                for (int d = 0; d < 32; ++d) o[d] *= al;
            }
#pragma unroll
            for (int c = 0; c < 4; ++c) { const v4u w = vp[c];
                o[8 * c] += wgt * bflo(w.x); o[8 * c + 1] += wgt * bfhi(w.x); o[8 * c + 2] += wgt * bflo(w.y); o[8 * c + 3] += wgt * bfhi(w.y); o[8 * c + 4] += wgt * bflo(w.z); o[8 * c + 5] += wgt * bfhi(w.z); o[8 * c + 6] += wgt * bflo(w.w); o[8 * c + 7] += wgt * bfhi(w.w); }
        }
        const float inv = MODE == 0 ? 1.0f : 1.0f / lrun;
        v4u* op = (v4u*)(O + row * DH + h * HD + half * 32);
#pragma unroll
        for (int i = 0; i < 4; ++i) { v4u w; w.x = pk2(o[8 * i] * inv, o[8 * i + 1] * inv); w.y = pk2(o[8 * i + 2] * inv, o[8 * i + 3] * inv); w.z = pk2(o[8 * i + 4] * inv, o[8 * i + 5] * inv); w.w = pk2(o[8 * i + 6] * inv, o[8 * i + 7] * inv); op[i] = w; }
    }
}
__device__ __forceinline__ void nattn_mem(Frame& F, int wg, int nwg) {
    const int tid = threadIdx.x, qt = tid & 3;
    for (int u = wg; u < 512; u += nwg) {
        const int b = u >> 6, hm = (u >> 4) & 3, blk = u & 15, t = blk * 128 + (tid >> 2); const size_t row = (size_t)b * SEQ + t;
        float q[32], o[32];
        { const v4u* qp = (const v4u*)(F.MQ + row * DH + hm * MHD + qt * 32);
#pragma unroll
          for (int i = 0; i < 4; ++i) { const v4u w = qp[i]; q[8 * i] = bflo(w.x); q[8 * i + 1] = bfhi(w.x); q[8 * i + 2] = bflo(w.y); q[8 * i + 3] = bfhi(w.y); q[8 * i + 4] = bflo(w.z); q[8 * i + 5] = bfhi(w.z); q[8 * i + 6] = bflo(w.w); q[8 * i + 7] = bfhi(w.w); } }
        float ss = 0.f;
#pragma unroll
        for (int d = 0; d < 32; ++d) ss += q[d] * q[d];
        ss += __shfl_xor(ss, 1); ss += __shfl_xor(ss, 2);
        const float rq = (1.0f / sqrtf(ss * (1.f / MHD) + EPS)) * C2M;
#pragma unroll
        for (int d = 0; d < 32; ++d) { q[d] = q[d] * rq * F.g_mq[qt * 32 + d] * F.g_mk[qt * 32 + d]; o[d] = 0.f; }
        float mrun = -1e30f, lrun = 0.f;
        for (int key = 0; key < MEMLEN; ++key) {
            const f32x4* kp = (const f32x4*)(F.MKf + (size_t)(b * MEMLEN + key) * DH + hm * MHD + qt * 32);
            const v4u* vp = (const v4u*)(F.MV + (size_t)(b * MEMLEN + key) * DH + hm * MHD + qt * 32);
            float dot = 0.f, kss = 0.f;
#pragma unroll
            for (int c = 0; c < 8; ++c) { const f32x4 k4 = kp[c]; dot += q[4 * c] * k4.x + q[4 * c + 1] * k4.y + q[4 * c + 2] * k4.z + q[4 * c + 3] * k4.w; kss += k4.x * k4.x + k4.y * k4.y + k4.z * k4.z + k4.w * k4.w; }
            dot += __shfl_xor(dot, 1); dot += __shfl_xor(dot, 2); kss += __shfl_xor(kss, 1); kss += __shfl_xor(kss, 2);
            const float z2 = dot * (1.0f / sqrtf(kss * (1.f / MHD) + EPS));
            const float mn = fmaxf(mrun, z2), al = exp2f(mrun - mn), wgt = exp2f(z2 - mn);
            lrun = lrun * al + wgt; mrun = mn;
#pragma unroll
            for (int c = 0; c < 4; ++c) { const v4u w = vp[c];
                o[8 * c] = o[8 * c] * al + wgt * bflo(w.x); o[8 * c + 1] = o[8 * c + 1] * al + wgt * bfhi(w.x); o[8 * c + 2] = o[8 * c + 2] * al + wgt * bflo(w.y); o[8 * c + 3] = o[8 * c + 3] * al + wgt * bfhi(w.y);
                o[8 * c + 4] = o[8 * c + 4] * al + wgt * bflo(w.z); o[8 * c + 5] = o[8 * c + 5] * al + wgt * bfhi(w.z); o[8 * c + 6] = o[8 * c + 6] * al + wgt * bflo(w.w); o[8 * c + 7] = o[8 * c + 7] * al + wgt * bfhi(w.w); }
        }
        const float inv = 1.0f / lrun;
        v4u* op = (v4u*)(F.MQ + row * DH + hm * MHD + qt * 32);
#pragma unroll
        for (int i = 0; i < 4; ++i) { v4u w; w.x = pk2(o[8 * i] * inv, o[8 * i + 1] * inv); w.y = pk2(o[8 * i + 2] * inv, o[8 * i + 3] * inv); w.z = pk2(o[8 * i + 4] * inv, o[8 * i + 5] * inv); w.w = pk2(o[8 * i + 6] * inv, o[8 * i + 7] * inv); op[i] = w; }
    }
}

__device__ __forceinline__ void nmerged(Frame& F, int wg, int nwg) {
    const int tid = threadIdx.x, lane = tid & 63, wid = tid >> 6, wm = wid >> 1, wn = wid & 1;
    const int tilesN = D / 128, ntiles = (M / 128) * tilesN;
    for (int t = wg; t < ntiles; t += nwg) {
        const int tm = t / tilesN, tn = t % tilesN, r0 = tm * 128 + wm * 32, c0 = tn * 128 + wn * 64;
        f32x4 tot[2][4];
#pragma unroll
        for (int m = 0; m < 2; ++m)
#pragma unroll
            for (int n = 0; n < 4; ++n) tot[m][n] = (f32x4){0.f, 0.f, 0.f, 0.f};
#pragma unroll 1
        for (int br = 0; br < 3; ++br) {
            const bf16* A = F.SBQ + (size_t)br * 3 * M * DH; const bf16* Bt = F.Wbr_t + (size_t)br * D * DH; const bf16* G = br < 2 ? F.G0 + (size_t)br * M * D : F.G2;
            f32x4 acc[2][4];
#pragma unroll
            for (int m = 0; m < 2; ++m)
#pragma unroll
                for (int n = 0; n < 4; ++n) acc[m][n] = (f32x4){0.f, 0.f, 0.f, 0.f};
            const bf16* ap = A + (size_t)(r0 + (lane & 15)) * DH + 8 * (lane >> 4);
            const bf16* bp = Bt + (size_t)(c0 + (lane & 15)) * DH + 8 * (lane >> 4);
            for (int k0 = 0; k0 < DH; k0 += 32) {
                bf16x8 a[2], b[4];
#pragma unroll
                for (int m = 0; m < 2; ++m) a[m] = *(const bf16x8*)(ap + (size_t)(m * 16) * DH + k0);
#pragma unroll
                for (int n = 0; n < 4; ++n) b[n] = *(const bf16x8*)(bp + (size_t)(n * 16) * DH + k0);
#pragma unroll
                for (int m = 0; m < 2; ++m)
#pragma unroll
                    for (int n = 0; n < 4; ++n) acc[m][n] = __builtin_amdgcn_mfma_f32_16x16x32_bf16(a[m], b[n], acc[m][n], 0, 0, 0);
            }
#pragma unroll
            for (int m = 0; m < 2; ++m)
#pragma unroll
                for (int n = 0; n < 4; ++n)
#pragma unroll
                    for (int j = 0; j < 4; ++j) tot[m][n][j] += bf2f(G[(size_t)(r0 + m * 16 + (lane >> 4) * 4 + j) * D + c0 + n * 16 + (lane & 15)]) * acc[m][n][j];
        }
#pragma unroll
        for (int m = 0; m < 2; ++m)
#pragma unroll
            for (int n = 0; n < 4; ++n)
#pragma unroll
                for (int j = 0; j < 4; ++j) F.MRG[(size_t)(r0 + m * 16 + (lane >> 4) * 4 + j) * D + c0 + n * 16 + (lane & 15)] = (bf16)f2bf(tot[m][n][j]);
    }
}
__device__ __forceinline__ void ssq_naive(Frame& F) {
    const int gw = F.vcu * NWAVES + F.wave, NGW = F.G * NWAVES;
    for (int m = gw; m < M; m += NGW) {
        const GAS f32x4* xr = (const GAS f32x4*)(F.out + (size_t)m * D) + F.lane; float s = 0.f;
#pragma unroll
        for (int j = 0; j < 4; ++j) { const f32x4 v = xr[64 * j]; s += (v.x * v.x + v.y * v.y) + (v.z * v.z + v.w * v.w); }
        s = wave_sum(s);
        if (F.lane < 16) F.ssq[(size_t)m * 16 + F.lane] = F.lane == 0 ? s : 0.f;
    }
}

constexpr int N_PHASES = 9;
#ifndef MK_N_LAUNCHES
#define MK_N_LAUNCHES 9
#endif
constexpr int N_LAUNCHES = MK_N_LAUNCHES;
struct Args { const float* in[18]; float* out; unsigned char* ws; int ph_lo, ph_hi, li, pad; };

__global__ void __launch_bounds__(NTHREADS, 2) skel_fwd(Args args) {
    extern __shared__ __attribute__((aligned(16))) unsigned char lds[];
    Frame F;
    F.lds = (LAS unsigned char*)lds;
    F.MISC = (volatile LAS unsigned*)(F.lds + MISC_OFF);
    F.tid = threadIdx.x; F.lane = F.tid & 63; F.wave = __builtin_amdgcn_readfirstlane(F.tid >> 6);
    F.G = gridDim.x; { const int bx = blockIdx.x; F.vcu = (F.G % 8 == 0) ? (bx % 8) * (F.G / 8) + bx / 8 : bx; }
    unsigned char* ws = args.ws;
    F.ctl = (gu32*)(ws + WS_CTL);
    F.x = args.in[0]; F.mem = args.in[1]; F.g_mix = args.in[2]; F.g_memn = args.in[3]; F.w_in = args.in[4]; F.b_forget = args.in[5]; F.g_fq = args.in[6]; F.g_fk = args.in[7];
    F.g_mq = args.in[8]; F.g_mk = args.in[9]; F.w_mkv = args.in[10]; F.w_bsb = args.in[11]; F.w_bfx = args.in[12]; F.w_bmm = args.in[13]; F.w_out = args.in[14]; F.g_mlp = args.in[15];
    F.w_up = args.in[16]; F.w_dn = args.in[17]; F.out = args.out;
    F.logf = (float*)(ws + WS_LOGF); F.FC = (float*)(ws + WS_FC); F.ssq = (float*)(ws + WS_SSQ); F.MKf = (float*)(ws + WS_MKF);
    F.Win_t = (bf16*)(ws + WS_WIN); F.Wmkv_t = (bf16*)(ws + WS_WMKV); F.Wbr_t = (bf16*)(ws + WS_WBR); F.Wout_t = (bf16*)(ws + WS_WOUT); F.Wup_t = (bf16*)(ws + WS_WUP); F.Wdn_t = (bf16*)(ws + WS_WDN);
    F.MHb = (bf16*)(ws + WS_MH); F.MV = (bf16*)(ws + WS_MV); F.XN = (bf16*)(ws + WS_XN);
    F.SBQ = (bf16*)(ws + WS_SBQ); F.SBK = (bf16*)(ws + WS_SBK); F.SBV = (bf16*)(ws + WS_SBV); F.FXQ = (bf16*)(ws + WS_FXQ); F.FXK = (bf16*)(ws + WS_FXK); F.FXV = (bf16*)(ws + WS_FXV); F.MQ = (bf16*)(ws + WS_MQ);
    F.G0 = (bf16*)args.out; F.G1 = (bf16*)args.out + (size_t)M * D; F.G2 = (bf16*)(ws + WS_G2); F.MRG = (bf16*)(ws + WS_MRG); F.U = (bf16*)(ws + WS_U);
    for (int u = F.tid; u < (LDS_BYTES - LDSCTL_OFF) / 4; u += NTHREADS) ((LAS unsigned*)(F.lds + LDSCTL_OFF))[u] = 0u;
    __syncthreads();
    XcdBarrier bar; bar.bar = (unsigned*)(F.ctl + CW_BAR); bar.x = 0; bar.st = nullptr;
    if (N_LAUNCHES == 1) bar = xcd_barrier_post((unsigned*)(F.ctl + CW_BAR), F.MISC + 8);
#define GRID_BAR() do { if (N_LAUNCHES == 1) xcd_barrier(bar); } while (0)
    const int lo = args.ph_lo, hi = args.ph_hi;
#define IN(k) (lo <= (k) && (k) < hi)
#define BOTH(k) (IN(k) && IN((k) + 1))
    const int wg = (int)blockIdx.x, nwg = F.G;

    if (IN(0)) { p0_prologue(F); if (BOTH(0)) GRID_BAR(); }
    if (IN(1)) {
        fcumsum(F);
        { EpiProjN E{F.SBQ, F.G0, F.G2}; ngemm(F.XN, D, F.Win_t, D, M, NPROJ, D, E, wg, nwg); }
        { EpiMkvN E{F.MKf, F.MV}; ngemm(F.MHb, D, F.Wmkv_t, D, MROWS, 1024, D, E, wg, nwg); }
        if (BOTH(1)) GRID_BAR();
    }
    if (IN(2)) { headnorm_naive(F); if (BOTH(2)) GRID_BAR(); }
    if (IN(3)) {
        nattn64<0>(F.SBQ, F.SBK, F.SBV, F.SBQ, F.FC, wg, nwg);
        nattn64<1>(F.FXQ, F.FXK, F.FXV, F.FXQ, F.FC, wg, nwg);
        nattn_mem(F, wg, nwg);
        if (BOTH(3)) GRID_BAR();
    }
    if (IN(4)) { nmerged(F, wg, nwg); if (BOTH(4)) GRID_BAR(); }
    if (IN(5)) { EpiOutN E{F.x, F.g_mlp, F.out, F.XN}; ngemm(F.MRG, D, F.Wout_t, D, M, D, D, E, wg, nwg); if (BOTH(5)) GRID_BAR(); }
    if (IN(6)) { ssq_naive(F); if (BOTH(6)) GRID_BAR(); }
    if (IN(7)) { EpiUpN E{F.ssq, F.U}; ngemm(F.XN, D, F.Wup_t, D, M, FF, D, E, wg, nwg); if (BOTH(7)) GRID_BAR(); }
    if (IN(8)) { EpiDnN E{F.out}; ngemm(F.U, FF, F.Wdn_t, FF, M, D, FF, E, wg, nwg); }
#undef IN
#undef BOTH
}

extern "C" void kernel_launch(void* const* d_in, const int* in_sizes, int n_in, void* d_out, int out_size, void* d_ws, size_t ws_size, hipStream_t stream) {
    static int grid = 0;
    if (grid == 0) {
        if (n_in != 18 || in_sizes[0] != M * D || out_size != M * D || ws_size < WS_END) { fprintf(stderr, "kernel_launch: unexpected shapes (n_in %d, in0 %d, out %d, ws %zu); nothing launched\n", n_in, n_in > 0 ? in_sizes[0] : -1, out_size, ws_size); grid = -1; return; }
        int dev = 0, cus = 0, per_cu = 0;
        if (hipGetDevice(&dev) != hipSuccess || hipDeviceGetAttribute(&cus, hipDeviceAttributeMultiprocessorCount, dev) != hipSuccess) { grid = -1; return; }
        if (hipFuncSetAttribute((const void*)skel_fwd, hipFuncAttributeMaxDynamicSharedMemorySize, LDS_BYTES) != hipSuccess) { fprintf(stderr, "kernel_launch: hipFuncSetAttribute failed\n"); grid = -1; return; }
        if (hipOccupancyMaxActiveBlocksPerMultiprocessor(&per_cu, (const void*)skel_fwd, NTHREADS, LDS_BYTES) != hipSuccess || per_cu < 1) fprintf(stderr, "kernel_launch: occupancy query reports %d\n", per_cu);
        (void)hipGetLastError();
        grid = cus;
    }
    if (grid < 0) return;
    if (hipMemsetAsync((char*)d_ws + WS_CTL, 0, CTL_ZERO_BYTES, stream) != hipSuccess) return;
    Args a{};
    for (int i = 0; i < 18; ++i) a.in[i] = (const float*)d_in[i];
    a.out = (float*)d_out; a.ws = (unsigned char*)d_ws;
    for (int li = 0; li < N_LAUNCHES; ++li) {
        a.ph_lo = (N_LAUNCHES == 1) ? 0 : li; a.ph_hi = (N_LAUNCHES == 1) ? N_PHASES : li + 1; a.li = li;
        hipLaunchKernelGGL(skel_fwd, dim3(grid), dim3(NTHREADS), LDS_BYTES, stream, a);
        if (hipPeekAtLastError() != hipSuccess) break;
    }
}
```

```cpp
#include <hip/hip_runtime.h>
#include <cstdio>
#include <cstdint>

#define GAS __attribute__((address_space(1)))
#define LAS __attribute__((address_space(3)))
typedef unsigned short bf16;
typedef short bf16x8 __attribute__((ext_vector_type(8)));
typedef float f32x4 __attribute__((ext_vector_type(4)));
typedef unsigned v4u __attribute__((ext_vector_type(4)));
typedef GAS unsigned gu32;
#define RLX_AGENT __ATOMIC_RELAXED, __HIP_MEMORY_SCOPE_AGENT
#define LDS_WAIT() asm volatile("s_waitcnt lgkmcnt(0)" ::: "memory")
#define VM_WAIT() asm volatile("s_waitcnt vmcnt(0)" ::: "memory")

constexpr int NWAVES = 8, NTHREADS = 512;
constexpr int BATCH = 8, SEQ = 2048, M = BATCH * SEQ, D = 1024, MEMLEN = 256, MROWS = BATCH * MEMLEN;
constexpr int HD = 64, NH = 8, MNH = 4, MHD = 128, DH = 512, FF = 4096;
constexpr int DIN = 6664, NPROJ = 6656;
constexpr float EPS = 1e-6f, LOG2E = 1.4426950408889634f, LN2 = 0.6931471805599453f;
constexpr float C2 = 0.125f * LOG2E;
constexpr float C2M = 0.08838834764831845f * LOG2E;

constexpr size_t MiB = 1u << 20;
constexpr size_t WS_CTL = 0, CTL_ZERO_BYTES = 65536;
constexpr size_t WS_LOGF = 1 * MiB, WS_FC = 1 * MiB + 512 * 1024, WS_SSQ = 2 * MiB;
constexpr size_t WS_WIN = 3 * MiB, WS_WMKV = 16 * MiB, WS_WBR = 18 * MiB, WS_WOUT = 21 * MiB, WS_WUP = 23 * MiB, WS_WDN = 31 * MiB;
constexpr size_t WS_MH = 39 * MiB, WS_MV = 43 * MiB, WS_XN = 48 * MiB;
constexpr size_t WS_SBQ = 80 * MiB, WS_SBK = 96 * MiB, WS_SBV = 112 * MiB, WS_FXQ = 128 * MiB, WS_FXK = 144 * MiB, WS_FXV = 160 * MiB, WS_MQ = 176 * MiB;
constexpr size_t WS_G2 = 192 * MiB, WS_MRG = 224 * MiB, WS_MKF = 224 * MiB, WS_U = 80 * MiB, WS_END = 256 * MiB;
constexpr int CW_BAR = 4096;

constexpr int RING_BYTES = 131072, LDSCTL_OFF = RING_BYTES, MISC_OFF = LDSCTL_OFF + 320, LDS_BYTES = 147456;

__device__ __forceinline__ unsigned f2bf(float f) { unsigned u = __builtin_bit_cast(unsigned, f); return (u + 0x7fffu + ((u >> 16) & 1u)) >> 16; }
__device__ __forceinline__ unsigned pk2(float lo, float hi) { return f2bf(lo) | (f2bf(hi) << 16); }
__device__ __forceinline__ float bf2f(unsigned b) { return __uint_as_float(b << 16); }
__device__ __forceinline__ float bflo(unsigned w) { return __uint_as_float(w << 16); }
__device__ __forceinline__ float bfhi(unsigned w) { return __uint_as_float(w & 0xffff0000u); }
__device__ __forceinline__ float wave_sum(float v) {
#pragma unroll
    for (int o = 1; o < 64; o <<= 1) v += __shfl_xor(v, o);
    return v;
}
__device__ __forceinline__ float log_sigmoid_f(float x) { return fminf(x, 0.f) - log1pf(expf(-fabsf(x))); }

#define XB_TMO      128
#define XB_XCNT(j)  (256  + 64 * (j))
#define XB_XSUB(j)  (1280 + 64 * (j))
#define XB_XGEN(j)  (2304 + 64 * (j))
#define XB_TOP      3328
#define XB_TOPGEN   3392
#define XCD_BAR_WORDS 3456
#define XB_SPIN_CAP (1u << 18)
__device__ __forceinline__ unsigned xb_ld(unsigned* p)              { return __hip_atomic_load(p, __ATOMIC_RELAXED, __HIP_MEMORY_SCOPE_AGENT); }
__device__ __forceinline__ unsigned xb_add(unsigned* p, unsigned v) { return __hip_atomic_fetch_add(p, v, __ATOMIC_RELAXED, __HIP_MEMORY_SCOPE_AGENT); }
__device__ __forceinline__ unsigned xb_xcc_id() { return (unsigned)__builtin_amdgcn_s_getreg((3 << 11) | 20) & 0xFu; }
#define XB_SPIN(cond, bar) do { unsigned _sp = 0; while (cond) { __builtin_amdgcn_s_sleep(1); \
    if ((++_sp & 255u) == 0u) { if (xb_ld(&(bar)[XB_TMO])) break; if (_sp > XB_SPIN_CAP) { atomicAdd(&(bar)[XB_TMO], 1u); break; } } } } while (0)
struct XcdBarrier { unsigned* bar; unsigned x; volatile LAS unsigned* st; };
__device__ __forceinline__ XcdBarrier xcd_barrier_post(unsigned* bar, volatile LAS unsigned* st) {
    XcdBarrier b; b.bar = bar; b.x = xb_xcc_id(); b.st = st;
    if (threadIdx.x == 0) (void)xb_add(&bar[XB_XCNT(b.x)], 1u);
    return b;
}
__device__ __forceinline__ void xcd_barrier_complete(unsigned* bar, unsigned x, unsigned& nloc, unsigned& nx) {
    const unsigned G = gridDim.x * gridDim.y * gridDim.z;
    unsigned sum, cnt, mine, sp = 0u;
    for (;;) {
        sum = 0u; cnt = 0u; mine = 0u;
#pragma unroll
        for (unsigned j = 0; j < 16; ++j) { const unsigned c = xb_ld(&bar[XB_XCNT(j)]); sum += c; cnt += (c > 0u) ? 1u : 0u; mine = (j == x) ? c : mine; }
        if (sum == G) break;
        __builtin_amdgcn_s_sleep(1);
        if ((++sp & 255u) == 0u) { if (xb_ld(&bar[XB_TMO])) break; if (sp > XB_SPIN_CAP) { atomicAdd(&bar[XB_TMO], 1u); break; } }
    }
    nloc = mine > 0u ? mine : 1u; nx = cnt > 0u ? cnt : 1u;
}
__device__ __forceinline__ void xcd_barrier(const XcdBarrier& b) {
    asm volatile("s_waitcnt vmcnt(0)" ::: "memory");
    __syncthreads();
    if (threadIdx.x == 0) {
        unsigned* bar = b.bar;
        __builtin_amdgcn_s_waitcnt(0);
        unsigned nloc = b.st[0], nx = b.st[1];
        if (nloc == 0u) { xcd_barrier_complete(bar, b.x, nloc, nx); b.st[0] = nloc; b.st[1] = nx; }
        const unsigned old = xb_add(&bar[XB_XSUB(b.x)], 1u);
        const unsigned gen = old / nloc;
        if (old + 1u == (gen + 1u) * nloc) {
            __builtin_amdgcn_fence(__ATOMIC_RELEASE, "agent");
            asm volatile("s_waitcnt vmcnt(0)" ::: "memory");
            const unsigned og = xb_add(&bar[XB_TOP], 1u);
            const unsigned tg = og / nx;
            if (og + 1u == (tg + 1u) * nx) xb_add(&bar[XB_TOPGEN], 1u);
            else XB_SPIN(xb_ld(&bar[XB_TOPGEN]) == tg, bar);
            __builtin_amdgcn_fence(__ATOMIC_ACQUIRE, "agent");
            xb_add(&bar[XB_XGEN(b.x)], 1u);
            asm volatile("s_waitcnt vmcnt(0)" ::: "memory");
        } else {
            XB_SPIN(xb_ld(&bar[XB_XGEN(b.x)]) == gen, bar);
            __builtin_amdgcn_fence(__ATOMIC_ACQUIRE, "agent");
            asm volatile("s_waitcnt vmcnt(0)" ::: "memory");
        }
    }
    __syncthreads();
}

struct Frame {
    LAS unsigned char* lds;
    volatile LAS unsigned* MISC;
    gu32* ctl;
    int tid, lane, wave, vcu, G;
    const float *x, *mem, *g_mix, *g_memn, *w_in, *b_forget, *g_fq, *g_fk, *g_mq, *g_mk, *w_mkv, *w_bsb, *w_bfx, *w_bmm, *w_out, *g_mlp, *w_up, *w_dn;
    float* out;
    float *logf, *FC, *ssq, *MKf;
    bf16 *Win_t, *Wmkv_t, *Wbr_t, *Wout_t, *Wup_t, *Wdn_t, *MHb, *MV, *XN, *SBQ, *SBK, *SBV, *FXQ, *FXK, *FXV, *MQ, *G0, *G1, *G2, *MRG, *U;
};

__device__ __forceinline__ void tr_item(const float* W, int ldw, int K, bf16* WT, int src_c0, int dst_r0, int k0, LAS float* scr, int lane) {
#pragma unroll 8
    for (int i = 0; i < 32; ++i) { const int kk = 2 * i + (lane >> 5); scr[kk * 33 + (lane & 31)] = W[(size_t)(k0 + kk) * ldw + src_c0 + (lane & 31)]; }
    LDS_WAIT(); asm volatile("" ::: "memory");
    const int c = lane & 7;
#pragma unroll
    for (int j = 0; j < 4; ++j) { const int n = (lane >> 3) + 8 * j; const LAS float* s = scr + (8 * c) * 33 + n;
        v4u o; o.x = pk2(s[0 * 33], s[1 * 33]); o.y = pk2(s[2 * 33], s[3 * 33]); o.z = pk2(s[4 * 33], s[5 * 33]); o.w = pk2(s[6 * 33], s[7 * 33]);
        *(GAS v4u*)(WT + (size_t)(dst_r0 + n) * K + k0 + 8 * c) = o; }
    LDS_WAIT(); asm volatile("" ::: "memory");
}
__host__ __device__ __forceinline__ int proj_src_col(int n) {
    const int pn = n >> 8, j = n & 255;
    if (pn < 12) { const int T = pn >> 1, bj = j >> 7, wc = (j >> 5) & 3, e = j & 31; return T * 512 + ((pn & 1) * 4 + wc) * 64 + bj * 32 + e; }
    if (pn < 14) return 3080 + (n - 12 * 256);
    return 3592 + (n - 14 * 256);
}
template <bool IS_X>
__device__ __forceinline__ void p0_rows(Frame& F, const float* srcb, const float* g, bf16* dstb, int nrows, LAS float* wf, int gw, int NGW) {
    const GAS f32x4* gr = (const GAS f32x4*)g + F.lane;
    for (int m = gw; m < nrows; m += NGW) {
        const GAS f32x4* xr = (const GAS f32x4*)(srcb + (size_t)m * D) + F.lane;
        f32x4 v[4]; float s = 0.f;
#pragma unroll
        for (int j = 0; j < 4; ++j) { v[j] = xr[64 * j]; s += (v[j].x * v[j].x + v[j].y * v[j].y) + (v[j].z * v[j].z + v[j].w * v[j].w); }
        const float rstd = 1.0f / sqrtf(wave_sum(s) * (1.f / D) + EPS);
#pragma unroll
        for (int j = 0; j < 4; ++j) { const f32x4 gg = gr[64 * j]; v[j] = v[j] * rstd * gg; }
        GAS unsigned long long* o8 = (GAS unsigned long long*)(dstb + (size_t)m * D) + F.lane;
#pragma unroll
        for (int j = 0; j < 4; ++j) o8[64 * j] = (unsigned long long)pk2(v[j].x, v[j].y) | ((unsigned long long)pk2(v[j].z, v[j].w) << 32);
        if (IS_X) {
            float fl[8];
#pragma unroll
            for (int c = 0; c < 8; ++c) fl[c] = 0.f;
#pragma unroll
            for (int j = 0; j < 4; ++j)
#pragma unroll
                for (int e = 0; e < 4; ++e) { const int d = 256 * j + 4 * F.lane + e; const float hv = v[j][e];
                    const f32x4 w0 = *(const LAS f32x4*)(wf + d * 8), w1 = *(const LAS f32x4*)(wf + d * 8 + 4);
                    fl[0] += hv * w0.x; fl[1] += hv * w0.y; fl[2] += hv * w0.z; fl[3] += hv * w0.w; fl[4] += hv * w1.x; fl[5] += hv * w1.y; fl[6] += hv * w1.z; fl[7] += hv * w1.w; }
            float mine = 0.f;
#pragma unroll
            for (int c = 0; c < 8; ++c) { const float t = wave_sum(fl[c]); if (F.lane == c) mine = t; }
            if (F.lane < 8) F.logf[(size_t)m * 8 + F.lane] = log_sigmoid_f(mine + F.b_forget[F.lane]);
        }
    }
}
__device__ __forceinline__ void p0_prologue(Frame& F) {
    LAS float* scr = (LAS float*)(F.lds + F.wave * 8448);
    LAS float* wf = (LAS float*)(F.lds + 8 * 8448);
    for (int i = F.tid; i < D * 8; i += NTHREADS) wf[i] = F.w_in[(size_t)(i >> 3) * DIN + 3072 + (i & 7)];
    const int gw = F.vcu * NWAVES + F.wave, NGW = F.G * NWAVES;
    constexpr int I_IN = 16 * 208, I_MKV = 16 * 32, I_BR = 8 * 32, I_OUT = 16 * 32, I_UP = 16 * 128, I_DN = 64 * 32;
    constexpr int NITEMS = I_IN + I_MKV + 3 * I_BR + I_OUT + I_UP + I_DN;
    for (int it = gw; it < NITEMS; it += NGW) {
        int r = it;
        if (r < I_IN) { const int kb = r / 208, gi = r % 208; tr_item(F.w_in, DIN, D, F.Win_t, proj_src_col(32 * gi), 32 * gi, 64 * kb, scr, F.lane); continue; } r -= I_IN;
        if (r < I_MKV) { const int kb = r / 32, gi = r % 32; tr_item(F.w_mkv, 1024, D, F.Wmkv_t, 32 * gi, 32 * gi, 64 * kb, scr, F.lane); continue; } r -= I_MKV;
        if (r < I_BR) { const int kb = r / 32, gi = r % 32; tr_item(F.w_bsb, D, DH, F.Wbr_t, 32 * gi, 32 * gi, 64 * kb, scr, F.lane); continue; } r -= I_BR;
        if (r < I_BR) { const int kb = r / 32, gi = r % 32; tr_item(F.w_bfx, D, DH, F.Wbr_t + (size_t)D * DH, 32 * gi, 32 * gi, 64 * kb, scr, F.lane); continue; } r -= I_BR;
        if (r < I_BR) { const int kb = r / 32, gi = r % 32; tr_item(F.w_bmm, D, DH, F.Wbr_t + (size_t)2 * D * DH, 32 * gi, 32 * gi, 64 * kb, scr, F.lane); continue; } r -= I_BR;
        if (r < I_OUT) { const int kb = r / 32, gi = r % 32; tr_item(F.w_out, D, D, F.Wout_t, 32 * gi, 32 * gi, 64 * kb, scr, F.lane); continue; } r -= I_OUT;
        if (r < I_UP) { const int kb = r / 128, gi = r % 128; tr_item(F.w_up, FF, D, F.Wup_t, 32 * gi, 32 * gi, 64 * kb, scr, F.lane); continue; } r -= I_UP;
        { const int kb = r / 32, gi = r % 32; tr_item(F.w_dn, D, FF, F.Wdn_t, 32 * gi, 32 * gi, 64 * kb, scr, F.lane); }
    }
    __syncthreads();
    p0_rows<true>(F, F.x, F.g_mix, F.XN, M, wf, gw, NGW);
    p0_rows<false>(F, F.mem, F.g_memn, F.MHb, MROWS, wf, gw, NGW);
}

template <class Epi>
__device__ __forceinline__ void ngemm(const bf16* A, int lda, const bf16* Bt, int ldb, int Mr, int Nc, int K, const Epi& E, int wg, int nwg) {
    const int tid = threadIdx.x, lane = tid & 63, wid = tid >> 6, wm = wid >> 1, wn = wid & 1;
    const int tilesN = Nc / 128, ntiles = (Mr / 128) * tilesN;
    for (int t = wg; t < ntiles; t += nwg) {
        const int tm = t / tilesN, tn = t % tilesN, r0 = tm * 128 + wm * 32, c0 = tn * 128 + wn * 64;
        f32x4 acc[2][4];
#pragma unroll
        for (int m = 0; m < 2; ++m)
#pragma unroll
            for (int n = 0; n < 4; ++n) acc[m][n] = (f32x4){0.f, 0.f, 0.f, 0.f};
        const bf16* ap = A + (size_t)(r0 + (lane & 15)) * lda + 8 * (lane >> 4);
        const bf16* bp = Bt + (size_t)(c0 + (lane & 15)) * ldb + 8 * (lane >> 4);
        for (int k0 = 0; k0 < K; k0 += 32) {
            bf16x8 a[2], b[4];
#pragma unroll
            for (int m = 0; m < 2; ++m) a[m] = *(const bf16x8*)(ap + (size_t)(m * 16) * lda + k0);
#pragma unroll
            for (int n = 0; n < 4; ++n) b[n] = *(const bf16x8*)(bp + (size_t)(n * 16) * ldb + k0);
#pragma unroll
            for (int m = 0; m < 2; ++m)
#pragma unroll
                for (int n = 0; n < 4; ++n) acc[m][n] = __builtin_amdgcn_mfma_f32_16x16x32_bf16(a[m], b[n], acc[m][n], 0, 0, 0);
        }
#pragma unroll
        for (int m = 0; m < 2; ++m)
#pragma unroll
            for (int n = 0; n < 4; ++n)
#pragma unroll
                for (int j = 0; j < 4; ++j) E(r0 + m * 16 + (lane >> 4) * 4 + j, c0 + n * 16 + (lane & 15), acc[m][n][j]);
    }
}

struct EpiProjN {
    bf16 *SBQ, *G0, *G2;
    __device__ __forceinline__ void operator()(int row, int n, float v) const {
        const int pn = n >> 8, j = n & 255;
        if (pn < 12) { const int T = pn >> 1, bj = j >> 7, wc = (j >> 5) & 3, e = j & 31, c = ((pn & 1) * 4 + wc) * 64 + bj * 32 + e;
            if (T == 0) v *= C2;
            (SBQ + (size_t)T * M * DH)[(size_t)row * DH + c] = (bf16)f2bf(v); }
        else if (pn < 14) { (SBQ + (size_t)6 * M * DH)[(size_t)row * DH + (n - 12 * 256)] = (bf16)f2bf(v); }
        else { const int g = (pn - 14) >> 2, c = n - (14 + 4 * g) * 256; bf16* G = g < 2 ? G0 + (size_t)g * M * D : G2;
            G[(size_t)row * D + c] = (bf16)f2bf(1.0f / (1.0f + expf(-v))); }
    }
};
struct EpiMkvN { float* MKf; bf16* MV;
    __device__ __forceinline__ void operator()(int row, int n, float v) const { if (n < DH) MKf[(size_t)row * DH + n] = v; else MV[(size_t)row * DH + (n - DH)] = (bf16)f2bf(v); } };
struct EpiOutN { const float* x; const float* g; float* x1; bf16* A2;
    __device__ __forceinline__ void operator()(int row, int n, float v) const { const size_t o = (size_t)row * D + n; const float r = x[o] + v; x1[o] = r; A2[o] = (bf16)f2bf(r * g[n]); } };
struct EpiUpN { const float* ssq; bf16* U;
    __device__ __forceinline__ void operator()(int row, int n, float v) const {
        const f32x4* p = (const f32x4*)(ssq + (size_t)row * 16); const f32x4 a = p[0], b = p[1], c = p[2], d = p[3];
        const float ss = ((a.x + a.y) + (a.z + a.w)) + ((b.x + b.y) + (b.z + b.w)) + ((c.x + c.y) + (c.z + c.w)) + ((d.x + d.y) + (d.z + d.w));
        const float rstd = 1.0f / sqrtf(ss * (1.f / D) + EPS); const float r = fmaxf(v, 0.f) * rstd; U[(size_t)row * FF + n] = (bf16)f2bf(r * r); } };
struct EpiDnN { float* out;
    __device__ __forceinline__ void operator()(int row, int n, float v) const { const size_t o = (size_t)row * D + n; out[o] = out[o] + v; } };

__device__ __forceinline__ void fcumsum(Frame& F) {
    const int gw = F.vcu * NWAVES + F.wave;
    if (gw >= BATCH * NH) return;
    const int b = gw >> 3, h = gw & 7;
    const float* src = F.logf + ((size_t)b * SEQ + 32 * F.lane) * 8 + h;
    float tot = 0.f;
    for (int i = 0; i < 32; ++i) tot += src[i * 8];
    float incl = tot;
#pragma unroll
    for (int off = 1; off < 64; off <<= 1) { const float y = __shfl_up(incl, off); if (F.lane >= off) incl += y; }
    float run = incl - tot;
    float* dst = F.FC + (size_t)gw * SEQ + 32 * F.lane;
    for (int i = 0; i < 32; ++i) { run += src[i * 8]; dst[i] = run; }
}

__device__ __forceinline__ void headnorm_naive(Frame& F) {
    const int gw = F.vcu * NWAVES + F.wave, NGW = F.G * NWAVES;
    for (int it = gw; it < 2 * M; it += NGW) {
        const int which = it / M, row = it % M;
        bf16* p = F.FXQ + (size_t)which * M * DH + (size_t)row * DH + 8 * F.lane;
        const float* g = (which == 0 ? F.g_fq : F.g_fk) + 8 * (F.lane & 7);
        const v4u w = *(const v4u*)p; float v[8] = {bflo(w.x), bfhi(w.x), bflo(w.y), bfhi(w.y), bflo(w.z), bfhi(w.z), bflo(w.w), bfhi(w.w)};
        float s = 0.f;
#pragma unroll
        for (int i = 0; i < 8; ++i) s += v[i] * v[i];
        s += __shfl_xor(s, 1); s += __shfl_xor(s, 2); s += __shfl_xor(s, 4);
        const float sc = (1.0f / sqrtf(s * (1.f / HD) + EPS)) * (which == 0 ? C2 : 1.0f);
#pragma unroll
        for (int i = 0; i < 8; ++i) v[i] = v[i] * sc * g[i];
        v4u o; o.x = pk2(v[0], v[1]); o.y = pk2(v[2], v[3]); o.z = pk2(v[4], v[5]); o.w = pk2(v[6], v[7]);
        *(v4u*)p = o;
    }
}

template <int MODE>
__device__ __forceinline__ void nattn64(const bf16* Q, const bf16* K, const bf16* V, bf16* O, const float* FC, int wg, int nwg) {
    const int tid = threadIdx.x, half = tid & 1;
    for (int u = wg; u < 512; u += nwg) {
        const int b = u >> 6, h = (u >> 3) & 7, blk = u & 7, t = blk * 256 + (tid >> 1); const size_t row = (size_t)b * SEQ + t;
        float q[32], o[32];
        { const v4u* qp = (const v4u*)(Q + row * DH + h * HD + half * 32);
#pragma unroll
          for (int i = 0; i < 4; ++i) { const v4u w = qp[i]; q[8 * i] = bflo(w.x); q[8 * i + 1] = bfhi(w.x); q[8 * i + 2] = bflo(w.y); q[8 * i + 3] = bfhi(w.y); q[8 * i + 4] = bflo(w.z); q[8 * i + 5] = bfhi(w.z); q[8 * i + 6] = bflo(w.w); q[8 * i + 7] = bfhi(w.w); } }
#pragma unroll
        for (int d = 0; d < 32; ++d) o[d] = 0.f;
        const int kend = blk * 256 + 256;
        const bf16* Kb = K + (size_t)b * SEQ * DH + h * HD + half * 32; const bf16* Vb = V + (size_t)b * SEQ * DH + h * HD + half * 32;
        const float* Fs = FC + (size_t)(b * NH + h) * SEQ;
        float carry = 0.f, mrun = -1e30f, lrun = 0.f;
        for (int i = 0; i < kend; ++i) {
            const int s = MODE == 0 ? kend - 1 - i : i;
            const v4u* kp = (const v4u*)(Kb + (size_t)s * DH); const v4u* vp = (const v4u*)(Vb + (size_t)s * DH);
            float z = 0.f;
#pragma unroll
            for (int c = 0; c < 4; ++c) { const v4u w = kp[c];
                z += q[8 * c] * bflo(w.x) + q[8 * c + 1] * bfhi(w.x) + q[8 * c + 2] * bflo(w.y) + q[8 * c + 3] * bfhi(w.y) + q[8 * c + 4] * bflo(w.z) + q[8 * c + 5] * bfhi(w.z) + q[8 * c + 6] * bflo(w.w) + q[8 * c + 7] * bfhi(w.w); }
            z += __shfl_xor(z, 1);
            float wgt;
            if (MODE == 0) {
                const float zn = z * LN2; const bool strict = s < t;
                const float lr = log_sigmoid_f(-zn), ls = zn + lr;
                wgt = strict ? expf(ls + carry) : 0.f; carry += strict ? lr : 0.f;
            } else {
                const float z2 = (s <= t) ? z - Fs[s] * LOG2E : -1e30f;
                const float mn = fmaxf(mrun, z2), al = exp2f(mrun - mn); wgt = (s <= t) ? exp2f(z2 - mn) : 0.f;
                lrun = lrun * al + wgt; mrun = mn;
#pragma unroll
                for (int d = 0; d < 32; ++d) o[d] *= al;
            }
#pragma unroll
            for (int c = 0; c < 4; ++c) { const v4u w = vp[c];
                o[8 * c] += wgt * bflo(w.x); o[8 * c + 1] += wgt * bfhi(w.x); o[8 * c + 2] += wgt * bflo(w.y); o[8 * c + 3] += wgt * bfhi(w.y); o[8 * c + 4] += wgt * bflo(w.z); o[8 * c + 5] += wgt * bfhi(w.z); o[8 * c + 6] += wgt * bflo(w.w); o[8 * c + 7] += wgt * bfhi(w.w); }
        }
        const float inv = MODE == 0 ? 1.0f : 1.0f / lrun;
        v4u* op = (v4u*)(O + row * DH + h * HD + half * 32);
#pragma unroll
        for (int i = 0; i < 4; ++i) { v4u w; w.x = pk2(o[8 * i] * inv, o[8 * i + 1] * inv); w.y = pk2(o[8 * i + 2] * inv, o[8 * i + 3] * inv); w.z = pk2(o[8 * i + 4] * inv, o[8 * i + 5] * inv); w.w = pk2(o[8 * i + 6] * inv, o[8 * i + 7] * inv); op[i] = w; }
    }
}
__device__ __forceinline__ void nattn_mem(Frame& F, int wg, int nwg) {
    const int tid = threadIdx.x, qt = tid & 3;
    for (int u = wg; u < 512; u += nwg) {
        const int b = u >> 6, hm = (u >> 4) & 3, blk = u & 15, t = blk * 128 + (tid >> 2); const size_t row = (size_t)b * SEQ + t;
        float q[32], o[32];
        { const v4u* qp = (const v4u*)(F.MQ + row * DH + hm * MHD + qt * 32);
#pragma unroll
          for (int i = 0; i < 4; ++i) { const v4u w = qp[i]; q[8 * i] = bflo(w.x); q[8 * i + 1] = bfhi(w.x); q[8 * i + 2] = bflo(w.y); q[8 * i + 3] = bfhi(w.y); q[8 * i + 4] = bflo(w.z); q[8 * i + 5] = bfhi(w.z); q[8 * i + 6] = bflo(w.w); q[8 * i + 7] = bfhi(w.w); } }
        float ss = 0.f;
#pragma unroll
        for (int d = 0; d < 32; ++d) ss += q[d] * q[d];
        ss += __shfl_xor(ss, 1); ss += __shfl_xor(ss, 2);
        const float rq = (1.0f / sqrtf(ss * (1.f / MHD) + EPS)) * C2M;
#pragma unroll
        for (int d = 0; d < 32; ++d) { q[d] = q[d] * rq * F.g_mq[qt * 32 + d] * F.g_mk[qt * 32 + d]; o[d] = 0.f; }
        float mrun = -1e30f, lrun = 0.f;
        for (int key = 0; key < MEMLEN; ++key) {
            const f32x4* kp = (const f32x4*)(F.MKf + (size_t)(b * MEMLEN + key) * DH + hm * MHD + qt * 32);
            const v4u* vp = (const v4u*)(F.MV + (size_t)(b * MEMLEN + key) * DH + hm * MHD + qt * 32);
            float dot = 0.f, kss = 0.f;
#pragma unroll
            for (int c = 0; c < 8; ++c) { const f32x4 k4 = kp[c]; dot += q[4 * c] * k4.x + q[4 * c + 1] * k4.y + q[4 * c + 2] * k4.z + q[4 * c + 3] * k4.w; kss += k4.x * k4.x + k4.y * k4.y + k4.z * k4.z + k4.w * k4.w; }
            dot += __shfl_xor(dot, 1); dot += __shfl_xor(dot, 2); kss += __shfl_xor(kss, 1); kss += __shfl_xor(kss, 2);
            const float z2 = dot * (1.0f / sqrtf(kss * (1.f / MHD) + EPS));
            const float mn = fmaxf(mrun, z2), al = exp2f(mrun - mn), wgt = exp2f(z2 - mn);
            lrun = lrun * al + wgt; mrun = mn;
#pragma unroll
            for (int c = 0; c < 4; ++c) { const v4u w = vp[c];
                o[8 * c] = o[8 * c] * al + wgt * bflo(w.x); o[8 * c + 1] = o[8 * c + 1] * al + wgt * bfhi(w.x); o[8 * c + 2] = o[8 * c + 2] * al + wgt * bflo(w.y); o[8 * c + 3] = o[8 * c + 3] * al + wgt * bfhi(w.y);
                o[8 * c + 4] = o[8 * c + 4] * al + wgt * bflo(w.z); o[8 * c + 5] = o[8 * c + 5] * al + wgt * bfhi(w.z); o[8 * c + 6] = o[8 * c + 6] * al + wgt * bflo(w.w); o[8 * c + 7] = o[8 * c + 7] * al + wgt * bfhi(w.w); }
        }
        const float inv = 1.0f / lrun;
        v4u* op = (v4u*)(F.MQ + row * DH + hm * MHD + qt * 32);
#pragma unroll
        for (int i = 0; i < 4; ++i) { v4u w; w.x = pk2(o[8 * i] * inv, o[8 * i + 1] * inv); w.y = pk2(o[8 * i + 2] * inv, o[8 * i + 3] * inv); w.z = pk2(o[8 * i + 4] * inv, o[8 * i + 5] * inv); w.w = pk2(o[8 * i + 6] * inv, o[8 * i + 7] * inv); op[i] = w; }
    }
}

__device__ __forceinline__ void nmerged(Frame& F, int wg, int nwg) {
    const int tid = threadIdx.x, lane = tid & 63, wid = tid >> 6, wm = wid >> 1, wn = wid & 1;
    const int tilesN = D / 128, ntiles = (M / 128) * tilesN;
    for (int t = wg; t < ntiles; t += nwg) {
        const int tm = t / tilesN, tn = t % tilesN, r0 = tm * 128 + wm * 32, c0 = tn * 128 + wn * 64;
        f32x4 tot[2][4];
#pragma unroll
        for (int m = 0; m < 2; ++m)
#pragma unroll
            for (int n = 0; n < 4; ++n) tot[m][n] = (f32x4){0.f, 0.f, 0.f, 0.f};
#pragma unroll 1
        for (int br = 0; br < 3; ++br) {
            const bf16* A = F.SBQ + (size_t)br * 3 * M * DH; const bf16* Bt = F.Wbr_t + (size_t)br * D * DH; const bf16* G = br < 2 ? F.G0 + (size_t)br * M * D : F.G2;
            f32x4 acc[2][4];
#pragma unroll
            for (int m = 0; m < 2; ++m)
#pragma unroll
                for (int n = 0; n < 4; ++n) acc[m][n] = (f32x4){0.f, 0.f, 0.f, 0.f};
            const bf16* ap = A + (size_t)(r0 + (lane & 15)) * DH + 8 * (lane >> 4);
            const bf16* bp = Bt + (size_t)(c0 + (lane & 15)) * DH + 8 * (lane >> 4);
            for (int k0 = 0; k0 < DH; k0 += 32) {
                bf16x8 a[2], b[4];
#pragma unroll
                for (int m = 0; m < 2; ++m) a[m] = *(const bf16x8*)(ap + (size_t)(m * 16) * DH + k0);
#pragma unroll
                for (int n = 0; n < 4; ++n) b[n] = *(const bf16x8*)(bp + (size_t)(n * 16) * DH + k0);
#pragma unroll
                for (int m = 0; m < 2; ++m)
#pragma unroll
                    for (int n = 0; n < 4; ++n) acc[m][n] = __builtin_amdgcn_mfma_f32_16x16x32_bf16(a[m], b[n], acc[m][n], 0, 0, 0);
            }
#pragma unroll
            for (int m = 0; m < 2; ++m)
#pragma unroll
                for (int n = 0; n < 4; ++n)
#pragma unroll
                    for (int j = 0; j < 4; ++j) tot[m][n][j] += bf2f(G[(size_t)(r0 + m * 16 + (lane >> 4) * 4 + j) * D + c0 + n * 16 + (lane & 15)]) * acc[m][n][j];
        }
#pragma unroll
        for (int m = 0; m < 2; ++m)
#pragma unroll
            for (int n = 0; n < 4; ++n)
#pragma unroll
                for (int j = 0; j < 4; ++j) F.MRG[(size_t)(r0 + m * 16 + (lane >> 4) * 4 + j) * D + c0 + n * 16 + (lane & 15)] = (bf16)f2bf(tot[m][n][j]);
    }
}
__device__ __forceinline__ void ssq_naive(Frame& F) {
    const int gw = F.vcu * NWAVES + F.wave, NGW = F.G * NWAVES;
    for (int m = gw; m < M; m += NGW) {
        const GAS f32x4* xr = (const GAS f32x4*)(F.out + (size_t)m * D) + F.lane; float s = 0.f;
#pragma unroll
        for (int j = 0; j < 4; ++j) { const f32x4 v = xr[64 * j]; s += (v.x * v.x + v.y * v.y) + (v.z * v.z + v.w * v.w); }
        s = wave_sum(s);
        if (F.lane < 16) F.ssq[(size_t)m * 16 + F.lane] = F.lane == 0 ? s : 0.f;
    }
}

constexpr int N_PHASES = 9;
#ifndef MK_N_LAUNCHES
#define MK_N_LAUNCHES 1
#endif
constexpr int N_LAUNCHES = MK_N_LAUNCHES;
struct Args { const float* in[18]; float* out; unsigned char* ws; int ph_lo, ph_hi, li, pad; };

__global__ void __launch_bounds__(NTHREADS, 2) skel_fwd(Args args) {
    extern __shared__ __attribute__((aligned(16))) unsigned char lds[];
    Frame F;
    F.lds = (LAS unsigned char*)lds;
    F.MISC = (volatile LAS unsigned*)(F.lds + MISC_OFF);
    F.tid = threadIdx.x; F.lane = F.tid & 63; F.wave = __builtin_amdgcn_readfirstlane(F.tid >> 6);
    F.G = gridDim.x; { const int bx = blockIdx.x; F.vcu = (F.G % 8 == 0) ? (bx % 8) * (F.G / 8) + bx / 8 : bx; }
    unsigned char* ws = args.ws;
    F.ctl = (gu32*)(ws + WS_CTL);
    F.x = args.in[0]; F.mem = args.in[1]; F.g_mix = args.in[2]; F.g_memn = args.in[3]; F.w_in = args.in[4]; F.b_forget = args.in[5]; F.g_fq = args.in[6]; F.g_fk = args.in[7];
    F.g_mq = args.in[8]; F.g_mk = args.in[9]; F.w_mkv = args.in[10]; F.w_bsb = args.in[11]; F.w_bfx = args.in[12]; F.w_bmm = args.in[13]; F.w_out = args.in[14]; F.g_mlp = args.in[15];
    F.w_up = args.in[16]; F.w_dn = args.in[17]; F.out = args.out;
    F.logf = (float*)(ws + WS_LOGF); F.FC = (float*)(ws + WS_FC); F.ssq = (float*)(ws + WS_SSQ); F.MKf = (float*)(ws + WS_MKF);
    F.Win_t = (bf16*)(ws + WS_WIN); F.Wmkv_t = (bf16*)(ws + WS_WMKV); F.Wbr_t = (bf16*)(ws + WS_WBR); F.Wout_t = (bf16*)(ws + WS_WOUT); F.Wup_t = (bf16*)(ws + WS_WUP); F.Wdn_t = (bf16*)(ws + WS_WDN);
    F.MHb = (bf16*)(ws + WS_MH); F.MV = (bf16*)(ws + WS_MV); F.XN = (bf16*)(ws + WS_XN);
    F.SBQ = (bf16*)(ws + WS_SBQ); F.SBK = (bf16*)(ws + WS_SBK); F.SBV = (bf16*)(ws + WS_SBV); F.FXQ = (bf16*)(ws + WS_FXQ); F.FXK = (bf16*)(ws + WS_FXK); F.FXV = (bf16*)(ws + WS_FXV); F.MQ = (bf16*)(ws + WS_MQ);
    F.G0 = (bf16*)args.out; F.G1 = (bf16*)args.out + (size_t)M * D; F.G2 = (bf16*)(ws + WS_G2); F.MRG = (bf16*)(ws + WS_MRG); F.U = (bf16*)(ws + WS_U);
    for (int u = F.tid; u < (LDS_BYTES - LDSCTL_OFF) / 4; u += NTHREADS) ((LAS unsigned*)(F.lds + LDSCTL_OFF))[u] = 0u;
    __syncthreads();
    XcdBarrier bar; bar.bar = (unsigned*)(F.ctl + CW_BAR); bar.x = 0; bar.st = nullptr;
    if (N_LAUNCHES == 1) bar = xcd_barrier_post((unsigned*)(F.ctl + CW_BAR), F.MISC + 8);
#define GRID_BAR() do { if (N_LAUNCHES == 1) xcd_barrier(bar); } while (0)
    const int lo = args.ph_lo, hi = args.ph_hi;
#define IN(k) (lo <= (k) && (k) < hi)
#define BOTH(k) (IN(k) && IN((k) + 1))
    const int wg = (int)blockIdx.x, nwg = F.G;

    if (IN(0)) { p0_prologue(F); if (BOTH(0)) GRID_BAR(); }
    if (IN(1)) {
        fcumsum(F);
        { EpiProjN E{F.SBQ, F.G0, F.G2}; ngemm(F.XN, D, F.Win_t, D, M, NPROJ, D, E, wg, nwg); }
        { EpiMkvN E{F.MKf, F.MV}; ngemm(F.MHb, D, F.Wmkv_t, D, MROWS, 1024, D, E, wg, nwg); }
        if (BOTH(1)) GRID_BAR();
    }
    if (IN(2)) { headnorm_naive(F); if (BOTH(2)) GRID_BAR(); }
    if (IN(3)) {
        nattn64<0>(F.SBQ, F.SBK, F.SBV, F.SBQ, F.FC, wg, nwg);
        nattn64<1>(F.FXQ, F.FXK, F.FXV, F.FXQ, F.FC, wg, nwg);
        nattn_mem(F, wg, nwg);
        if (BOTH(3)) GRID_BAR();
    }
    if (IN(4)) { nmerged(F, wg, nwg); if (BOTH(4)) GRID_BAR(); }
    if (IN(5)) { EpiOutN E{F.x, F.g_mlp, F.out, F.XN}; ngemm(F.MRG, D, F.Wout_t, D, M, D, D, E, wg, nwg); if (BOTH(5)) GRID_BAR(); }
    if (IN(6)) { ssq_naive(F); if (BOTH(6)) GRID_BAR(); }
    if (IN(7)) { EpiUpN E{F.ssq, F.U}; ngemm(F.XN, D, F.Wup_t, D, M, FF, D, E, wg, nwg); if (BOTH(7)) GRID_BAR(); }
    if (IN(8)) { EpiDnN E{F.out}; ngemm(F.U, FF, F.Wdn_t, FF, M, D, FF, E, wg, nwg); }
#undef IN
#undef BOTH
}

extern "C" void kernel_launch(void* const* d_in, const int* in_sizes, int n_in, void* d_out, int out_size, void* d_ws, size_t ws_size, hipStream_t stream) {
    static int grid = 0;
    if (grid == 0) {
        if (n_in != 18 || in_sizes[0] != M * D || out_size != M * D || ws_size < WS_END) { fprintf(stderr, "kernel_launch: unexpected shapes (n_in %d, in0 %d, out %d, ws %zu); nothing launched\n", n_in, n_in > 0 ? in_sizes[0] : -1, out_size, ws_size); grid = -1; return; }
        int dev = 0, cus = 0, per_cu = 0;
        if (hipGetDevice(&dev) != hipSuccess || hipDeviceGetAttribute(&cus, hipDeviceAttributeMultiprocessorCount, dev) != hipSuccess) { grid = -1; return; }
        if (hipFuncSetAttribute((const void*)skel_fwd, hipFuncAttributeMaxDynamicSharedMemorySize, LDS_BYTES) != hipSuccess) { fprintf(stderr, "kernel_launch: hipFuncSetAttribute failed\n"); grid = -1; return; }
        if (hipOccupancyMaxActiveBlocksPerMultiprocessor(&per_cu, (const void*)skel_fwd, NTHREADS, LDS_BYTES) != hipSuccess || per_cu < 1) fprintf(stderr, "kernel_launch: occupancy query reports %d\n", per_cu);
        (void)hipGetLastError();
        grid = cus;
    }
    if (grid < 0) return;
    if (hipMemsetAsync((char*)d_ws + WS_CTL, 0, CTL_ZERO_BYTES, stream) != hipSuccess) return;
    Args a{};
    for (int i = 0; i < 18; ++i) a.in[i] = (const float*)d_in[i];
    a.out = (float*)d_out; a.ws = (unsigned char*)d_ws;
    for (int li = 0; li < N_LAUNCHES; ++li) {
        a.ph_lo = (N_LAUNCHES == 1) ? 0 : li; a.ph_hi = (N_LAUNCHES == 1) ? N_PHASES : li + 1; a.li = li;
        hipLaunchKernelGGL(skel_fwd, dim3(grid), dim3(NTHREADS), LDS_BYTES, stream, a);
        if (hipPeekAtLastError() != hipSuccess) break;
    }
}
```

```cpp
#include <hip/hip_runtime.h>
#include <cstdio>
#include <cstdint>

#define GAS __attribute__((address_space(1)))
#define LAS __attribute__((address_space(3)))
typedef unsigned short bf16;
typedef short bf16x8 __attribute__((ext_vector_type(8)));
typedef float f32x4 __attribute__((ext_vector_type(4)));
typedef unsigned v4u __attribute__((ext_vector_type(4)));
typedef GAS unsigned gu32;
#define RLX_AGENT __ATOMIC_RELAXED, __HIP_MEMORY_SCOPE_AGENT
#define LDS_WAIT() asm volatile("s_waitcnt lgkmcnt(0)" ::: "memory")
#define VM_WAIT() asm volatile("s_waitcnt vmcnt(0)" ::: "memory")

constexpr int NWAVES = 8, NTHREADS = 512;
constexpr int BATCH = 8, SEQ = 2048, M = BATCH * SEQ, D = 1024, MEMLEN = 256, MROWS = BATCH * MEMLEN;
constexpr int HD = 64, NH = 8, MNH = 4, MHD = 128, DH = 512, FF = 4096;
constexpr int DIN = 6664, NPROJ = 6656;
constexpr float EPS = 1e-6f, LOG2E = 1.4426950408889634f, LN2 = 0.6931471805599453f;
constexpr float C2 = 0.125f * LOG2E;
constexpr float C2M = 0.08838834764831845f * LOG2E;

constexpr size_t MiB = 1u << 20;
constexpr size_t WS_CTL = 0, CTL_ZERO_BYTES = 65536;
constexpr size_t WS_LOGF = 1 * MiB, WS_FC = 1 * MiB + 512 * 1024, WS_SSQ = 2 * MiB;
constexpr size_t WS_WIN = 3 * MiB, WS_WMKV = 16 * MiB, WS_WBR = 18 * MiB, WS_WOUT = 21 * MiB, WS_WUP = 23 * MiB, WS_WDN = 31 * MiB;
constexpr size_t WS_MV = 39 * MiB, WS_XN = 44 * MiB, WS_MH = 76 * MiB;
constexpr size_t WS_T1 = 96 * MiB, WS_T2 = 144 * MiB;
constexpr size_t WS_SBQ = 80 * MiB, WS_SBK = 96 * MiB, WS_SBV = 112 * MiB, WS_FXQ = 128 * MiB, WS_FXK = 144 * MiB, WS_FXV = 160 * MiB, WS_MQ = 176 * MiB;
constexpr size_t WS_G2 = 192 * MiB, WS_MRG = 224 * MiB, WS_MKF = 224 * MiB, WS_U = 80 * MiB, WS_END = 256 * MiB;
constexpr int CW_BAR = 4096;

constexpr int RING_BYTES = 131072, LDSCTL_OFF = RING_BYTES, MISC_OFF = LDSCTL_OFF + 320, LDS_BYTES = 147456;

__device__ __forceinline__ unsigned f2bf(float f) { unsigned u = __builtin_bit_cast(unsigned, f); return (u + 0x7fffu + ((u >> 16) & 1u)) >> 16; }
__device__ __forceinline__ unsigned pk2(float lo, float hi) { return f2bf(lo) | (f2bf(hi) << 16); }
__device__ __forceinline__ float bf2f(unsigned b) { return __uint_as_float(b << 16); }
__device__ __forceinline__ float bflo(unsigned w) { return __uint_as_float(w << 16); }
__device__ __forceinline__ float bfhi(unsigned w) { return __uint_as_float(w & 0xffff0000u); }
__device__ __forceinline__ float wave_sum(float v) {
#pragma unroll
    for (int o = 1; o < 64; o <<= 1) v += __shfl_xor(v, o);
    return v;
}
__device__ __forceinline__ float log_sigmoid_f(float x) { return fminf(x, 0.f) - log1pf(expf(-fabsf(x))); }

#define XB_TMO      128
#define XB_XCNT(j)  (256  + 64 * (j))
#define XB_XSUB(j)  (1280 + 64 * (j))
#define XB_XGEN(j)  (2304 + 64 * (j))
#define XB_TOP      3328
#define XB_TOPGEN   3392
#define XCD_BAR_WORDS 3456
#define XB_SPIN_CAP (1u << 18)
__device__ __forceinline__ unsigned xb_ld(unsigned* p)              { return __hip_atomic_load(p, __ATOMIC_RELAXED, __HIP_MEMORY_SCOPE_AGENT); }
__device__ __forceinline__ unsigned xb_add(unsigned* p, unsigned v) { return __hip_atomic_fetch_add(p, v, __ATOMIC_RELAXED, __HIP_MEMORY_SCOPE_AGENT); }
__device__ __forceinline__ unsigned xb_xcc_id() { return (unsigned)__builtin_amdgcn_s_getreg((3 << 11) | 20) & 0xFu; }
#define XB_SPIN(cond, bar) do { unsigned _sp = 0; while (cond) { __builtin_amdgcn_s_sleep(1); \
    if ((++_sp & 255u) == 0u) { if (xb_ld(&(bar)[XB_TMO])) break; if (_sp > XB_SPIN_CAP) { atomicAdd(&(bar)[XB_TMO], 1u); break; } } } } while (0)
struct XcdBarrier { unsigned* bar; unsigned x; volatile LAS unsigned* st; };
__device__ __forceinline__ XcdBarrier xcd_barrier_post(unsigned* bar, volatile LAS unsigned* st) {
    XcdBarrier b; b.bar = bar; b.x = xb_xcc_id(); b.st = st;
    if (threadIdx.x == 0) (void)xb_add(&bar[XB_XCNT(b.x)], 1u);
    return b;
}
__device__ __forceinline__ void xcd_barrier_complete(unsigned* bar, unsigned x, unsigned& nloc, unsigned& nx) {
    const unsigned G = gridDim.x * gridDim.y * gridDim.z;
    unsigned sum, cnt, mine, sp = 0u;
    for (;;) {
        sum = 0u; cnt = 0u; mine = 0u;
#pragma unroll
        for (unsigned j = 0; j < 16; ++j) { const unsigned c = xb_ld(&bar[XB_XCNT(j)]); sum += c; cnt += (c > 0u) ? 1u : 0u; mine = (j == x) ? c : mine; }
        if (sum == G) break;
        __builtin_amdgcn_s_sleep(1);
        if ((++sp & 255u) == 0u) { if (xb_ld(&bar[XB_TMO])) break; if (sp > XB_SPIN_CAP) { atomicAdd(&bar[XB_TMO], 1u); break; } }
    }
    nloc = mine > 0u ? mine : 1u; nx = cnt > 0u ? cnt : 1u;
}
__device__ __forceinline__ void xcd_barrier(const XcdBarrier& b) {
    asm volatile("s_waitcnt vmcnt(0)" ::: "memory");
    __syncthreads();
    if (threadIdx.x == 0) {
        unsigned* bar = b.bar;
        __builtin_amdgcn_s_waitcnt(0);
        unsigned nloc = b.st[0], nx = b.st[1];
        if (nloc == 0u) { xcd_barrier_complete(bar, b.x, nloc, nx); b.st[0] = nloc; b.st[1] = nx; }
        const unsigned old = xb_add(&bar[XB_XSUB(b.x)], 1u);
        const unsigned gen = old / nloc;
        if (old + 1u == (gen + 1u) * nloc) {
            __builtin_amdgcn_fence(__ATOMIC_RELEASE, "agent");
            asm volatile("s_waitcnt vmcnt(0)" ::: "memory");
            const unsigned og = xb_add(&bar[XB_TOP], 1u);
            const unsigned tg = og / nx;
            if (og + 1u == (tg + 1u) * nx) xb_add(&bar[XB_TOPGEN], 1u);
            else XB_SPIN(xb_ld(&bar[XB_TOPGEN]) == tg, bar);
            __builtin_amdgcn_fence(__ATOMIC_ACQUIRE, "agent");
            xb_add(&bar[XB_XGEN(b.x)], 1u);
            asm volatile("s_waitcnt vmcnt(0)" ::: "memory");
        } else {
            XB_SPIN(xb_ld(&bar[XB_XGEN(b.x)]) == gen, bar);
            __builtin_amdgcn_fence(__ATOMIC_ACQUIRE, "agent");
            asm volatile("s_waitcnt vmcnt(0)" ::: "memory");
        }
    }
    __syncthreads();
}

struct Frame {
    LAS unsigned char* lds;
    volatile LAS unsigned* MISC;
    gu32* ctl;
    int tid, lane, wave, vcu, G;
    const float *x, *mem, *g_mix, *g_memn, *w_in, *b_forget, *g_fq, *g_fk, *g_mq, *g_mk, *w_mkv, *w_bsb, *w_bfx, *w_bmm, *w_out, *g_mlp, *w_up, *w_dn;
    float* out;
    float *logf, *FC, *ssq, *MKf;
    bf16 *Win_t, *Wmkv_t, *Wbr_t, *Wout_t, *Wup_t, *Wdn_t, *MHb, *MV, *XN, *SBQ, *SBK, *SBV, *FXQ, *FXK, *FXV, *MQ, *G0, *G1, *G2, *MRG, *U;
};

__device__ __forceinline__ void tr_item(const float* W, int ldw, int K, bf16* WT, int src_c0, int dst_r0, int k0, LAS float* scr, int lane, const float* kgain = nullptr) {
#pragma unroll 8
    for (int i = 0; i < 32; ++i) { const int kk = 2 * i + (lane >> 5); float w = W[(size_t)(k0 + kk) * ldw + src_c0 + (lane & 31)]; if (kgain) w *= kgain[k0 + kk]; scr[kk * 33 + (lane & 31)] = w; }
    LDS_WAIT(); asm volatile("" ::: "memory");
    const int c = lane & 7;
#pragma unroll
    for (int j = 0; j < 4; ++j) { const int n = (lane >> 3) + 8 * j; const LAS float* s = scr + (8 * c) * 33 + n;
        v4u o; o.x = pk2(s[0 * 33], s[1 * 33]); o.y = pk2(s[2 * 33], s[3 * 33]); o.z = pk2(s[4 * 33], s[5 * 33]); o.w = pk2(s[6 * 33], s[7 * 33]);
        *(GAS v4u*)(WT + (size_t)(dst_r0 + n) * K + k0 + 8 * c) = o; }
    LDS_WAIT(); asm volatile("" ::: "memory");
}
__host__ __device__ __forceinline__ int proj_src_col(int n) {
    const int pn = n >> 8, j = n & 255;
    if (pn < 12) { const int T = pn >> 1, bj = j >> 7, wc = (j >> 5) & 3, e = j & 31; return T * 512 + ((pn & 1) * 4 + wc) * 64 + bj * 32 + e; }
    if (pn < 14) return 3080 + (n - 12 * 256);
    return 3592 + (n - 14 * 256);
}
template <bool IS_X>
__device__ __forceinline__ void p0_rows(Frame& F, const float* srcb, const float* g, bf16* dstb, int nrows, LAS float* wf, int gw, int NGW) {
    const GAS f32x4* gr = (const GAS f32x4*)g + F.lane;
    for (int m = gw; m < nrows; m += NGW) {
        const GAS f32x4* xr = (const GAS f32x4*)(srcb + (size_t)m * D) + F.lane;
        f32x4 v[4]; float s = 0.f;
#pragma unroll
        for (int j = 0; j < 4; ++j) { v[j] = xr[64 * j]; s += (v[j].x * v[j].x + v[j].y * v[j].y) + (v[j].z * v[j].z + v[j].w * v[j].w); }
        const float rstd = 1.0f / sqrtf(wave_sum(s) * (1.f / D) + EPS);
#pragma unroll
        for (int j = 0; j < 4; ++j) { const f32x4 gg = gr[64 * j]; v[j] = v[j] * rstd * gg; }
        GAS unsigned long long* o8 = (GAS unsigned long long*)(dstb + (size_t)m * D) + F.lane;
#pragma unroll
        for (int j = 0; j < 4; ++j) o8[64 * j] = (unsigned long long)pk2(v[j].x, v[j].y) | ((unsigned long long)pk2(v[j].z, v[j].w) << 32);
        if (IS_X) {
            float fl[8];
#pragma unroll
            for (int c = 0; c < 8; ++c) fl[c] = 0.f;
#pragma unroll
            for (int j = 0; j < 4; ++j)
#pragma unroll
                for (int e = 0; e < 4; ++e) { const int d = 256 * j + 4 * F.lane + e; const float hv = v[j][e];
                    const f32x4 w0 = *(const LAS f32x4*)(wf + d * 8), w1 = *(const LAS f32x4*)(wf + d * 8 + 4);
                    fl[0] += hv * w0.x; fl[1] += hv * w0.y; fl[2] += hv * w0.z; fl[3] += hv * w0.w; fl[4] += hv * w1.x; fl[5] += hv * w1.y; fl[6] += hv * w1.z; fl[7] += hv * w1.w; }
            float mine = 0.f;
#pragma unroll
            for (int c = 0; c < 8; ++c) { const float t = wave_sum(fl[c]); if (F.lane == c) mine = t; }
            if (F.lane < 8) F.logf[(size_t)m * 8 + F.lane] = log_sigmoid_f(mine + F.b_forget[F.lane]);
        }
    }
}
__device__ __forceinline__ void p0_prologue(Frame& F) {
    LAS float* scr = (LAS float*)(F.lds + F.wave * 8448);
    LAS float* wf = (LAS float*)(F.lds + 8 * 8448);
    for (int i = F.tid; i < D * 8; i += NTHREADS) wf[i] = F.w_in[(size_t)(i >> 3) * DIN + 3072 + (i & 7)];
    const int gw = F.vcu * NWAVES + F.wave, NGW = F.G * NWAVES;
    constexpr int I_IN = 16 * 208, I_MKV = 16 * 32, I_BR = 8 * 32, I_OUT = 16 * 32, I_UP = 16 * 128, I_DN = 64 * 32;
    constexpr int NITEMS = I_IN + I_MKV + 3 * I_BR + I_OUT + I_UP + I_DN;
    for (int it = gw; it < NITEMS; it += NGW) {
        int r = it;
        if (r < I_IN) { const int kb = r / 208, gi = r % 208; tr_item(F.w_in, DIN, D, F.Win_t, proj_src_col(32 * gi), 32 * gi, 64 * kb, scr, F.lane); continue; } r -= I_IN;
        if (r < I_MKV) { const int kb = r / 32, gi = r % 32; tr_item(F.w_mkv, 1024, D, F.Wmkv_t, 32 * gi, 32 * gi, 64 * kb, scr, F.lane); continue; } r -= I_MKV;
        if (r < I_BR) { const int kb = r / 32, gi = r % 32; tr_item(F.w_bsb, D, DH, F.Wbr_t, 32 * gi, 32 * gi, 64 * kb, scr, F.lane); continue; } r -= I_BR;
        if (r < I_BR) { const int kb = r / 32, gi = r % 32; tr_item(F.w_bfx, D, DH, F.Wbr_t + (size_t)D * DH, 32 * gi, 32 * gi, 64 * kb, scr, F.lane); continue; } r -= I_BR;
        if (r < I_BR) { const int kb = r / 32, gi = r % 32; tr_item(F.w_bmm, D, DH, F.Wbr_t + (size_t)2 * D * DH, 32 * gi, 32 * gi, 64 * kb, scr, F.lane); continue; } r -= I_BR;
        if (r < I_OUT) { const int kb = r / 32, gi = r % 32; tr_item(F.w_out, D, D, F.Wout_t, 32 * gi, 32 * gi, 64 * kb, scr, F.lane); continue; } r -= I_OUT;
        if (r < I_UP) { const int kb = r / 128, gi = r % 128; tr_item(F.w_up, FF, D, F.Wup_t, 32 * gi, 32 * gi, 64 * kb, scr, F.lane, F.g_mlp); continue; } r -= I_UP;
        { const int kb = r / 32, gi = r % 32; tr_item(F.w_dn, D, FF, F.Wdn_t, 32 * gi, 32 * gi, 64 * kb, scr, F.lane); }
    }
    __syncthreads();
    p0_rows<true>(F, F.x, F.g_mix, F.XN, M, wf, gw, NGW);
    p0_rows<false>(F, F.mem, F.g_memn, F.MHb, MROWS, wf, gw, NGW);
}

template <class Epi>
__device__ __forceinline__ void ngemm(const bf16* A, int lda, const bf16* Bt, int ldb, int Mr, int Nc, int K, const Epi& E, int wg, int nwg) {
    const int tid = threadIdx.x, lane = tid & 63, wid = tid >> 6, wm = wid >> 1, wn = wid & 1;
    const int tilesN = Nc / 128, ntiles = (Mr / 128) * tilesN;
    for (int t = wg; t < ntiles; t += nwg) {
        const int tm = t / tilesN, tn = t % tilesN, r0 = tm * 128 + wm * 32, c0 = tn * 128 + wn * 64;
        f32x4 acc[2][4];
#pragma unroll
        for (int m = 0; m < 2; ++m)
#pragma unroll
            for (int n = 0; n < 4; ++n) acc[m][n] = (f32x4){0.f, 0.f, 0.f, 0.f};
        const bf16* ap = A + (size_t)(r0 + (lane & 15)) * lda + 8 * (lane >> 4);
        const bf16* bp = Bt + (size_t)(c0 + (lane & 15)) * ldb + 8 * (lane >> 4);
        for (int k0 = 0; k0 < K; k0 += 32) {
            bf16x8 a[2], b[4];
#pragma unroll
            for (int m = 0; m < 2; ++m) a[m] = *(const bf16x8*)(ap + (size_t)(m * 16) * lda + k0);
#pragma unroll
            for (int n = 0; n < 4; ++n) b[n] = *(const bf16x8*)(bp + (size_t)(n * 16) * ldb + k0);
#pragma unroll
            for (int m = 0; m < 2; ++m)
#pragma unroll
                for (int n = 0; n < 4; ++n) acc[m][n] = __builtin_amdgcn_mfma_f32_16x16x32_bf16(a[m], b[n], acc[m][n], 0, 0, 0);
        }
#pragma unroll
        for (int m = 0; m < 2; ++m)
#pragma unroll
            for (int n = 0; n < 4; ++n)
#pragma unroll
                for (int j = 0; j < 4; ++j) E(r0 + m * 16 + (lane >> 4) * 4 + j, c0 + n * 16 + (lane & 15), acc[m][n][j]);
    }
}

struct EpiProjN {
    bf16 *SBQ, *G0, *G2;
    __device__ __forceinline__ void operator()(int row, int n, float v) const {
        const int pn = n >> 8, j = n & 255;
        if (pn < 12) { const int T = pn >> 1, bj = j >> 7, wc = (j >> 5) & 3, e = j & 31, c = ((pn & 1) * 4 + wc) * 64 + bj * 32 + e;
            if (T == 0) v *= C2;
            (SBQ + (size_t)T * M * DH)[(size_t)row * DH + c] = (bf16)f2bf(v); }
        else if (pn < 14) { (SBQ + (size_t)6 * M * DH)[(size_t)row * DH + (n - 12 * 256)] = (bf16)f2bf(v); }
        else { const int g = (pn - 14) >> 2, c = n - (14 + 4 * g) * 256; bf16* G = g < 2 ? G0 + (size_t)g * M * D : G2;
            G[(size_t)row * D + c] = (bf16)f2bf(1.0f / (1.0f + expf(-v))); }
    }
};
struct EpiMkvN { float* MKf; bf16* MV;
    __device__ __forceinline__ void operator()(int row, int n, float v) const { if (n < DH) MKf[(size_t)row * DH + n] = v; else MV[(size_t)row * DH + (n - DH)] = (bf16)f2bf(v); } };
struct EpiOutN { const float* x; float* x1; bf16* A2;
    __device__ __forceinline__ void operator()(int row, int n, float v) const { const size_t o = (size_t)row * D + n; const float r = x[o] + v; x1[o] = r; A2[o] = (bf16)f2bf(r); } };
struct EpiUpN { const float* ssq; bf16* U;
    __device__ __forceinline__ void operator()(int row, int n, float v) const {
        const f32x4* p = (const f32x4*)(ssq + (size_t)row * 16); const f32x4 a = p[0], b = p[1], c = p[2], d = p[3];
        const float ss = ((a.x + a.y) + (a.z + a.w)) + ((b.x + b.y) + (b.z + b.w)) + ((c.x + c.y) + (c.z + c.w)) + ((d.x + d.y) + (d.z + d.w));
        (void)ss; const float r = fmaxf(v, 0.f); U[(size_t)row * FF + n] = (bf16)f2bf(r * r); } };
struct EpiDnN { float* out; const float* ssq;
    __device__ __forceinline__ void operator()(int row, int n, float v) const { const size_t o = (size_t)row * D + n;
        const f32x4* p = (const f32x4*)(ssq + (size_t)row * 16); const f32x4 a = p[0], b = p[1], c = p[2], d = p[3];
        const float ss = ((a.x + a.y) + (a.z + a.w)) + ((b.x + b.y) + (b.z + b.w)) + ((c.x + c.y) + (c.z + c.w)) + ((d.x + d.y) + (d.z + d.w));
        out[o] = out[o] + v / (ss * (1.f / D) + EPS); } };

__device__ __forceinline__ void fcumsum(Frame& F) {
    const int gw = F.vcu * NWAVES + F.wave;
    if (gw >= BATCH * NH) return;
    const int b = gw >> 3, h = gw & 7;
    const float* src = F.logf + ((size_t)b * SEQ + 32 * F.lane) * 8 + h;
    float tot = 0.f;
    for (int i = 0; i < 32; ++i) tot += src[i * 8];
    float incl = tot;
#pragma unroll
    for (int off = 1; off < 64; off <<= 1) { const float y = __shfl_up(incl, off); if (F.lane >= off) incl += y; }
    float run = incl - tot;
    float* dst = F.FC + (size_t)gw * SEQ + 32 * F.lane;
    for (int i = 0; i < 32; ++i) { run += src[i * 8]; dst[i] = run; }
}

__device__ __forceinline__ void headnorm_naive(Frame& F) {
    const int gw = F.vcu * NWAVES + F.wave, NGW = F.G * NWAVES;
    for (int it = gw; it < 2 * M; it += NGW) {
        const int which = it / M, row = it % M;
        bf16* p = F.FXQ + (size_t)which * M * DH + (size_t)row * DH + 8 * F.lane;
        const v4u w = *(const v4u*)p; float v[8] = {bflo(w.x), bfhi(w.x), bflo(w.y), bfhi(w.y), bflo(w.z), bfhi(w.z), bflo(w.w), bfhi(w.w)};
        float s = 0.f;
#pragma unroll
        for (int i = 0; i < 8; ++i) s += v[i] * v[i];
        s += __shfl_xor(s, 1); s += __shfl_xor(s, 2); s += __shfl_xor(s, 4);
        const float sc = (1.0f / sqrtf(s * (1.f / HD) + EPS)) * (which == 0 ? C2 : 1.0f);
#pragma unroll
        for (int i = 0; i < 8; ++i) v[i] = v[i] * sc;
        v4u o; o.x = pk2(v[0], v[1]); o.y = pk2(v[2], v[3]); o.z = pk2(v[4], v[5]); o.w = pk2(v[6], v[7]);
        *(v4u*)p = o;
    }
}

template <int MODE>
__device__ __forceinline__ void nattn64(const bf16* Q, const bf16* K, const bf16* V, bf16* O, const float* FC, const float* gq, const float* gk, int wg, int nwg) {
    const int tid = threadIdx.x, half = tid & 1;
    for (int u = wg; u < 512; u += nwg) {
        const int b = u >> 6, h = (u >> 3) & 7, blk = u & 7, t = blk * 256 + (tid >> 1); const size_t row = (size_t)b * SEQ + t;
        float q[32], o[32];
        { const v4u* qp = (const v4u*)(Q + row * DH + h * HD + half * 32);
#pragma unroll
          for (int i = 0; i < 4; ++i) { const v4u w = qp[i]; q[8 * i] = bflo(w.x); q[8 * i + 1] = bfhi(w.x); q[8 * i + 2] = bflo(w.y); q[8 * i + 3] = bfhi(w.y); q[8 * i + 4] = bflo(w.z); q[8 * i + 5] = bfhi(w.z); q[8 * i + 6] = bflo(w.w); q[8 * i + 7] = bfhi(w.w); } }
        if (MODE == 1) {
#pragma unroll
            for (int d = 0; d < 32; ++d) q[d] *= gq[half * 32 + d] * gk[half * 32 + d]; }
#pragma unroll
        for (int d = 0; d < 32; ++d) o[d] = 0.f;
        const int kend = blk * 256 + 256;
        const bf16* Kb = K + (size_t)b * SEQ * DH + h * HD + half * 32; const bf16* Vb = V + (size_t)b * SEQ * DH + h * HD + half * 32;
        const float* Fs = FC + (size_t)(b * NH + h) * SEQ;
        float carry = 0.f, mrun = -1e30f, lrun = 0.f;
        for (int i = 0; i < kend; ++i) {
            const int s = MODE == 0 ? kend - 1 - i : i;
            const v4u* kp = (const v4u*)(Kb + (size_t)s * DH); const v4u* vp = (const v4u*)(Vb + (size_t)s * DH);
            float z = 0.f;
#pragma unroll
            for (int c = 0; c < 4; ++c) { const v4u w = kp[c];
                z += q[8 * c] * bflo(w.x) + q[8 * c + 1] * bfhi(w.x) + q[8 * c + 2] * bflo(w.y) + q[8 * c + 3] * bfhi(w.y) + q[8 * c + 4] * bflo(w.z) + q[8 * c + 5] * bfhi(w.z) + q[8 * c + 6] * bflo(w.w) + q[8 * c + 7] * bfhi(w.w); }
            z += __shfl_xor(z, 1);
            float wgt;
            if (MODE == 0) {
                const float zn = z * LN2; const bool strict = s < t;
                const float lr = log_sigmoid_f(-zn), ls = zn + lr;
                wgt = strict ? expf(ls + carry) : 0.f; carry += strict ? lr : 0.f;
            } else {
                const float z2 = (s <= t) ? z - Fs[s] * LOG2E : -1e30f;
                const float mn = fmaxf(mrun, z2), al = exp2f(mrun - mn); wgt = (s <= t) ? exp2f(z2 - mn) : 0.f;
                lrun = lrun * al + wgt; mrun = mn;
#pragma unroll
                for (int d = 0; d < 32; ++d) o[d] *= al;
            }
#pragma unroll
            for (int c = 0; c < 4; ++c) { const v4u w = vp[c];
                o[8 * c] += wgt * bflo(w.x); o[8 * c + 1] += wgt * bfhi(w.x); o[8 * c + 2] += wgt * bflo(w.y); o[8 * c + 3] += wgt * bfhi(w.y); o[8 * c + 4] += wgt * bflo(w.z); o[8 * c + 5] += wgt * bfhi(w.z); o[8 * c + 6] += wgt * bflo(w.w); o[8 * c + 7] += wgt * bfhi(w.w); }
        }
        const float inv = MODE == 0 ? 1.0f : 1.0f / lrun;
        v4u* op = (v4u*)(O + row * DH + h * HD + half * 32);
#pragma unroll
        for (int i = 0; i < 4; ++i) { v4u w; w.x = pk2(o[8 * i] * inv, o[8 * i + 1] * inv); w.y = pk2(o[8 * i + 2] * inv, o[8 * i + 3] * inv); w.z = pk2(o[8 * i + 4] * inv, o[8 * i + 5] * inv); w.w = pk2(o[8 * i + 6] * inv, o[8 * i + 7] * inv); op[i] = w; }
    }
}
__device__ __forceinline__ void nattn_mem(Frame& F, int wg, int nwg) {
    const int tid = threadIdx.x, qt = tid & 3;
    for (int u = wg; u < 512; u += nwg) {
        const int b = u >> 6, hm = (u >> 4) & 3, blk = u & 15, t = blk * 128 + (tid >> 2); const size_t row = (size_t)b * SEQ + t;
        float q[32], o[32];
        { const v4u* qp = (const v4u*)(F.MQ + row * DH + hm * MHD + qt * 32);
#pragma unroll
          for (int i = 0; i < 4; ++i) { const v4u w = qp[i]; q[8 * i] = bflo(w.x); q[8 * i + 1] = bfhi(w.x); q[8 * i + 2] = bflo(w.y); q[8 * i + 3] = bfhi(w.y); q[8 * i + 4] = bflo(w.z); q[8 * i + 5] = bfhi(w.z); q[8 * i + 6] = bflo(w.w); q[8 * i + 7] = bfhi(w.w); } }
        float ss = 0.f;
#pragma unroll
        for (int d = 0; d < 32; ++d) ss += q[d] * q[d];
        ss += __shfl_xor(ss, 1); ss += __shfl_xor(ss, 2);
        const float rq = (1.0f / sqrtf(ss * (1.f / MHD) + EPS)) * C2M;
#pragma unroll
        for (int d = 0; d < 32; ++d) { q[d] = q[d] * rq * F.g_mq[qt * 32 + d] * F.g_mk[qt * 32 + d]; o[d] = 0.f; }
        float mrun = -1e30f, lrun = 0.f;
        for (int key = 0; key < MEMLEN; ++key) {
            const f32x4* kp = (const f32x4*)(F.MKf + (size_t)(b * MEMLEN + key) * DH + hm * MHD + qt * 32);
            const v4u* vp = (const v4u*)(F.MV + (size_t)(b * MEMLEN + key) * DH + hm * MHD + qt * 32);
            float dot = 0.f, kss = 0.f;
#pragma unroll
            for (int c = 0; c < 8; ++c) { const f32x4 k4 = kp[c]; dot += q[4 * c] * k4.x + q[4 * c + 1] * k4.y + q[4 * c + 2] * k4.z + q[4 * c + 3] * k4.w; kss += k4.x * k4.x + k4.y * k4.y + k4.z * k4.z + k4.w * k4.w; }
            dot += __shfl_xor(dot, 1); dot += __shfl_xor(dot, 2); kss += __shfl_xor(kss, 1); kss += __shfl_xor(kss, 2);
            const float z2 = dot * (1.0f / sqrtf(kss * (1.f / MHD) + EPS));
            const float mn = fmaxf(mrun, z2), al = exp2f(mrun - mn), wgt = exp2f(z2 - mn);
            lrun = lrun * al + wgt; mrun = mn;
#pragma unroll
            for (int c = 0; c < 4; ++c) { const v4u w = vp[c];
                o[8 * c] = o[8 * c] * al + wgt * bflo(w.x); o[8 * c + 1] = o[8 * c + 1] * al + wgt * bfhi(w.x); o[8 * c + 2] = o[8 * c + 2] * al + wgt * bflo(w.y); o[8 * c + 3] = o[8 * c + 3] * al + wgt * bfhi(w.y);
                o[8 * c + 4] = o[8 * c + 4] * al + wgt * bflo(w.z); o[8 * c + 5] = o[8 * c + 5] * al + wgt * bfhi(w.z); o[8 * c + 6] = o[8 * c + 6] * al + wgt * bflo(w.w); o[8 * c + 7] = o[8 * c + 7] * al + wgt * bfhi(w.w); }
        }
        const float inv = 1.0f / lrun;
        v4u* op = (v4u*)(F.MQ + row * DH + hm * MHD + qt * 32);
#pragma unroll
        for (int i = 0; i < 4; ++i) { v4u w; w.x = pk2(o[8 * i] * inv, o[8 * i + 1] * inv); w.y = pk2(o[8 * i + 2] * inv, o[8 * i + 3] * inv); w.z = pk2(o[8 * i + 4] * inv, o[8 * i + 5] * inv); w.w = pk2(o[8 * i + 6] * inv, o[8 * i + 7] * inv); op[i] = w; }
    }
}

__device__ __forceinline__ void nmerged(Frame& F, int wg, int nwg) {
    const int tid = threadIdx.x, lane = tid & 63, wid = tid >> 6, wm = wid >> 1, wn = wid & 1;
    const int tilesN = D / 128, ntiles = (M / 128) * tilesN;
    for (int t = wg; t < ntiles; t += nwg) {
        const int tm = t / tilesN, tn = t % tilesN, r0 = tm * 128 + wm * 32, c0 = tn * 128 + wn * 64;
        f32x4 tot[2][4];
#pragma unroll
        for (int m = 0; m < 2; ++m)
#pragma unroll
            for (int n = 0; n < 4; ++n) tot[m][n] = (f32x4){0.f, 0.f, 0.f, 0.f};
#pragma unroll 1
        for (int br = 0; br < 3; ++br) {
            const bf16* A = F.SBQ + (size_t)br * 3 * M * DH; const bf16* Bt = F.Wbr_t + (size_t)br * D * DH; const bf16* G = br < 2 ? F.G0 + (size_t)br * M * D : F.G2;
            f32x4 acc[2][4];
#pragma unroll
            for (int m = 0; m < 2; ++m)
#pragma unroll
                for (int n = 0; n < 4; ++n) acc[m][n] = (f32x4){0.f, 0.f, 0.f, 0.f};
            const bf16* ap = A + (size_t)(r0 + (lane & 15)) * DH + 8 * (lane >> 4);
            const bf16* bp = Bt + (size_t)(c0 + (lane & 15)) * DH + 8 * (lane >> 4);
            for (int k0 = 0; k0 < DH; k0 += 32) {
                bf16x8 a[2], b[4];
#pragma unroll
                for (int m = 0; m < 2; ++m) a[m] = *(const bf16x8*)(ap + (size_t)(m * 16) * DH + k0);
#pragma unroll
                for (int n = 0; n < 4; ++n) b[n] = *(const bf16x8*)(bp + (size_t)(n * 16) * DH + k0);
#pragma unroll
                for (int m = 0; m < 2; ++m)
#pragma unroll
                    for (int n = 0; n < 4; ++n) acc[m][n] = __builtin_amdgcn_mfma_f32_16x16x32_bf16(a[m], b[n], acc[m][n], 0, 0, 0);
            }
#pragma unroll
            for (int m = 0; m < 2; ++m)
#pragma unroll
                for (int n = 0; n < 4; ++n)
#pragma unroll
                    for (int j = 0; j < 4; ++j) tot[m][n][j] += bf2f(G[(size_t)(r0 + m * 16 + (lane >> 4) * 4 + j) * D + c0 + n * 16 + (lane & 15)]) * acc[m][n][j];
        }
#pragma unroll
        for (int m = 0; m < 2; ++m)
#pragma unroll
            for (int n = 0; n < 4; ++n)
#pragma unroll
                for (int j = 0; j < 4; ++j) F.MRG[(size_t)(r0 + m * 16 + (lane >> 4) * 4 + j) * D + c0 + n * 16 + (lane & 15)] = (bf16)f2bf(tot[m][n][j]);
    }
}
__device__ __forceinline__ void ssq_naive(Frame& F) {
    const int gw = F.vcu * NWAVES + F.wave, NGW = F.G * NWAVES;
    for (int m = gw; m < M; m += NGW) {
        const GAS f32x4* xr = (const GAS f32x4*)(F.out + (size_t)m * D) + F.lane; float s = 0.f;
#pragma unroll
        for (int j = 0; j < 4; ++j) { const f32x4 v = xr[64 * j]; s += (v.x * v.x + v.y * v.y) + (v.z * v.z + v.w * v.w); }
        s = wave_sum(s);
        if (F.lane < 16) F.ssq[(size_t)m * 16 + F.lane] = F.lane == 0 ? s : 0.f;

    }
}

namespace pg8 {
#define PG8_LAS __attribute__((address_space(3)))
typedef unsigned short bf16_t;
typedef unsigned u32x4 __attribute__((ext_vector_type(4)));
typedef unsigned u32x2 __attribute__((ext_vector_type(2)));
constexpr int BM = 256, BK = 64, HALF = 128, HTB = HALF * BK * 2, STAGE_BYTES = 8 * HTB, NXCD = 8, WGM = 8;
__host__ __device__ __forceinline__ int lds_byte(int r, int c) { const int st = (r >> 4) * 2 + (c >> 5), rr = r & 15, cc = c & 31, ob = rr * 64 + cc * 2; return st * 1024 + (ob ^ (((ob >> 9) & 1) << 5)); }
__host__ __device__ __forceinline__ void stage_rc(int b, int& R, int& C) { const int st = b / 1024, sb = b % 1024, swz = sb ^ (((sb >> 9) & 1) << 5); R = (st >> 1) * 16 + swz / 64; C = (st & 1) * 32 + (swz % 64) / 2; }
__host__ __device__ __forceinline__ int perm32(int rho) { const int n = rho >> 4, i = rho & 15; return 8 * (i >> 2) + 4 * n + (i & 3); }
struct Unit { int pm, pn, br; };
__device__ __forceinline__ unsigned cvt_pk_bf16(float lo, float hi) { unsigned r; asm volatile("v_cvt_pk_bf16_f32 %0, %1, %2" : "=v"(r) : "v"(lo), "v"(hi)); return r; }
__device__ __forceinline__ float bflo(unsigned w) { return __uint_as_float(w << 16); }
__device__ __forceinline__ float bfhi(unsigned w) { return __uint_as_float(w & 0xffff0000u); }

__device__ __forceinline__ float xsum16(float v) { auto r = __builtin_amdgcn_permlane16_swap(__float_as_uint(v), __float_as_uint(v), false, false); return __uint_as_float(r[0]) + __uint_as_float(r[1]); }
__device__ __forceinline__ float xsum32(float v) { auto r = __builtin_amdgcn_permlane32_swap(__float_as_uint(v), __float_as_uint(v), false, false); return __uint_as_float(r[0]) + __uint_as_float(r[1]); }
__device__ __forceinline__ void static_tile(int L, int nM, int nN, int& pm, int& pn) {
    const int nwg = nM * nN; int wgid = L;
    { const int q = nwg / NXCD, r = nwg % NXCD, xcd = wgid % NXCD, off = wgid / NXCD; wgid = (xcd < r ? xcd * (q + 1) : r * (q + 1) + (xcd - r) * q) + off; }
    const int nig = WGM * nN, gid = wgid / nig, fm = gid * WGM, gsz = (nM - fm) < WGM ? (nM - fm) : WGM;
    pm = fm + ((wgid % nig) % gsz); pn = (wgid % nig) / gsz;
}
struct SchedPlain {
    int nM, nN, G, c; const char* A; const char* B; size_t tstep;
    __device__ __forceinline__ bool next(int i, Unit& u) const { const long L = (long)i * G + c; if (L >= (long)nM * nN) return false; static_tile((int)L, nM, nN, u.pm, u.pn); u.br = 0; return true; }
    __device__ __forceinline__ const char* a_ptr(const Unit& u) const { return A + (size_t)u.pm * tstep; }
    __device__ __forceinline__ const char* b_ptr(const Unit& u) const { return B + (size_t)u.pn * tstep; }
    __device__ __forceinline__ void a_ready(const Unit&) const {}
    __device__ __forceinline__ void done(const Unit&) const {}
};
struct SchedP1 {
    int G, c; const char* A; const char* B;
    __device__ __forceinline__ bool next(int i, Unit& u) const { const long L = (long)i * G + c; if (L >= 1696) return false;
        if (L < 1664) static_tile((int)L, 64, 26, u.pm, u.pn); else { const int r = (int)L - 1664; u.pm = 64 + (r >> 2); u.pn = 26 + (r & 3); } u.br = 0; return true; }
    __device__ __forceinline__ const char* a_ptr(const Unit& u) const { return A + (size_t)u.pm * (256 * 1024 * 2); }
    __device__ __forceinline__ const char* b_ptr(const Unit& u) const { return B + (size_t)u.pn * (256 * 1024 * 2); }
    __device__ __forceinline__ void a_ready(const Unit&) const {}
    __device__ __forceinline__ void done(const Unit&) const {}
};
struct SchedP3 {
    int G, c; const char* A; const char* B; int br;
    __device__ __forceinline__ bool next(int i, Unit& u) const { if (i >= 1 || c >= 256) return false; static_tile(c, 64, 4, u.pm, u.pn); u.br = br; return true; }
    __device__ __forceinline__ const char* a_ptr(const Unit& u) const { return A + (size_t)u.br * ((size_t)3 * M * DH * 2) + (size_t)u.pm * (256 * 512 * 2); }
    __device__ __forceinline__ const char* b_ptr(const Unit& u) const { return B + (size_t)u.br * ((size_t)D * DH * 2) + (size_t)u.pn * (256 * 512 * 2); }
    __device__ __forceinline__ void a_ready(const Unit&) const {}
    __device__ __forceinline__ void done(const Unit&) const {}
};

typedef f32x4 acc_t[2][2][4][2];
__device__ __forceinline__ u32x4 pack8(const f32x4 a, const f32x4 b) { u32x4 w; w.x = cvt_pk_bf16(a[0], a[1]); w.y = cvt_pk_bf16(a[2], a[3]); w.z = cvt_pk_bf16(b[0], b[1]); w.w = cvt_pk_bf16(b[2], b[3]); return w; }
__device__ __forceinline__ float sigm(float x) { return __builtin_amdgcn_rcpf(1.0f + __builtin_amdgcn_exp2f(-LOG2E * x)); }

struct EpiProj {
    static constexpr bool PERM = true, AFTER_DRAIN = false;
    bf16_t* SBQ; bf16_t* G0; bf16_t* G2; float* MKf; bf16_t* MV;
    __device__ __forceinline__ void operator()(const acc_t& acc, const Unit& u, int wr, int wc, int fr, int fq) const {
        const int pn = u.pn; const int row0 = u.pm * BM + wr * 64 + fr;
        if (pn < 12) {
            const int T = pn >> 1, hd = (pn & 1) * 4 + wc;
            bf16_t* base = SBQ + (size_t)T * M * DH + (size_t)row0 * DH + hd * 64 + 8 * fq;
            if (T == 3 || T == 4) {
                const float qs = T == 3 ? C2 : 1.0f;
#pragma unroll
                for (int ai = 0; ai < 2; ++ai)
#pragma unroll
                    for (int m = 0; m < 4; ++m) {
                        float ss = 0.f;
#pragma unroll
                        for (int bj = 0; bj < 2; ++bj)
#pragma unroll
                            for (int n = 0; n < 2; ++n) { const f32x4 x = acc[ai][bj][m][n]; ss += (x[0] * x[0] + x[1] * x[1]) + (x[2] * x[2] + x[3] * x[3]); }
                        ss = xsum16(ss); ss = xsum32(ss);
                        const float sc = qs / sqrtf(ss * (1.0f / HD) + EPS);
                        bf16_t* rowp = base + (size_t)(ai * HALF + m * 16) * DH;
#pragma unroll
                        for (int bj = 0; bj < 2; ++bj) *(u32x4*)(rowp + 32 * bj) = pack8(acc[ai][bj][m][0] * sc, acc[ai][bj][m][1] * sc);
                    }
            } else {
                const float sc = T == 0 ? C2 : 1.0f;
#pragma unroll
                for (int ai = 0; ai < 2; ++ai)
#pragma unroll
                    for (int m = 0; m < 4; ++m) { bf16_t* rowp = base + (size_t)(ai * HALF + m * 16) * DH;
#pragma unroll
                        for (int bj = 0; bj < 2; ++bj) *(u32x4*)(rowp + 32 * bj) = pack8(acc[ai][bj][m][0] * sc, acc[ai][bj][m][1] * sc); }
            }
        } else if (pn < 14) {
            bf16_t* base = SBQ + (size_t)6 * M * DH + (size_t)row0 * DH + (pn - 12) * 256 + wc * 32 + 8 * fq;
#pragma unroll
            for (int ai = 0; ai < 2; ++ai)
#pragma unroll
                for (int m = 0; m < 4; ++m) { bf16_t* rowp = base + (size_t)(ai * HALF + m * 16) * DH;
#pragma unroll
                    for (int bj = 0; bj < 2; ++bj) *(u32x4*)(rowp + HALF * bj) = pack8(acc[ai][bj][m][0], acc[ai][bj][m][1]); }
        } else if (pn < 26) {
            const int g = (pn - 14) >> 2; bf16_t* G = g < 2 ? G0 + (size_t)g * M * D : G2;
            bf16_t* base = G + (size_t)row0 * D + ((pn - 14) & 3) * 256 + wc * 32 + 8 * fq;
#pragma unroll
            for (int ai = 0; ai < 2; ++ai)
#pragma unroll
                for (int m = 0; m < 4; ++m) { bf16_t* rowp = base + (size_t)(ai * HALF + m * 16) * D;
#pragma unroll
                    for (int bj = 0; bj < 2; ++bj) { f32x4 a = acc[ai][bj][m][0], b = acc[ai][bj][m][1];
#pragma unroll
                        for (int e = 0; e < 4; ++e) { a[e] = sigm(a[e]); b[e] = sigm(b[e]); }
                        *(u32x4*)(rowp + HALF * bj) = pack8(a, b); } }
        } else {
            const int mrow0 = (u.pm - 64) * BM + wr * 64 + fr, pl = pn - 26;
            if (pl < 2) { float* base = MKf + (size_t)mrow0 * DH + pl * 256 + wc * 32 + 8 * fq;
#pragma unroll
                for (int ai = 0; ai < 2; ++ai)
#pragma unroll
                    for (int m = 0; m < 4; ++m) { float* rowp = base + (size_t)(ai * HALF + m * 16) * DH;
#pragma unroll
                        for (int bj = 0; bj < 2; ++bj) { *(f32x4*)(rowp + HALF * bj) = acc[ai][bj][m][0]; *(f32x4*)(rowp + HALF * bj + 4) = acc[ai][bj][m][1]; } }
            } else { bf16_t* base = MV + (size_t)mrow0 * DH + (pl - 2) * 256 + wc * 32 + 8 * fq;
#pragma unroll
                for (int ai = 0; ai < 2; ++ai)
#pragma unroll
                    for (int m = 0; m < 4; ++m) { bf16_t* rowp = base + (size_t)(ai * HALF + m * 16) * DH;
#pragma unroll
                        for (int bj = 0; bj < 2; ++bj) *(u32x4*)(rowp + HALF * bj) = pack8(acc[ai][bj][m][0], acc[ai][bj][m][1]); } }
        }
    }
};
struct EpiMerged {
    static constexpr bool PERM = true, AFTER_DRAIN = true;
    const bf16_t* G0; const bf16_t* G2; float* T1; float* T2; bf16_t* MRG;
    __device__ __forceinline__ void fused(const acc_t& acc, const Unit& u, int wr, int wc, int fr, int fq, PG8_LAS unsigned char*, int, int) const {
        const int br = u.br; const int row0 = u.pm * BM + wr * 64 + fr, col0 = u.pn * BM + wc * 32 + 8 * fq;
        const bf16_t* G = (br < 2 ? G0 + (size_t)br * M * D : G2) + (size_t)row0 * D + col0;
        float* T = (u.pn < 2 ? T1 : T2) + (size_t)row0 * 512 + (col0 & 511);
        bf16_t* O = MRG + (size_t)row0 * D + col0;
#pragma unroll
        for (int ai = 0; ai < 2; ++ai)
#pragma unroll
            for (int m = 0; m < 4; ++m) { const size_t ro = (size_t)(ai * HALF + m * 16);
#pragma unroll
                for (int bj = 0; bj < 2; ++bj) {
                    const u32x4 gw = *(const u32x4*)(G + ro * D + HALF * bj);
                    f32x4 a = acc[ai][bj][m][0], b = acc[ai][bj][m][1];
                    a[0] *= bflo(gw.x); a[1] *= bfhi(gw.x); a[2] *= bflo(gw.y); a[3] *= bfhi(gw.y); b[0] *= bflo(gw.z); b[1] *= bfhi(gw.z); b[2] *= bflo(gw.w); b[3] *= bfhi(gw.w);
                    float* tp = T + ro * 512 + HALF * bj;
                    if (br > 0) { a += *(const f32x4*)tp; b += *(const f32x4*)(tp + 4); }
                    if (br < 2) { *(f32x4*)tp = a; *(f32x4*)(tp + 4) = b; } else *(u32x4*)(O + ro * D + HALF * bj) = pack8(a, b);
                }
                if (m & 1) asm volatile("" ::: "memory"); }
    }
};
struct EpiOut {
    static constexpr bool PERM = false, AFTER_DRAIN = true;
    const float* x; float* x1; bf16_t* A2; float* ssq;
    __device__ __forceinline__ void fused(const acc_t& acc, const Unit& u, int wr, int wc, int fr, int fq, PG8_LAS unsigned char*, int, int) const {
        const int row0 = u.pm * BM + wr * 64 + fr, col0 = u.pn * BM + wc * 32 + 4 * fq;
#pragma unroll
        for (int ai = 0; ai < 2; ++ai)
#pragma unroll
            for (int m = 0; m < 4; ++m) { const int row = row0 + ai * HALF + m * 16; const size_t off = (size_t)row * D + col0; float ss = 0.f;
#pragma unroll
                for (int bj = 0; bj < 2; ++bj)
#pragma unroll
                    for (int n = 0; n < 2; ++n) { const size_t o = off + bj * HALF + n * 16; const f32x4 r = *(const f32x4*)(x + o) + acc[ai][bj][m][n];
                        *(f32x4*)(x1 + o) = r; ss += (r[0] * r[0] + r[1] * r[1]) + (r[2] * r[2] + r[3] * r[3]);
                        u32x2 w; w.x = cvt_pk_bf16(r[0], r[1]); w.y = cvt_pk_bf16(r[2], r[3]); *(u32x2*)(A2 + o) = w; }
                (void)ss;
                if (m & 1) asm volatile("" ::: "memory"); }
    }
};
struct EpiUp {
    static constexpr bool PERM = true, AFTER_DRAIN = false;
    bf16_t* U;
    __device__ __forceinline__ void operator()(const acc_t& acc, const Unit& u, int wr, int wc, int fr, int fq) const {
        const int row0 = u.pm * BM + wr * 64 + fr; bf16_t* base = U + (size_t)row0 * FF + u.pn * BM + wc * 32 + 8 * fq;
#pragma unroll
        for (int ai = 0; ai < 2; ++ai)
#pragma unroll
            for (int m = 0; m < 4; ++m) { bf16_t* rowp = base + (size_t)(ai * HALF + m * 16) * FF;
#pragma unroll
                for (int bj = 0; bj < 2; ++bj) { f32x4 a = acc[ai][bj][m][0], b = acc[ai][bj][m][1];
#pragma unroll
                    for (int e = 0; e < 4; ++e) { const float ta = fmaxf(a[e], 0.f), tb = fmaxf(b[e], 0.f); a[e] = ta * ta; b[e] = tb * tb; }
                    *(u32x4*)(rowp + HALF * bj) = pack8(a, b); } }
    }
};
struct EpiDown {
    static constexpr bool PERM = false, AFTER_DRAIN = true;
    float* out; const float* ssq;
    __device__ __forceinline__ void fused(const acc_t& acc, const Unit& u, int wr, int wc, int fr, int fq, PG8_LAS unsigned char*, int, int) const {
        const int row0 = u.pm * BM + wr * 64 + fr, col0 = u.pn * BM + wc * 32 + 4 * fq;
#pragma unroll
        for (int ai = 0; ai < 2; ++ai)
#pragma unroll
            for (int m = 0; m < 4; ++m) { const int row = row0 + ai * HALF + m * 16; const size_t off = (size_t)row * D + col0;
                const f32x4* p = (const f32x4*)(ssq + (size_t)row * 16); const f32x4 a = p[0], b = p[1], c = p[2], d = p[3];
                const float ss = ((a[0] + a[1]) + (a[2] + a[3])) + ((b[0] + b[1]) + (b[2] + b[3])) + ((c[0] + c[1]) + (c[2] + c[3])) + ((d[0] + d[1]) + (d[2] + d[3]));
                const float r2 = 1.0f / (ss * (1.0f / D) + EPS);
#pragma unroll
                for (int bj = 0; bj < 2; ++bj)
#pragma unroll
                    for (int n = 0; n < 2; ++n) { float* q = out + off + bj * HALF + n * 16; *(f32x4*)q = *(const f32x4*)q + acc[ai][bj][m][n] * r2; }
                if (m & 1) asm volatile("" ::: "memory"); }
    }
};

template <class Epi, class Sched, bool ALIGN_EPI = false, bool SP2 = false>
__device__ __forceinline__ void gemm_phase(PG8_LAS unsigned char* lds, const int K, const Sched& S, const Epi& E) {
    const int tid = threadIdx.x, wid = __builtin_amdgcn_readfirstlane(tid >> 6), lane = tid & 63, wr = wid >> 2, wc = wid & 3, fr = lane & 15, fq = lane >> 4;
    const int nt = K / BK;
    unsigned voffA[2], voffB[2];
#pragma unroll
    for (int i = 0; i < 2; ++i) { int R, C; stage_rc(tid * 16 + i * 8192, R, C); const int Rb = Epi::PERM ? ((R & ~31) + perm32(R & 31)) : R;
        voffA[i] = (unsigned)(R * K + C) * 2u; voffB[i] = (unsigned)(Rb * K + C) * 2u; }
    const size_t kstep = (size_t)(BK * 2);
    const size_t hstep = (size_t)HALF * K * 2;
    const unsigned ldsw = (unsigned)wid * 1024u;
    const int aoff = lds_byte(wr * 64 + fr, fq * 8), boff = lds_byte(wc * 32 + fr, fq * 8);
#define PG8_SA(b, h) (((b) * 2 + (h)) * HTB)
#define PG8_SB(b, h) ((4 + (b) * 2 + (h)) * HTB)
#define PG8_STAGE(bufoff, gbase, voff) do { _Pragma("unroll") for (int _i = 0; _i < 2; ++_i) \
        __builtin_amdgcn_global_load_lds((const unsigned*)((const char*)(gbase) + (voff)[_i]), (PG8_LAS unsigned*)(lds + (bufoff) + ldsw + _i * 8192), 16, 0, 0); } while (0)
#define PG8_LDA(dst, b, h) do { _Pragma("unroll") for (int m = 0; m < 4; ++m) _Pragma("unroll") for (int k = 0; k < 2; ++k) dst[m][k] = *(const PG8_LAS bf16x8*)(lds + PG8_SA(b, h) + aoff + m * 2048 + k * 1024); } while (0)
#define PG8_LDB(dst, b, h) do { _Pragma("unroll") for (int n = 0; n < 2; ++n) _Pragma("unroll") for (int k = 0; k < 2; ++k) dst[n][k] = *(const PG8_LAS bf16x8*)(lds + PG8_SB(b, h) + boff + n * 2048 + k * 1024); } while (0)
#define PG8_MMA(ai, bj, At, Bt) do { __builtin_amdgcn_s_setprio(1); _Pragma("unroll") for (int m = 0; m < 4; ++m) _Pragma("unroll") for (int n = 0; n < 2; ++n) _Pragma("unroll") for (int k = 0; k < 2; ++k) \
        acc[ai][bj][m][n] = __builtin_amdgcn_mfma_f32_16x16x32_bf16(Bt[n][k], At[m][k], acc[ai][bj][m][n], 0, 0, 0); __builtin_amdgcn_s_setprio(0); } while (0)
#define PG8_WAIT_V(n) asm volatile("s_waitcnt vmcnt(" #n ")" ::: "memory")
#define PG8_WAIT_L(n) asm volatile("s_waitcnt lgkmcnt(" #n ")" ::: "memory")
#define PG8_BAR __builtin_amdgcn_s_barrier()
#define PG8_SCHED __builtin_amdgcn_sched_barrier(0)
    Unit cur, nxt; int ui = 0;
    if (!S.next(0, cur)) return;
    f32x4 acc[2][2][4][2];
#pragma unroll
    for (int a = 0; a < 2; ++a)
#pragma unroll
        for (int b = 0; b < 2; ++b)
#pragma unroll
            for (int m = 0; m < 4; ++m)
#pragma unroll
                for (int n = 0; n < 2; ++n) acc[a][b][m][n] = (f32x4){0.f, 0.f, 0.f, 0.f};
    bf16x8 At[4][2], B0[2][2], B1[2][2];
    const char* cA = S.a_ptr(cur); const char* cB = S.b_ptr(cur);
    S.a_ready(cur);
    if constexpr (SP2) {
        PG8_STAGE(PG8_SB(0, 0), cB, voffB); PG8_STAGE(PG8_SB(0, 1), cB + hstep, voffB); PG8_STAGE(PG8_SA(0, 0), cA, voffA); PG8_STAGE(PG8_SA(0, 1), cA + hstep, voffA);
        if (wr == 1) PG8_BAR;
        PG8_WAIT_V(2); PG8_BAR;
        PG8_STAGE(PG8_SB(1, 0), cB + kstep, voffB); PG8_STAGE(PG8_SA(1, 0), cA + kstep, voffA); PG8_STAGE(PG8_SB(1, 1), cB + hstep + kstep, voffB);
        PG8_WAIT_V(6); PG8_BAR;
    } else {
        PG8_STAGE(PG8_SB(0, 0), cB, voffB); PG8_STAGE(PG8_SA(0, 0), cA, voffA); PG8_STAGE(PG8_SB(0, 1), cB + hstep, voffB); PG8_STAGE(PG8_SA(0, 1), cA + hstep, voffA);
        if (wr == 1) PG8_BAR;
        PG8_WAIT_V(4); PG8_BAR;
        PG8_STAGE(PG8_SB(1, 0), cB + kstep, voffB); PG8_STAGE(PG8_SA(1, 0), cA + kstep, voffA); PG8_STAGE(PG8_SB(1, 1), cB + hstep + kstep, voffB);
        PG8_WAIT_V(6); PG8_BAR;
    }
    for (;;) {
        const bool has_next = S.next(ui + 1, nxt);
        const char* nA = has_next ? S.a_ptr(nxt) : cA; const char* nB = has_next ? S.b_ptr(nxt) : cB;
        for (int t = 0; t < nt; t += 2) {
            const bool last = (t == nt - 2);
            const char* a1 = cA + (size_t)(t + 1) * kstep;
            const char* a2 = last ? nA : cA + (size_t)(t + 2) * kstep; const char* b2 = last ? nB : cB + (size_t)(t + 2) * kstep;
            const char* a3 = a2 + kstep; const char* b3 = b2 + kstep;
            if (last && has_next) S.a_ready(nxt);
            if constexpr (SP2) {
            PG8_LDB(B0, 0, 0); PG8_LDB(B1, 0, 1); PG8_SCHED; PG8_LDA(At, 0, 0); PG8_STAGE(PG8_SA(1, 1), a1 + hstep, voffA);
            PG8_WAIT_V(8); PG8_WAIT_L(0); PG8_BAR; PG8_MMA(0, 0, At, B0); PG8_MMA(0, 1, At, B1); PG8_BAR; PG8_SCHED;
            PG8_LDA(At, 0, 1); PG8_STAGE(PG8_SB(0, 0), b2, voffB); PG8_STAGE(PG8_SB(0, 1), b2 + hstep, voffB); PG8_STAGE(PG8_SA(0, 0), a2, voffA);
            PG8_WAIT_V(8); PG8_WAIT_L(0); PG8_BAR; PG8_MMA(1, 0, At, B0); PG8_MMA(1, 1, At, B1); PG8_BAR; PG8_SCHED;
            PG8_LDB(B0, 1, 0); PG8_LDB(B1, 1, 1); PG8_SCHED; PG8_LDA(At, 1, 0); PG8_STAGE(PG8_SA(0, 1), a2 + hstep, voffA);
            PG8_WAIT_V(8); PG8_WAIT_L(0); PG8_BAR; PG8_MMA(0, 0, At, B0); PG8_MMA(0, 1, At, B1); PG8_BAR; PG8_SCHED;
            PG8_LDA(At, 1, 1); PG8_STAGE(PG8_SB(1, 0), b3, voffB); PG8_STAGE(PG8_SB(1, 1), b3 + hstep, voffB); PG8_STAGE(PG8_SA(1, 0), a3, voffA);
            PG8_WAIT_V(8); PG8_WAIT_L(0); PG8_BAR; PG8_MMA(1, 0, At, B0); PG8_MMA(1, 1, At, B1); PG8_BAR; PG8_SCHED;
            } else {
            PG8_LDB(B0, 0, 0); PG8_SCHED; PG8_LDA(At, 0, 0); PG8_STAGE(PG8_SA(1, 1), a1 + hstep, voffA);
            PG8_WAIT_L(8); PG8_BAR; PG8_WAIT_L(0); PG8_MMA(0, 0, At, B0); PG8_BAR; PG8_SCHED;
            PG8_LDB(B1, 0, 1); PG8_STAGE(PG8_SB(0, 0), b2, voffB);
            PG8_BAR; PG8_WAIT_L(0); PG8_MMA(0, 1, At, B1); PG8_BAR;
            PG8_LDA(At, 0, 1); PG8_STAGE(PG8_SA(0, 0), a2, voffA);
            PG8_BAR; PG8_WAIT_L(0); PG8_MMA(1, 0, At, B0); PG8_BAR; PG8_SCHED;
            PG8_STAGE(PG8_SB(0, 1), b2 + hstep, voffB);
            PG8_WAIT_V(6); PG8_BAR; PG8_MMA(1, 1, At, B1); PG8_BAR;
            PG8_LDB(B0, 1, 0); PG8_SCHED; PG8_LDA(At, 1, 0); PG8_STAGE(PG8_SA(0, 1), a2 + hstep, voffA);
            PG8_WAIT_L(8); PG8_BAR; PG8_WAIT_L(0); PG8_MMA(0, 0, At, B0); PG8_BAR; PG8_SCHED;
            PG8_LDB(B1, 1, 1); PG8_STAGE(PG8_SB(1, 0), b3, voffB);
            PG8_BAR; PG8_WAIT_L(0); PG8_MMA(0, 1, At, B1); PG8_BAR;
            PG8_LDA(At, 1, 1); PG8_STAGE(PG8_SA(1, 0), a3, voffA);
            PG8_BAR; PG8_WAIT_L(0); PG8_MMA(1, 0, At, B0); PG8_BAR; PG8_SCHED;
            PG8_STAGE(PG8_SB(1, 1), b3 + hstep, voffB);
            PG8_WAIT_V(6); PG8_BAR; PG8_MMA(1, 1, At, B1); PG8_BAR;
            }
        }
        if constexpr (ALIGN_EPI) { if (wr == 0) PG8_BAR; }
        if constexpr (!Epi::AFTER_DRAIN) { E(acc, cur, wr, wc, fr, fq); S.done(cur); }
        if (!has_next) break;
#pragma unroll
        for (int a = 0; a < 2; ++a)
#pragma unroll
            for (int b = 0; b < 2; ++b)
#pragma unroll
                for (int m = 0; m < 4; ++m)
#pragma unroll
                    for (int n = 0; n < 2; ++n) acc[a][b][m][n] = (f32x4){0.f, 0.f, 0.f, 0.f};
        cur = nxt; cA = nA; cB = nB; ++ui;
        if constexpr (ALIGN_EPI) { if (wr == 1) PG8_BAR; }
    }
    PG8_WAIT_V(0);
    if constexpr (!ALIGN_EPI) { if (wr == 0) PG8_BAR; }
    PG8_BAR;
    if constexpr (Epi::AFTER_DRAIN) { E.fused(acc, cur, wr, wc, fr, fq, lds, wid, lane); S.done(cur); }
#undef PG8_SA
#undef PG8_SB
#undef PG8_STAGE
#undef PG8_LDA
#undef PG8_LDB
#undef PG8_MMA
#undef PG8_WAIT_V
#undef PG8_WAIT_L
#undef PG8_BAR
#undef PG8_SCHED
}
}

constexpr int N_PHASES = 9;
#ifndef OPT_P1
#define OPT_P1 1
#endif
#ifndef OPT_P3
#define OPT_P3 1
#endif
#ifndef OPT_P4
#define OPT_P4 1
#endif
#ifndef OPT_P5
#define OPT_P5 1
#endif
#ifndef OPT_P6
#define OPT_P6 1
#endif
#ifndef MK_N_LAUNCHES
#define MK_N_LAUNCHES 1
#endif
constexpr int N_LAUNCHES = MK_N_LAUNCHES;
struct Args { const float* in[18]; float* out; unsigned char* ws; int ph_lo, ph_hi, li, pad; };

__global__ void __launch_bounds__(NTHREADS, 2) skel_fwd(Args args) {
    extern __shared__ __attribute__((aligned(16))) unsigned char lds[];
    Frame F;
    F.lds = (LAS unsigned char*)lds;
    F.MISC = (volatile LAS unsigned*)(F.lds + MISC_OFF);
    F.tid = threadIdx.x; F.lane = F.tid & 63; F.wave = __builtin_amdgcn_readfirstlane(F.tid >> 6);
    F.G = gridDim.x; { const int bx = blockIdx.x; F.vcu = (F.G % 8 == 0) ? (bx % 8) * (F.G / 8) + bx / 8 : bx; }
    unsigned char* ws = args.ws;
    F.ctl = (gu32*)(ws + WS_CTL);
    F.x = args.in[0]; F.mem = args.in[1]; F.g_mix = args.in[2]; F.g_memn = args.in[3]; F.w_in = args.in[4]; F.b_forget = args.in[5]; F.g_fq = args.in[6]; F.g_fk = args.in[7];
    F.g_mq = args.in[8]; F.g_mk = args.in[9]; F.w_mkv = args.in[10]; F.w_bsb = args.in[11]; F.w_bfx = args.in[12]; F.w_bmm = args.in[13]; F.w_out = args.in[14]; F.g_mlp = args.in[15];
    F.w_up = args.in[16]; F.w_dn = args.in[17]; F.out = args.out;
    F.logf = (float*)(ws + WS_LOGF); F.FC = (float*)(ws + WS_FC); F.ssq = (float*)(ws + WS_SSQ); F.MKf = (float*)(ws + WS_MKF);
    F.Win_t = (bf16*)(ws + WS_WIN); F.Wmkv_t = (bf16*)(ws + WS_WMKV); F.Wbr_t = (bf16*)(ws + WS_WBR); F.Wout_t = (bf16*)(ws + WS_WOUT); F.Wup_t = (bf16*)(ws + WS_WUP); F.Wdn_t = (bf16*)(ws + WS_WDN);
    F.MHb = (bf16*)(ws + WS_MH); F.MV = (bf16*)(ws + WS_MV); F.XN = (bf16*)(ws + WS_XN);
    F.SBQ = (bf16*)(ws + WS_SBQ); F.SBK = (bf16*)(ws + WS_SBK); F.SBV = (bf16*)(ws + WS_SBV); F.FXQ = (bf16*)(ws + WS_FXQ); F.FXK = (bf16*)(ws + WS_FXK); F.FXV = (bf16*)(ws + WS_FXV); F.MQ = (bf16*)(ws + WS_MQ);
    F.G0 = (bf16*)args.out; F.G1 = (bf16*)args.out + (size_t)M * D; F.G2 = (bf16*)(ws + WS_G2); F.MRG = (bf16*)(ws + WS_MRG); F.U = (bf16*)(ws + WS_U);
    for (int u = F.tid; u < (LDS_BYTES - LDSCTL_OFF) / 4; u += NTHREADS) ((LAS unsigned*)(F.lds + LDSCTL_OFF))[u] = 0u;
    __syncthreads();
    XcdBarrier bar; bar.bar = (unsigned*)(F.ctl + CW_BAR); bar.x = 0; bar.st = nullptr;
    if (N_LAUNCHES == 1) bar = xcd_barrier_post((unsigned*)(F.ctl + CW_BAR), F.MISC + 8);
#define GRID_BAR() do { if (N_LAUNCHES == 1) xcd_barrier(bar); } while (0)
    const int lo = args.ph_lo, hi = args.ph_hi;
#define IN(k) (lo <= (k) && (k) < hi)
#define BOTH(k) (IN(k) && IN((k) + 1))
    const int wg = (int)blockIdx.x, nwg = F.G;

    if (IN(0)) { p0_prologue(F); if (BOTH(0)) GRID_BAR(); }
    if (IN(1)) {
        fcumsum(F); VM_WAIT();
#if OPT_P1
        { pg8::EpiProj E{F.SBQ, F.G0, F.G2, F.MKf, F.MV};
          pg8::SchedP1 S{F.G, (int)blockIdx.x, (const char*)F.XN, (const char*)F.Win_t};
          pg8::gemm_phase<pg8::EpiProj, pg8::SchedP1, false, true>(F.lds, D, S, E); }
#else
        { EpiProjN E{F.SBQ, F.G0, F.G2}; ngemm(F.XN, D, F.Win_t, D, M, NPROJ, D, E, wg, nwg); }
        { EpiMkvN E{F.MKf, F.MV}; ngemm(F.MHb, D, F.Wmkv_t, D, MROWS, 1024, D, E, wg, nwg); }
#endif
        if (BOTH(1)) GRID_BAR();
    }
    if (IN(2)) {
#if !OPT_P1
        headnorm_naive(F);
#endif
        if (BOTH(2)) { if (!OPT_P1) GRID_BAR(); } }
    if (IN(3)) {
        nattn64<0>(F.SBQ, F.SBK, F.SBV, F.SBQ, F.FC, F.g_fq, F.g_fk, wg, nwg);
        nattn64<1>(F.FXQ, F.FXK, F.FXV, F.FXQ, F.FC, F.g_fq, F.g_fk, wg, nwg);
        nattn_mem(F, wg, nwg);
        if (BOTH(3)) GRID_BAR();
    }
    if (IN(4)) {
#if OPT_P3
        { pg8::EpiMerged E{F.G0, F.G2, (float*)(ws + WS_T1), (float*)(ws + WS_T2), F.MRG};
          for (int br = 0; br < 3; ++br) { pg8::SchedP3 S{F.G, (int)blockIdx.x, (const char*)F.SBQ, (const char*)F.Wbr_t, br};
              pg8::gemm_phase<pg8::EpiMerged, pg8::SchedP3, false, true>(F.lds, DH, S, E); } }
#else
        nmerged(F, wg, nwg);
#endif
        if (BOTH(4)) GRID_BAR(); }
    if (IN(5)) {
#if OPT_P4
        { pg8::SchedPlain S{64, 4, F.G, (int)blockIdx.x, (const char*)F.MRG, (const char*)F.Wout_t, (size_t)256 * D * 2};
          pg8::EpiOut E{F.x, F.out, F.XN, F.ssq};
          pg8::gemm_phase<pg8::EpiOut, pg8::SchedPlain, false, true>(F.lds, D, S, E); }
#else
        { EpiOutN E{F.x, F.out, F.XN}; ngemm(F.MRG, D, F.Wout_t, D, M, D, D, E, wg, nwg); }
#endif
        if (BOTH(5)) GRID_BAR(); }
    if (IN(6)) {
        ssq_naive(F);
        if (BOTH(6)) { GRID_BAR(); } }
    if (IN(7)) {
#if OPT_P5
        { pg8::SchedPlain S{64, 16, F.G, (int)blockIdx.x, (const char*)F.XN, (const char*)F.Wup_t, (size_t)256 * D * 2};
          pg8::EpiUp E{F.U};
          pg8::gemm_phase<pg8::EpiUp, pg8::SchedPlain, false, true>(F.lds, D, S, E); }
#else
        { EpiUpN E{F.ssq, F.U}; ngemm(F.XN, D, F.Wup_t, D, M, FF, D, E, wg, nwg); }
#endif
        if (BOTH(7)) GRID_BAR(); }
    if (IN(8)) {
#if OPT_P6
        { pg8::SchedPlain S{64, 4, F.G, (int)blockIdx.x, (const char*)F.U, (const char*)F.Wdn_t, (size_t)256 * FF * 2};
          pg8::EpiDown E{F.out, F.ssq};
          pg8::gemm_phase<pg8::EpiDown, pg8::SchedPlain, false, true>(F.lds, FF, S, E); }
#else
        { EpiDnN E{F.out, F.ssq}; ngemm(F.U, FF, F.Wdn_t, FF, M, D, FF, E, wg, nwg); }
#endif
    }
#undef IN
#undef BOTH
}

extern "C" void kernel_launch(void* const* d_in, const int* in_sizes, int n_in, void* d_out, int out_size, void* d_ws, size_t ws_size, hipStream_t stream) {
    static int grid = 0;
    if (grid == 0) {
        if (n_in != 18 || in_sizes[0] != M * D || out_size != M * D || ws_size < WS_END) { fprintf(stderr, "kernel_launch: unexpected shapes (n_in %d, in0 %d, out %d, ws %zu); nothing launched\n", n_in, n_in > 0 ? in_sizes[0] : -1, out_size, ws_size); grid = -1; return; }
        int dev = 0, cus = 0, per_cu = 0;
        if (hipGetDevice(&dev) != hipSuccess || hipDeviceGetAttribute(&cus, hipDeviceAttributeMultiprocessorCount, dev) != hipSuccess) { grid = -1; return; }
        if (hipFuncSetAttribute((const void*)skel_fwd, hipFuncAttributeMaxDynamicSharedMemorySize, LDS_BYTES) != hipSuccess) { fprintf(stderr, "kernel_launch: hipFuncSetAttribute failed\n"); grid = -1; return; }
        if (hipOccupancyMaxActiveBlocksPerMultiprocessor(&per_cu, (const void*)skel_fwd, NTHREADS, LDS_BYTES) != hipSuccess || per_cu < 1) fprintf(stderr, "kernel_launch: occupancy query reports %d\n", per_cu);
        (void)hipGetLastError();
        grid = cus;
    }
    if (grid < 0) return;
    if (hipMemsetAsync((char*)d_ws + WS_CTL, 0, CTL_ZERO_BYTES, stream) != hipSuccess) return;
    Args a{};
    for (int i = 0; i < 18; ++i) a.in[i] = (const float*)d_in[i];
    a.out = (float*)d_out; a.ws = (unsigned char*)d_ws;
    for (int li = 0; li < N_LAUNCHES; ++li) {
        a.ph_lo = (N_LAUNCHES == 1) ? 0 : li; a.ph_hi = (N_LAUNCHES == 1) ? N_PHASES : li + 1; a.li = li;
        hipLaunchKernelGGL(skel_fwd, dim3(grid), dim3(NTHREADS), LDS_BYTES, stream, a);
        if (hipPeekAtLastError() != hipSuccess) break;
    }
}
```

```cpp
#include <hip/hip_runtime.h>
#include <cstdio>
#include <cstdint>

#define GAS __attribute__((address_space(1)))
#define LAS __attribute__((address_space(3)))
typedef unsigned short bf16;
typedef short bf16x8 __attribute__((ext_vector_type(8)));
typedef float f32x4 __attribute__((ext_vector_type(4)));
typedef unsigned v4u __attribute__((ext_vector_type(4)));
typedef GAS unsigned gu32;
#define RLX_AGENT __ATOMIC_RELAXED, __HIP_MEMORY_SCOPE_AGENT
#define LDS_WAIT() asm volatile("s_waitcnt lgkmcnt(0)" ::: "memory")
#define VM_WAIT() asm volatile("s_waitcnt vmcnt(0)" ::: "memory")

constexpr int NWAVES = 8, NTHREADS = 512;
constexpr int BATCH = 8, SEQ = 2048, M = BATCH * SEQ, D = 1024, MEMLEN = 256, MROWS = BATCH * MEMLEN;
constexpr int HD = 64, NH = 8, MNH = 4, MHD = 128, DH = 512, FF = 4096;
constexpr int DIN = 6664, NPROJ = 6656;
constexpr float EPS = 1e-6f, LOG2E = 1.4426950408889634f, LN2 = 0.6931471805599453f;
constexpr float C2 = 0.125f * LOG2E;
constexpr float C2M = 0.08838834764831845f * LOG2E;

constexpr size_t MiB = 1u << 20;
constexpr size_t WS_CTL = 0, CTL_ZERO_BYTES = 65536;
constexpr size_t WS_LOGF = 1 * MiB, WS_FC = 1 * MiB + 512 * 1024, WS_SSQ = 2 * MiB;
constexpr size_t WS_WIN = 3 * MiB, WS_WMKV = 16 * MiB, WS_WBR = 18 * MiB, WS_WOUT = 21 * MiB, WS_WUP = 23 * MiB, WS_WDN = 31 * MiB;
constexpr size_t WS_MV = 39 * MiB, WS_XN = 44 * MiB, WS_MH = 76 * MiB;
constexpr size_t WS_T1 = 96 * MiB, WS_T2 = 144 * MiB;
constexpr size_t WS_SBQ = 80 * MiB, WS_SBK = 96 * MiB, WS_SBV = 112 * MiB, WS_FXQ = 128 * MiB, WS_FXK = 144 * MiB, WS_FXV = 160 * MiB, WS_MQ = 176 * MiB;
constexpr size_t WS_G2 = 192 * MiB, WS_MRG = 224 * MiB, WS_MKF = 224 * MiB, WS_U = 80 * MiB, WS_END = 256 * MiB;
constexpr int CW_BAR = 4096;

constexpr int RING_BYTES = 131072, LDSCTL_OFF = RING_BYTES, MISC_OFF = LDSCTL_OFF + 320, LDS_BYTES = 147456;

__device__ __forceinline__ unsigned f2bf(float f) { unsigned u = __builtin_bit_cast(unsigned, f); return (u + 0x7fffu + ((u >> 16) & 1u)) >> 16; }
__device__ __forceinline__ unsigned pk2(float lo, float hi) { return f2bf(lo) | (f2bf(hi) << 16); }
__device__ __forceinline__ float bf2f(unsigned b) { return __uint_as_float(b << 16); }
__device__ __forceinline__ float bflo(unsigned w) { return __uint_as_float(w << 16); }
__device__ __forceinline__ float bfhi(unsigned w) { return __uint_as_float(w & 0xffff0000u); }
__device__ __forceinline__ float wave_sum(float v) {
#pragma unroll
    for (int o = 1; o < 64; o <<= 1) v += __shfl_xor(v, o);
    return v;
}
__device__ __forceinline__ float log_sigmoid_f(float x) { return fminf(x, 0.f) - log1pf(expf(-fabsf(x))); }

#define XB_TMO      128
#define XB_XCNT(j)  (256  + 64 * (j))
#define XB_XSUB(j)  (1280 + 64 * (j))
#define XB_XGEN(j)  (2304 + 64 * (j))
#define XB_TOP      3328
#define XB_TOPGEN   3392
#define XCD_BAR_WORDS 3456
#define XB_SPIN_CAP (1u << 18)
__device__ __forceinline__ unsigned xb_ld(unsigned* p)              { return __hip_atomic_load(p, __ATOMIC_RELAXED, __HIP_MEMORY_SCOPE_AGENT); }
__device__ __forceinline__ unsigned xb_add(unsigned* p, unsigned v) { return __hip_atomic_fetch_add(p, v, __ATOMIC_RELAXED, __HIP_MEMORY_SCOPE_AGENT); }
__device__ __forceinline__ unsigned xb_xcc_id() { return (unsigned)__builtin_amdgcn_s_getreg((3 << 11) | 20) & 0xFu; }
#define XB_SPIN(cond, bar) do { unsigned _sp = 0; while (cond) { __builtin_amdgcn_s_sleep(1); \
    if ((++_sp & 255u) == 0u) { if (xb_ld(&(bar)[XB_TMO])) break; if (_sp > XB_SPIN_CAP) { atomicAdd(&(bar)[XB_TMO], 1u); break; } } } } while (0)
struct XcdBarrier { unsigned* bar; unsigned x; volatile LAS unsigned* st; };
__device__ __forceinline__ XcdBarrier xcd_barrier_post(unsigned* bar, volatile LAS unsigned* st) {
    XcdBarrier b; b.bar = bar; b.x = xb_xcc_id(); b.st = st;
    if (threadIdx.x == 0) (void)xb_add(&bar[XB_XCNT(b.x)], 1u);
    return b;
}
__device__ __forceinline__ void xcd_barrier_complete(unsigned* bar, unsigned x, unsigned& nloc, unsigned& nx) {
    const unsigned G = gridDim.x * gridDim.y * gridDim.z;
    unsigned sum, cnt, mine, sp = 0u;
    for (;;) {
        sum = 0u; cnt = 0u; mine = 0u;
#pragma unroll
        for (unsigned j = 0; j < 16; ++j) { const unsigned c = xb_ld(&bar[XB_XCNT(j)]); sum += c; cnt += (c > 0u) ? 1u : 0u; mine = (j == x) ? c : mine; }
        if (sum == G) break;
        __builtin_amdgcn_s_sleep(1);
        if ((++sp & 255u) == 0u) { if (xb_ld(&bar[XB_TMO])) break; if (sp > XB_SPIN_CAP) { atomicAdd(&bar[XB_TMO], 1u); break; } }
    }
    nloc = mine > 0u ? mine : 1u; nx = cnt > 0u ? cnt : 1u;
}
__device__ __forceinline__ void xcd_barrier(const XcdBarrier& b) {
    asm volatile("s_waitcnt vmcnt(0)" ::: "memory");
    __syncthreads();
    if (threadIdx.x == 0) {
        unsigned* bar = b.bar;
        __builtin_amdgcn_s_waitcnt(0);
        unsigned nloc = b.st[0], nx = b.st[1];
        if (nloc == 0u) { xcd_barrier_complete(bar, b.x, nloc, nx); b.st[0] = nloc; b.st[1] = nx; }
        const unsigned old = xb_add(&bar[XB_XSUB(b.x)], 1u);
        const unsigned gen = old / nloc;
        if (old + 1u == (gen + 1u) * nloc) {
            __builtin_amdgcn_fence(__ATOMIC_RELEASE, "agent");
            asm volatile("s_waitcnt vmcnt(0)" ::: "memory");
            const unsigned og = xb_add(&bar[XB_TOP], 1u);
            const unsigned tg = og / nx;
            if (og + 1u == (tg + 1u) * nx) xb_add(&bar[XB_TOPGEN], 1u);
            else XB_SPIN(xb_ld(&bar[XB_TOPGEN]) == tg, bar);
            __builtin_amdgcn_fence(__ATOMIC_ACQUIRE, "agent");
            xb_add(&bar[XB_XGEN(b.x)], 1u);
            asm volatile("s_waitcnt vmcnt(0)" ::: "memory");
        } else {
            XB_SPIN(xb_ld(&bar[XB_XGEN(b.x)]) == gen, bar);
            __builtin_amdgcn_fence(__ATOMIC_ACQUIRE, "agent");
            asm volatile("s_waitcnt vmcnt(0)" ::: "memory");
        }
    }
    __syncthreads();
}

struct Frame {
    LAS unsigned char* lds;
    volatile LAS unsigned* MISC;
    gu32* ctl;
    int tid, lane, wave, vcu, G;
    const float *x, *mem, *g_mix, *g_memn, *w_in, *b_forget, *g_fq, *g_fk, *g_mq, *g_mk, *w_mkv, *w_bsb, *w_bfx, *w_bmm, *w_out, *g_mlp, *w_up, *w_dn;
    float* out;
    float *logf, *FC, *ssq, *MKf;
    bf16 *Win_t, *Wmkv_t, *Wbr_t, *Wout_t, *Wup_t, *Wdn_t, *MHb, *MV, *XN, *SBQ, *SBK, *SBV, *FXQ, *FXK, *FXV, *MQ, *G0, *G1, *G2, *MRG, *U;
};

__device__ __forceinline__ void tr_item(const float* W, int ldw, int K, bf16* WT, int src_c0, int dst_r0, int k0, LAS float* scr, int lane, const float* kgain = nullptr) {
#pragma unroll 8
    for (int i = 0; i < 32; ++i) { const int kk = 2 * i + (lane >> 5); float w = W[(size_t)(k0 + kk) * ldw + src_c0 + (lane & 31)]; if (kgain) w *= kgain[k0 + kk]; scr[kk * 33 + (lane & 31)] = w; }
    LDS_WAIT(); asm volatile("" ::: "memory");
    const int c = lane & 7;
#pragma unroll
    for (int j = 0; j < 4; ++j) { const int n = (lane >> 3) + 8 * j; const LAS float* s = scr + (8 * c) * 33 + n;
        v4u o; o.x = pk2(s[0 * 33], s[1 * 33]); o.y = pk2(s[2 * 33], s[3 * 33]); o.z = pk2(s[4 * 33], s[5 * 33]); o.w = pk2(s[6 * 33], s[7 * 33]);
        *(GAS v4u*)(WT + (size_t)(dst_r0 + n) * K + k0 + 8 * c) = o; }
    LDS_WAIT(); asm volatile("" ::: "memory");
}
__host__ __device__ __forceinline__ int proj_src_col(int n) {
    const int pn = n >> 8, j = n & 255;
    if (pn < 12) { const int T = pn >> 1, bj = j >> 7, wc = (j >> 5) & 3, e = j & 31; return T * 512 + ((pn & 1) * 4 + wc) * 64 + bj * 32 + e; }
    if (pn < 14) return 3080 + (n - 12 * 256);
    return 3592 + (n - 14 * 256);
}
template <bool IS_X>
__device__ __forceinline__ void p0_rows(Frame& F, const float* srcb, const float* g, bf16* dstb, int nrows, LAS float* wf, int gw, int NGW) {
    const GAS f32x4* gr = (const GAS f32x4*)g + F.lane;
    for (int m = gw; m < nrows; m += NGW) {
        const GAS f32x4* xr = (const GAS f32x4*)(srcb + (size_t)m * D) + F.lane;
        f32x4 v[4]; float s = 0.f;
#pragma unroll
        for (int j = 0; j < 4; ++j) { v[j] = xr[64 * j]; s += (v[j].x * v[j].x + v[j].y * v[j].y) + (v[j].z * v[j].z + v[j].w * v[j].w); }
        const float rstd = 1.0f / sqrtf(wave_sum(s) * (1.f / D) + EPS);
#pragma unroll
        for (int j = 0; j < 4; ++j) { const f32x4 gg = gr[64 * j]; v[j] = v[j] * rstd * gg; }
        GAS unsigned long long* o8 = (GAS unsigned long long*)(dstb + (size_t)m * D) + F.lane;
#pragma unroll
        for (int j = 0; j < 4; ++j) o8[64 * j] = (unsigned long long)pk2(v[j].x, v[j].y) | ((unsigned long long)pk2(v[j].z, v[j].w) << 32);
        if (IS_X) {
            float fl[8];
#pragma unroll
            for (int c = 0; c < 8; ++c) fl[c] = 0.f;
#pragma unroll
            for (int j = 0; j < 4; ++j)
#pragma unroll
                for (int e = 0; e < 4; ++e) { const int d = 256 * j + 4 * F.lane + e; const float hv = v[j][e];
                    const f32x4 w0 = *(const LAS f32x4*)(wf + d * 8), w1 = *(const LAS f32x4*)(wf + d * 8 + 4);
                    fl[0] += hv * w0.x; fl[1] += hv * w0.y; fl[2] += hv * w0.z; fl[3] += hv * w0.w; fl[4] += hv * w1.x; fl[5] += hv * w1.y; fl[6] += hv * w1.z; fl[7] += hv * w1.w; }
            float mine = 0.f;
#pragma unroll
            for (int c = 0; c < 8; ++c) { const float t = wave_sum(fl[c]); if (F.lane == c) mine = t; }
            if (F.lane < 8) F.logf[(size_t)m * 8 + F.lane] = log_sigmoid_f(mine + F.b_forget[F.lane]);
        }
    }
}
__device__ __forceinline__ void p0_prologue(Frame& F) {
    LAS float* scr = (LAS float*)(F.lds + F.wave * 8448);
    LAS float* wf = (LAS float*)(F.lds + 8 * 8448);
    for (int i = F.tid; i < D * 8; i += NTHREADS) wf[i] = F.w_in[(size_t)(i >> 3) * DIN + 3072 + (i & 7)];
    const int gw = F.vcu * NWAVES + F.wave, NGW = F.G * NWAVES;
    constexpr int I_IN = 16 * 208, I_MKV = 16 * 32, I_BR = 8 * 32, I_OUT = 16 * 32, I_UP = 16 * 128, I_DN = 64 * 32;
    constexpr int NITEMS = I_IN + I_MKV + 3 * I_BR + I_OUT + I_UP + I_DN;
    for (int it = gw; it < NITEMS; it += NGW) {
        int r = it;
        if (r < I_IN) { const int kb = r / 208, gi = r % 208; tr_item(F.w_in, DIN, D, F.Win_t, proj_src_col(32 * gi), 32 * gi, 64 * kb, scr, F.lane); continue; } r -= I_IN;
        if (r < I_MKV) { const int kb = r / 32, gi = r % 32; tr_item(F.w_mkv, 1024, D, F.Wmkv_t, 32 * gi, 32 * gi, 64 * kb, scr, F.lane); continue; } r -= I_MKV;
        if (r < I_BR) { const int kb = r / 32, gi = r % 32; tr_item(F.w_bsb, D, DH, F.Wbr_t, 32 * gi, 32 * gi, 64 * kb, scr, F.lane); continue; } r -= I_BR;
        if (r < I_BR) { const int kb = r / 32, gi = r % 32; tr_item(F.w_bfx, D, DH, F.Wbr_t + (size_t)D * DH, 32 * gi, 32 * gi, 64 * kb, scr, F.lane); continue; } r -= I_BR;
        if (r < I_BR) { const int kb = r / 32, gi = r % 32; tr_item(F.w_bmm, D, DH, F.Wbr_t + (size_t)2 * D * DH, 32 * gi, 32 * gi, 64 * kb, scr, F.lane); continue; } r -= I_BR;
        if (r < I_OUT) { const int kb = r / 32, gi = r % 32; tr_item(F.w_out, D, D, F.Wout_t, 32 * gi, 32 * gi, 64 * kb, scr, F.lane); continue; } r -= I_OUT;
        if (r < I_UP) { const int kb = r / 128, gi = r % 128; tr_item(F.w_up, FF, D, F.Wup_t, 32 * gi, 32 * gi, 64 * kb, scr, F.lane, F.g_mlp); continue; } r -= I_UP;
        { const int kb = r / 32, gi = r % 32; tr_item(F.w_dn, D, FF, F.Wdn_t, 32 * gi, 32 * gi, 64 * kb, scr, F.lane); }
    }
    __syncthreads();
    p0_rows<true>(F, F.x, F.g_mix, F.XN, M, wf, gw, NGW);
    p0_rows<false>(F, F.mem, F.g_memn, F.MHb, MROWS, wf, gw, NGW);
}

template <class Epi>
__device__ __forceinline__ void ngemm(const bf16* A, int lda, const bf16* Bt, int ldb, int Mr, int Nc, int K, const Epi& E, int wg, int nwg) {
    const int tid = threadIdx.x, lane = tid & 63, wid = tid >> 6, wm = wid >> 1, wn = wid & 1;
    const int tilesN = Nc / 128, ntiles = (Mr / 128) * tilesN;
    for (int t = wg; t < ntiles; t += nwg) {
        const int tm = t / tilesN, tn = t % tilesN, r0 = tm * 128 + wm * 32, c0 = tn * 128 + wn * 64;
        f32x4 acc[2][4];
#pragma unroll
        for (int m = 0; m < 2; ++m)
#pragma unroll
            for (int n = 0; n < 4; ++n) acc[m][n] = (f32x4){0.f, 0.f, 0.f, 0.f};
        const bf16* ap = A + (size_t)(r0 + (lane & 15)) * lda + 8 * (lane >> 4);
        const bf16* bp = Bt + (size_t)(c0 + (lane & 15)) * ldb + 8 * (lane >> 4);
        for (int k0 = 0; k0 < K; k0 += 32) {
            bf16x8 a[2], b[4];
#pragma unroll
            for (int m = 0; m < 2; ++m) a[m] = *(const bf16x8*)(ap + (size_t)(m * 16) * lda + k0);
#pragma unroll
            for (int n = 0; n < 4; ++n) b[n] = *(const bf16x8*)(bp + (size_t)(n * 16) * ldb + k0);
#pragma unroll
            for (int m = 0; m < 2; ++m)
#pragma unroll
                for (int n = 0; n < 4; ++n) acc[m][n] = __builtin_amdgcn_mfma_f32_16x16x32_bf16(a[m], b[n], acc[m][n], 0, 0, 0);
        }
#pragma unroll
        for (int m = 0; m < 2; ++m)
#pragma unroll
            for (int n = 0; n < 4; ++n)
#pragma unroll
                for (int j = 0; j < 4; ++j) E(r0 + m * 16 + (lane >> 4) * 4 + j, c0 + n * 16 + (lane & 15), acc[m][n][j]);
    }
}

struct EpiProjN {
    bf16 *SBQ, *G0, *G2;
    __device__ __forceinline__ void operator()(int row, int n, float v) const {
        const int pn = n >> 8, j = n & 255;
        if (pn < 12) { const int T = pn >> 1, bj = j >> 7, wc = (j >> 5) & 3, e = j & 31, c = ((pn & 1) * 4 + wc) * 64 + bj * 32 + e;
            if (T == 0) v *= C2;
            (SBQ + (size_t)T * M * DH)[(size_t)row * DH + c] = (bf16)f2bf(v); }
        else if (pn < 14) { (SBQ + (size_t)6 * M * DH)[(size_t)row * DH + (n - 12 * 256)] = (bf16)f2bf(v); }
        else { const int g = (pn - 14) >> 2, c = n - (14 + 4 * g) * 256; bf16* G = g < 2 ? G0 + (size_t)g * M * D : G2;
            G[(size_t)row * D + c] = (bf16)f2bf(1.0f / (1.0f + expf(-v))); }
    }
};
struct EpiMkvN { float* MKf; bf16* MV;
    __device__ __forceinline__ void operator()(int row, int n, float v) const { if (n < DH) MKf[(size_t)row * DH + n] = v; else MV[(size_t)row * DH + (n - DH)] = (bf16)f2bf(v); } };
struct EpiOutN { const float* x; float* x1; bf16* A2;
    __device__ __forceinline__ void operator()(int row, int n, float v) const { const size_t o = (size_t)row * D + n; const float r = x[o] + v; x1[o] = r; A2[o] = (bf16)f2bf(r); } };
struct EpiUpN { const float* ssq; bf16* U;
    __device__ __forceinline__ void operator()(int row, int n, float v) const {
        const f32x4* p = (const f32x4*)(ssq + (size_t)row * 16); const f32x4 a = p[0], b = p[1], c = p[2], d = p[3];
        const float ss = ((a.x + a.y) + (a.z + a.w)) + ((b.x + b.y) + (b.z + b.w)) + ((c.x + c.y) + (c.z + c.w)) + ((d.x + d.y) + (d.z + d.w));
        (void)ss; const float r = fmaxf(v, 0.f); U[(size_t)row * FF + n] = (bf16)f2bf(r * r); } };
struct EpiDnN { float* out; const float* ssq;
    __device__ __forceinline__ void operator()(int row, int n, float v) const { const size_t o = (size_t)row * D + n;
        const f32x4* p = (const f32x4*)(ssq + (size_t)row * 16); const f32x4 a = p[0], b = p[1], c = p[2], d = p[3];
        const float ss = ((a.x + a.y) + (a.z + a.w)) + ((b.x + b.y) + (b.z + b.w)) + ((c.x + c.y) + (c.z + c.w)) + ((d.x + d.y) + (d.z + d.w));
        out[o] = out[o] + v / (ss * (1.f / D) + EPS); } };

__device__ __forceinline__ void fcumsum(Frame& F) {
    const int gw = F.vcu * NWAVES + F.wave;
    if (gw >= BATCH * NH) return;
    const int b = gw >> 3, h = gw & 7;
    const float* src = F.logf + ((size_t)b * SEQ + 32 * F.lane) * 8 + h;
    float tot = 0.f;
    for (int i = 0; i < 32; ++i) tot += src[i * 8];
    float incl = tot;
#pragma unroll
    for (int off = 1; off < 64; off <<= 1) { const float y = __shfl_up(incl, off); if (F.lane >= off) incl += y; }
    float run = incl - tot;
    float* dst = F.FC + (size_t)gw * SEQ + 32 * F.lane;
    for (int i = 0; i < 32; ++i) { run += src[i * 8]; dst[i] = run; }
}

__device__ __forceinline__ void headnorm_naive(Frame& F) {
    const int gw = F.vcu * NWAVES + F.wave, NGW = F.G * NWAVES;
    for (int it = gw; it < 2 * M; it += NGW) {
        const int which = it / M, row = it % M;
        bf16* p = F.FXQ + (size_t)which * M * DH + (size_t)row * DH + 8 * F.lane;
        const v4u w = *(const v4u*)p; float v[8] = {bflo(w.x), bfhi(w.x), bflo(w.y), bfhi(w.y), bflo(w.z), bfhi(w.z), bflo(w.w), bfhi(w.w)};
        float s = 0.f;
#pragma unroll
        for (int i = 0; i < 8; ++i) s += v[i] * v[i];
        s += __shfl_xor(s, 1); s += __shfl_xor(s, 2); s += __shfl_xor(s, 4);
        const float sc = (1.0f / sqrtf(s * (1.f / HD) + EPS)) * (which == 0 ? C2 : 1.0f);
#pragma unroll
        for (int i = 0; i < 8; ++i) v[i] = v[i] * sc;
        v4u o; o.x = pk2(v[0], v[1]); o.y = pk2(v[2], v[3]); o.z = pk2(v[4], v[5]); o.w = pk2(v[6], v[7]);
        *(v4u*)p = o;
    }
}

template <int MODE>
__device__ __forceinline__ void nattn64(const bf16* Q, const bf16* K, const bf16* V, bf16* O, const float* FC, const float* gq, const float* gk, int wg, int nwg) {
    const int tid = threadIdx.x, half = tid & 1;
    for (int u = wg; u < 512; u += nwg) {
        const int b = u >> 6, h = (u >> 3) & 7, blk = u & 7, t = blk * 256 + (tid >> 1); const size_t row = (size_t)b * SEQ + t;
        float q[32], o[32];
        { const v4u* qp = (const v4u*)(Q + row * DH + h * HD + half * 32);
#pragma unroll
          for (int i = 0; i < 4; ++i) { const v4u w = qp[i]; q[8 * i] = bflo(w.x); q[8 * i + 1] = bfhi(w.x); q[8 * i + 2] = bflo(w.y); q[8 * i + 3] = bfhi(w.y); q[8 * i + 4] = bflo(w.z); q[8 * i + 5] = bfhi(w.z); q[8 * i + 6] = bflo(w.w); q[8 * i + 7] = bfhi(w.w); } }
        if (MODE == 1) {
#pragma unroll
            for (int d = 0; d < 32; ++d) q[d] *= gq[half * 32 + d] * gk[half * 32 + d]; }
#pragma unroll
        for (int d = 0; d < 32; ++d) o[d] = 0.f;
        const int kend = blk * 256 + 256;
        const bf16* Kb = K + (size_t)b * SEQ * DH + h * HD + half * 32; const bf16* Vb = V + (size_t)b * SEQ * DH + h * HD + half * 32;
        const float* Fs = FC + (size_t)(b * NH + h) * SEQ;
        float carry = 0.f, mrun = -1e30f, lrun = 0.f;
        for (int i = 0; i < kend; ++i) {
            const int s = MODE == 0 ? kend - 1 - i : i;
            const v4u* kp = (const v4u*)(Kb + (size_t)s * DH); const v4u* vp = (const v4u*)(Vb + (size_t)s * DH);
            float z = 0.f;
#pragma unroll
            for (int c = 0; c < 4; ++c) { const v4u w = kp[c];
                z += q[8 * c] * bflo(w.x) + q[8 * c + 1] * bfhi(w.x) + q[8 * c + 2] * bflo(w.y) + q[8 * c + 3] * bfhi(w.y) + q[8 * c + 4] * bflo(w.z) + q[8 * c + 5] * bfhi(w.z) + q[8 * c + 6] * bflo(w.w) + q[8 * c + 7] * bfhi(w.w); }
            z += __shfl_xor(z, 1);
            float wgt;
            if (MODE == 0) {
                const float zn = z * LN2; const bool strict = s < t;
                const float lr = log_sigmoid_f(-zn), ls = zn + lr;
                wgt = strict ? expf(ls + carry) : 0.f; carry += strict ? lr : 0.f;
            } else {
                const float z2 = (s <= t) ? z - Fs[s] * LOG2E : -1e30f;
                const float mn = fmaxf(mrun, z2), al = exp2f(mrun - mn); wgt = (s <= t) ? exp2f(z2 - mn) : 0.f;
                lrun = lrun * al + wgt; mrun = mn;
#pragma unroll
                for (int d = 0; d < 32; ++d) o[d] *= al;
            }
#pragma unroll
            for (int c = 0; c < 4; ++c) { const v4u w = vp[c];
                o[8 * c] += wgt * bflo(w.x); o[8 * c + 1] += wgt * bfhi(w.x); o[8 * c + 2] += wgt * bflo(w.y); o[8 * c + 3] += wgt * bfhi(w.y); o[8 * c + 4] += wgt * bflo(w.z); o[8 * c + 5] += wgt * bfhi(w.z); o[8 * c + 6] += wgt * bflo(w.w); o[8 * c + 7] += wgt * bfhi(w.w); }
        }
        const float inv = MODE == 0 ? 1.0f : 1.0f / lrun;
        v4u* op = (v4u*)(O + row * DH + h * HD + half * 32);
#pragma unroll
        for (int i = 0; i < 4; ++i) { v4u w; w.x = pk2(o[8 * i] * inv, o[8 * i + 1] * inv); w.y = pk2(o[8 * i + 2] * inv, o[8 * i + 3] * inv); w.z = pk2(o[8 * i + 4] * inv, o[8 * i + 5] * inv); w.w = pk2(o[8 * i + 6] * inv, o[8 * i + 7] * inv); op[i] = w; }
    }
}
__device__ __forceinline__ void nattn_mem(Frame& F, int wg, int nwg) {
    const int tid = threadIdx.x, qt = tid & 3;
    for (int u = wg; u < 512; u += nwg) {
        const int b = u >> 6, hm = (u >> 4) & 3, blk = u & 15, t = blk * 128 + (tid >> 2); const size_t row = (size_t)b * SEQ + t;
        float q[32], o[32];
        { const v4u* qp = (const v4u*)(F.MQ + row * DH + hm * MHD + qt * 32);
#pragma unroll
          for (int i = 0; i < 4; ++i) { const v4u w = qp[i]; q[8 * i] = bflo(w.x); q[8 * i + 1] = bfhi(w.x); q[8 * i + 2] = bflo(w.y); q[8 * i + 3] = bfhi(w.y); q[8 * i + 4] = bflo(w.z); q[8 * i + 5] = bfhi(w.z); q[8 * i + 6] = bflo(w.w); q[8 * i + 7] = bfhi(w.w); } }
        float ss = 0.f;
#pragma unroll
        for (int d = 0; d < 32; ++d) ss += q[d] * q[d];
        ss += __shfl_xor(ss, 1); ss += __shfl_xor(ss, 2);
        const float rq = (1.0f / sqrtf(ss * (1.f / MHD) + EPS)) * C2M;
#pragma unroll
        for (int d = 0; d < 32; ++d) { q[d] = q[d] * rq * F.g_mq[qt * 32 + d] * F.g_mk[qt * 32 + d]; o[d] = 0.f; }
        float mrun = -1e30f, lrun = 0.f;
        for (int key = 0; key < MEMLEN; ++key) {
            const f32x4* kp = (const f32x4*)(F.MKf + (size_t)(b * MEMLEN + key) * DH + hm * MHD + qt * 32);
            const v4u* vp = (const v4u*)(F.MV + (size_t)(b * MEMLEN + key) * DH + hm * MHD + qt * 32);
            float dot = 0.f, kss = 0.f;
#pragma unroll
            for (int c = 0; c < 8; ++c) { const f32x4 k4 = kp[c]; dot += q[4 * c] * k4.x + q[4 * c + 1] * k4.y + q[4 * c + 2] * k4.z + q[4 * c + 3] * k4.w; kss += k4.x * k4.x + k4.y * k4.y + k4.z * k4.z + k4.w * k4.w; }
            dot += __shfl_xor(dot, 1); dot += __shfl_xor(dot, 2); kss += __shfl_xor(kss, 1); kss += __shfl_xor(kss, 2);
            const float z2 = dot * (1.0f / sqrtf(kss * (1.f / MHD) + EPS));
            const float mn = fmaxf(mrun, z2), al = exp2f(mrun - mn), wgt = exp2f(z2 - mn);
            lrun = lrun * al + wgt; mrun = mn;
#pragma unroll
            for (int c = 0; c < 4; ++c) { const v4u w = vp[c];
                o[8 * c] = o[8 * c] * al + wgt * bflo(w.x); o[8 * c + 1] = o[8 * c + 1] * al + wgt * bfhi(w.x); o[8 * c + 2] = o[8 * c + 2] * al + wgt * bflo(w.y); o[8 * c + 3] = o[8 * c + 3] * al + wgt * bfhi(w.y);
                o[8 * c + 4] = o[8 * c + 4] * al + wgt * bflo(w.z); o[8 * c + 5] = o[8 * c + 5] * al + wgt * bfhi(w.z); o[8 * c + 6] = o[8 * c + 6] * al + wgt * bflo(w.w); o[8 * c + 7] = o[8 * c + 7] * al + wgt * bfhi(w.w); }
        }
        const float inv = 1.0f / lrun;
        v4u* op = (v4u*)(F.MQ + row * DH + hm * MHD + qt * 32);
#pragma unroll
        for (int i = 0; i < 4; ++i) { v4u w; w.x = pk2(o[8 * i] * inv, o[8 * i + 1] * inv); w.y = pk2(o[8 * i + 2] * inv, o[8 * i + 3] * inv); w.z = pk2(o[8 * i + 4] * inv, o[8 * i + 5] * inv); w.w = pk2(o[8 * i + 6] * inv, o[8 * i + 7] * inv); op[i] = w; }
    }
}

__device__ __forceinline__ void nmerged(Frame& F, int wg, int nwg) {
    const int tid = threadIdx.x, lane = tid & 63, wid = tid >> 6, wm = wid >> 1, wn = wid & 1;
    const int tilesN = D / 128, ntiles = (M / 128) * tilesN;
    for (int t = wg; t < ntiles; t += nwg) {
        const int tm = t / tilesN, tn = t % tilesN, r0 = tm * 128 + wm * 32, c0 = tn * 128 + wn * 64;
        f32x4 tot[2][4];
#pragma unroll
        for (int m = 0; m < 2; ++m)
#pragma unroll
            for (int n = 0; n < 4; ++n) tot[m][n] = (f32x4){0.f, 0.f, 0.f, 0.f};
#pragma unroll 1
        for (int br = 0; br < 3; ++br) {
            const bf16* A = F.SBQ + (size_t)br * 3 * M * DH; const bf16* Bt = F.Wbr_t + (size_t)br * D * DH; const bf16* G = br < 2 ? F.G0 + (size_t)br * M * D : F.G2;
            f32x4 acc[2][4];
#pragma unroll
            for (int m = 0; m < 2; ++m)
#pragma unroll
                for (int n = 0; n < 4; ++n) acc[m][n] = (f32x4){0.f, 0.f, 0.f, 0.f};
            const bf16* ap = A + (size_t)(r0 + (lane & 15)) * DH + 8 * (lane >> 4);
            const bf16* bp = Bt + (size_t)(c0 + (lane & 15)) * DH + 8 * (lane >> 4);
            for (int k0 = 0; k0 < DH; k0 += 32) {
                bf16x8 a[2], b[4];
#pragma unroll
                for (int m = 0; m < 2; ++m) a[m] = *(const bf16x8*)(ap + (size_t)(m * 16) * DH + k0);
#pragma unroll
                for (int n = 0; n < 4; ++n) b[n] = *(const bf16x8*)(bp + (size_t)(n * 16) * DH + k0);
#pragma unroll
                for (int m = 0; m < 2; ++m)
#pragma unroll
                    for (int n = 0; n < 4; ++n) acc[m][n] = __builtin_amdgcn_mfma_f32_16x16x32_bf16(a[m], b[n], acc[m][n], 0, 0, 0);
            }
#pragma unroll
            for (int m = 0; m < 2; ++m)
#pragma unroll
                for (int n = 0; n < 4; ++n)
#pragma unroll
                    for (int j = 0; j < 4; ++j) tot[m][n][j] += bf2f(G[(size_t)(r0 + m * 16 + (lane >> 4) * 4 + j) * D + c0 + n * 16 + (lane & 15)]) * acc[m][n][j];
        }
#pragma unroll
        for (int m = 0; m < 2; ++m)
#pragma unroll
            for (int n = 0; n < 4; ++n)
#pragma unroll
                for (int j = 0; j < 4; ++j) F.MRG[(size_t)(r0 + m * 16 + (lane >> 4) * 4 + j) * D + c0 + n * 16 + (lane & 15)] = (bf16)f2bf(tot[m][n][j]);
    }
}
__device__ __forceinline__ void ssq_naive(Frame& F) {
    const int gw = F.vcu * NWAVES + F.wave, NGW = F.G * NWAVES;
    for (int m = gw; m < M; m += NGW) {
        const GAS f32x4* xr = (const GAS f32x4*)(F.out + (size_t)m * D) + F.lane; float s = 0.f;
#pragma unroll
        for (int j = 0; j < 4; ++j) { const f32x4 v = xr[64 * j]; s += (v.x * v.x + v.y * v.y) + (v.z * v.z + v.w * v.w); }
        s = wave_sum(s);
        if (F.lane < 16) F.ssq[(size_t)m * 16 + F.lane] = F.lane == 0 ? s : 0.f;

    }
}

namespace pg8 {
#define PG8_LAS __attribute__((address_space(3)))
typedef unsigned short bf16_t;
typedef unsigned u32x4 __attribute__((ext_vector_type(4)));
typedef unsigned u32x2 __attribute__((ext_vector_type(2)));
constexpr int BM = 256, BK = 64, HALF = 128, HTB = HALF * BK * 2, STAGE_BYTES = 8 * HTB, NXCD = 8, WGM = 8;
__host__ __device__ __forceinline__ int lds_byte(int r, int c) { const int st = (r >> 4) * 2 + (c >> 5), rr = r & 15, cc = c & 31, ob = rr * 64 + cc * 2; return st * 1024 + (ob ^ (((ob >> 9) & 1) << 5)); }
__host__ __device__ __forceinline__ void stage_rc(int b, int& R, int& C) { const int st = b / 1024, sb = b % 1024, swz = sb ^ (((sb >> 9) & 1) << 5); R = (st >> 1) * 16 + swz / 64; C = (st & 1) * 32 + (swz % 64) / 2; }
__host__ __device__ __forceinline__ int perm32(int rho) { const int n = rho >> 4, i = rho & 15; return 8 * (i >> 2) + 4 * n + (i & 3); }
struct Unit { int pm, pn, br; };
__device__ __forceinline__ unsigned cvt_pk_bf16(float lo, float hi) { unsigned r; asm volatile("v_cvt_pk_bf16_f32 %0, %1, %2" : "=v"(r) : "v"(lo), "v"(hi)); return r; }
__device__ __forceinline__ float bflo(unsigned w) { return __uint_as_float(w << 16); }
__device__ __forceinline__ float bfhi(unsigned w) { return __uint_as_float(w & 0xffff0000u); }

__device__ __forceinline__ float xsum16(float v) { auto r = __builtin_amdgcn_permlane16_swap(__float_as_uint(v), __float_as_uint(v), false, false); return __uint_as_float(r[0]) + __uint_as_float(r[1]); }
__device__ __forceinline__ float xsum32(float v) { auto r = __builtin_amdgcn_permlane32_swap(__float_as_uint(v), __float_as_uint(v), false, false); return __uint_as_float(r[0]) + __uint_as_float(r[1]); }
__device__ __forceinline__ void static_tile(int L, int nM, int nN, int& pm, int& pn) {
    const int nwg = nM * nN; int wgid = L;
    { const int q = nwg / NXCD, r = nwg % NXCD, xcd = wgid % NXCD, off = wgid / NXCD; wgid = (xcd < r ? xcd * (q + 1) : r * (q + 1) + (xcd - r) * q) + off; }
    const int nig = WGM * nN, gid = wgid / nig, fm = gid * WGM, gsz = (nM - fm) < WGM ? (nM - fm) : WGM;
    pm = fm + ((wgid % nig) % gsz); pn = (wgid % nig) / gsz;
}
struct SchedPlain {
    int nM, nN, G, c; const char* A; const char* B; size_t tstep;
    __device__ __forceinline__ bool next(int i, Unit& u) const { const long L = (long)i * G + c; if (L >= (long)nM * nN) return false; static_tile((int)L, nM, nN, u.pm, u.pn); u.br = 0; return true; }
    __device__ __forceinline__ const char* a_ptr(const Unit& u) const { return A + (size_t)u.pm * tstep; }
    __device__ __forceinline__ const char* b_ptr(const Unit& u) const { return B + (size_t)u.pn * tstep; }
    __device__ __forceinline__ void a_ready(const Unit&) const {}
    __device__ __forceinline__ void done(const Unit&) const {}
};
struct SchedP1 {
    int G, c; const char* A; const char* B;
    __device__ __forceinline__ bool next(int i, Unit& u) const { const long L = (long)i * G + c; if (L >= 1696) return false;
        if (L < 1664) static_tile((int)L, 64, 26, u.pm, u.pn); else { const int r = (int)L - 1664; u.pm = 64 + (r >> 2); u.pn = 26 + (r & 3); } u.br = 0; return true; }
    __device__ __forceinline__ const char* a_ptr(const Unit& u) const { return A + (size_t)u.pm * (256 * 1024 * 2); }
    __device__ __forceinline__ const char* b_ptr(const Unit& u) const { return B + (size_t)u.pn * (256 * 1024 * 2); }
    __device__ __forceinline__ void a_ready(const Unit&) const {}
    __device__ __forceinline__ void done(const Unit&) const {}
};
struct SchedP3 {
    int G, c; const char* A; const char* B; int br;
    __device__ __forceinline__ bool next(int i, Unit& u) const { if (i >= 1 || c >= 256) return false; static_tile(c, 64, 4, u.pm, u.pn); u.br = br; return true; }
    __device__ __forceinline__ const char* a_ptr(const Unit& u) const { return A + (size_t)u.br * ((size_t)3 * M * DH * 2) + (size_t)u.pm * (256 * 512 * 2); }
    __device__ __forceinline__ const char* b_ptr(const Unit& u) const { return B + (size_t)u.br * ((size_t)D * DH * 2) + (size_t)u.pn * (256 * 512 * 2); }
    __device__ __forceinline__ void a_ready(const Unit&) const {}
    __device__ __forceinline__ void done(const Unit&) const {}
};

typedef f32x4 acc_t[2][2][4][2];
__device__ __forceinline__ u32x4 pack8(const f32x4 a, const f32x4 b) { u32x4 w; w.x = cvt_pk_bf16(a[0], a[1]); w.y = cvt_pk_bf16(a[2], a[3]); w.z = cvt_pk_bf16(b[0], b[1]); w.w = cvt_pk_bf16(b[2], b[3]); return w; }
__device__ __forceinline__ float sigm(float x) { return __builtin_amdgcn_rcpf(1.0f + __builtin_amdgcn_exp2f(-LOG2E * x)); }

struct EpiProj {
    static constexpr bool PERM = true, AFTER_DRAIN = false;
    bf16_t* SBQ; bf16_t* G0; bf16_t* G2; float* MKf; bf16_t* MV;
    __device__ __forceinline__ void operator()(const acc_t& acc, const Unit& u, int wr, int wc, int fr, int fq) const {
        const int pn = u.pn; const int row0 = u.pm * BM + wr * 64 + fr;
        if (pn < 12) {
            const int T = pn >> 1, hd = (pn & 1) * 4 + wc;
            bf16_t* base = SBQ + (size_t)T * M * DH + (size_t)row0 * DH + hd * 64 + 8 * fq;
            if (T == 3 || T == 4) {
                const float qs = T == 3 ? C2 : 1.0f;
#pragma unroll
                for (int ai = 0; ai < 2; ++ai)
#pragma unroll
                    for (int m = 0; m < 4; ++m) {
                        float ss = 0.f;
#pragma unroll
                        for (int bj = 0; bj < 2; ++bj)
#pragma unroll
                            for (int n = 0; n < 2; ++n) { const f32x4 x = acc[ai][bj][m][n]; ss += (x[0] * x[0] + x[1] * x[1]) + (x[2] * x[2] + x[3] * x[3]); }
                        ss = xsum16(ss); ss = xsum32(ss);
                        const float sc = qs / sqrtf(ss * (1.0f / HD) + EPS);
                        bf16_t* rowp = base + (size_t)(ai * HALF + m * 16) * DH;
#pragma unroll
                        for (int bj = 0; bj < 2; ++bj) *(u32x4*)(rowp + 32 * bj) = pack8(acc[ai][bj][m][0] * sc, acc[ai][bj][m][1] * sc);
                    }
            } else {
                const float sc = T == 0 ? C2 : 1.0f;
#pragma unroll
                for (int ai = 0; ai < 2; ++ai)
#pragma unroll
                    for (int m = 0; m < 4; ++m) { bf16_t* rowp = base + (size_t)(ai * HALF + m * 16) * DH;
#pragma unroll
                        for (int bj = 0; bj < 2; ++bj) *(u32x4*)(rowp + 32 * bj) = pack8(acc[ai][bj][m][0] * sc, acc[ai][bj][m][1] * sc); }
            }
        } else if (pn < 14) {
            bf16_t* base = SBQ + (size_t)6 * M * DH + (size_t)row0 * DH + (pn - 12) * 256 + wc * 32 + 8 * fq;
#pragma unroll
            for (int ai = 0; ai < 2; ++ai)
#pragma unroll
                for (int m = 0; m < 4; ++m) { bf16_t* rowp = base + (size_t)(ai * HALF + m * 16) * DH;
#pragma unroll
                    for (int bj = 0; bj < 2; ++bj) *(u32x4*)(rowp + HALF * bj) = pack8(acc[ai][bj][m][0], acc[ai][bj][m][1]); }
        } else if (pn < 26) {
            const int g = (pn - 14) >> 2; bf16_t* G = g < 2 ? G0 + (size_t)g * M * D : G2;
            bf16_t* base = G + (size_t)row0 * D + ((pn - 14) & 3) * 256 + wc * 32 + 8 * fq;
#pragma unroll
            for (int ai = 0; ai < 2; ++ai)
#pragma unroll
                for (int m = 0; m < 4; ++m) { bf16_t* rowp = base + (size_t)(ai * HALF + m * 16) * D;
#pragma unroll
                    for (int bj = 0; bj < 2; ++bj) { f32x4 a = acc[ai][bj][m][0], b = acc[ai][bj][m][1];
#pragma unroll
                        for (int e = 0; e < 4; ++e) { a[e] = sigm(a[e]); b[e] = sigm(b[e]); }
                        *(u32x4*)(rowp + HALF * bj) = pack8(a, b); } }
        } else {
            const int mrow0 = (u.pm - 64) * BM + wr * 64 + fr, pl = pn - 26;
            if (pl < 2) { float* base = MKf + (size_t)mrow0 * DH + pl * 256 + wc * 32 + 8 * fq;
#pragma unroll
                for (int ai = 0; ai < 2; ++ai)
#pragma unroll
                    for (int m = 0; m < 4; ++m) { float* rowp = base + (size_t)(ai * HALF + m * 16) * DH;
#pragma unroll
                        for (int bj = 0; bj < 2; ++bj) { *(f32x4*)(rowp + HALF * bj) = acc[ai][bj][m][0]; *(f32x4*)(rowp + HALF * bj + 4) = acc[ai][bj][m][1]; } }
            } else { bf16_t* base = MV + (size_t)mrow0 * DH + (pl - 2) * 256 + wc * 32 + 8 * fq;
#pragma unroll
                for (int ai = 0; ai < 2; ++ai)
#pragma unroll
                    for (int m = 0; m < 4; ++m) { bf16_t* rowp = base + (size_t)(ai * HALF + m * 16) * DH;
#pragma unroll
                        for (int bj = 0; bj < 2; ++bj) *(u32x4*)(rowp + HALF * bj) = pack8(acc[ai][bj][m][0], acc[ai][bj][m][1]); } }
        }
    }
};
struct EpiMerged {
    static constexpr bool PERM = true, AFTER_DRAIN = true;
    const bf16_t* G0; const bf16_t* G2; float* T1; float* T2; bf16_t* MRG;
    __device__ __forceinline__ void fused(const acc_t& acc, const Unit& u, int wr, int wc, int fr, int fq, PG8_LAS unsigned char*, int, int) const {
        const int br = u.br; const int row0 = u.pm * BM + wr * 64 + fr, col0 = u.pn * BM + wc * 32 + 8 * fq;
        const bf16_t* G = (br < 2 ? G0 + (size_t)br * M * D : G2) + (size_t)row0 * D + col0;
        float* T = (u.pn < 2 ? T1 : T2) + (size_t)row0 * 512 + (col0 & 511);
        bf16_t* O = MRG + (size_t)row0 * D + col0;
#pragma unroll
        for (int ai = 0; ai < 2; ++ai)
#pragma unroll
            for (int m = 0; m < 4; ++m) { const size_t ro = (size_t)(ai * HALF + m * 16);
#pragma unroll
                for (int bj = 0; bj < 2; ++bj) {
                    const u32x4 gw = *(const u32x4*)(G + ro * D + HALF * bj);
                    f32x4 a = acc[ai][bj][m][0], b = acc[ai][bj][m][1];
                    a[0] *= bflo(gw.x); a[1] *= bfhi(gw.x); a[2] *= bflo(gw.y); a[3] *= bfhi(gw.y); b[0] *= bflo(gw.z); b[1] *= bfhi(gw.z); b[2] *= bflo(gw.w); b[3] *= bfhi(gw.w);
                    float* tp = T + ro * 512 + HALF * bj;
                    if (br > 0) { a += *(const f32x4*)tp; b += *(const f32x4*)(tp + 4); }
                    if (br < 2) { *(f32x4*)tp = a; *(f32x4*)(tp + 4) = b; } else *(u32x4*)(O + ro * D + HALF * bj) = pack8(a, b);
                }
                if (m & 1) asm volatile("" ::: "memory"); }
    }
};
struct EpiOut {
    static constexpr bool PERM = false, AFTER_DRAIN = true;
    const float* x; float* x1; bf16_t* A2; float* ssq;
    __device__ __forceinline__ void fused(const acc_t& acc, const Unit& u, int wr, int wc, int fr, int fq, PG8_LAS unsigned char*, int, int) const {
        const int row0 = u.pm * BM + wr * 64 + fr, col0 = u.pn * BM + wc * 32 + 4 * fq;
#pragma unroll
        for (int ai = 0; ai < 2; ++ai)
#pragma unroll
            for (int m = 0; m < 4; ++m) { const int row = row0 + ai * HALF + m * 16; const size_t off = (size_t)row * D + col0; float ss = 0.f;
#pragma unroll
                for (int bj = 0; bj < 2; ++bj)
#pragma unroll
                    for (int n = 0; n < 2; ++n) { const size_t o = off + bj * HALF + n * 16; const f32x4 r = *(const f32x4*)(x + o) + acc[ai][bj][m][n];
                        *(f32x4*)(x1 + o) = r; ss += (r[0] * r[0] + r[1] * r[1]) + (r[2] * r[2] + r[3] * r[3]);
                        u32x2 w; w.x = cvt_pk_bf16(r[0], r[1]); w.y = cvt_pk_bf16(r[2], r[3]); *(u32x2*)(A2 + o) = w; }
                (void)ss;
                if (m & 1) asm volatile("" ::: "memory"); }
    }
};
struct EpiUp {
    static constexpr bool PERM = true, AFTER_DRAIN = false;
    bf16_t* U;
    __device__ __forceinline__ void operator()(const acc_t& acc, const Unit& u, int wr, int wc, int fr, int fq) const {
        const int row0 = u.pm * BM + wr * 64 + fr; bf16_t* base = U + (size_t)row0 * FF + u.pn * BM + wc * 32 + 8 * fq;
#pragma unroll
        for (int ai = 0; ai < 2; ++ai)
#pragma unroll
            for (int m = 0; m < 4; ++m) { bf16_t* rowp = base + (size_t)(ai * HALF + m * 16) * FF;
#pragma unroll
                for (int bj = 0; bj < 2; ++bj) { f32x4 a = acc[ai][bj][m][0], b = acc[ai][bj][m][1];
#pragma unroll
                    for (int e = 0; e < 4; ++e) { const float ta = fmaxf(a[e], 0.f), tb = fmaxf(b[e], 0.f); a[e] = ta * ta; b[e] = tb * tb; }
                    *(u32x4*)(rowp + HALF * bj) = pack8(a, b); } }
    }
};
struct EpiDown {
    static constexpr bool PERM = false, AFTER_DRAIN = true;
    float* out; const float* ssq;
    __device__ __forceinline__ void fused(const acc_t& acc, const Unit& u, int wr, int wc, int fr, int fq, PG8_LAS unsigned char*, int, int) const {
        const int row0 = u.pm * BM + wr * 64 + fr, col0 = u.pn * BM + wc * 32 + 4 * fq;
#pragma unroll
        for (int ai = 0; ai < 2; ++ai)
#pragma unroll
            for (int m = 0; m < 4; ++m) { const int row = row0 + ai * HALF + m * 16; const size_t off = (size_t)row * D + col0;
                const f32x4* p = (const f32x4*)(ssq + (size_t)row * 16); const f32x4 a = p[0], b = p[1], c = p[2], d = p[3];
                const float ss = ((a[0] + a[1]) + (a[2] + a[3])) + ((b[0] + b[1]) + (b[2] + b[3])) + ((c[0] + c[1]) + (c[2] + c[3])) + ((d[0] + d[1]) + (d[2] + d[3]));
                const float r2 = 1.0f / (ss * (1.0f / D) + EPS);
#pragma unroll
                for (int bj = 0; bj < 2; ++bj)
#pragma unroll
                    for (int n = 0; n < 2; ++n) { float* q = out + off + bj * HALF + n * 16; *(f32x4*)q = *(const f32x4*)q + acc[ai][bj][m][n] * r2; }
                if (m & 1) asm volatile("" ::: "memory"); }
    }
};

template <class Epi, class Sched, bool ALIGN_EPI = false, bool SP2 = false>
__device__ __forceinline__ void gemm_phase(PG8_LAS unsigned char* lds, const int K, const Sched& S, const Epi& E) {
    const int tid = threadIdx.x, wid = __builtin_amdgcn_readfirstlane(tid >> 6), lane = tid & 63, wr = wid >> 2, wc = wid & 3, fr = lane & 15, fq = lane >> 4;
    const int nt = K / BK;
    unsigned voffA[2], voffB[2];
#pragma unroll
    for (int i = 0; i < 2; ++i) { int R, C; stage_rc(tid * 16 + i * 8192, R, C); const int Rb = Epi::PERM ? ((R & ~31) + perm32(R & 31)) : R;
        voffA[i] = (unsigned)(R * K + C) * 2u; voffB[i] = (unsigned)(Rb * K + C) * 2u; }
    const size_t kstep = (size_t)(BK * 2);
    const size_t hstep = (size_t)HALF * K * 2;
    const unsigned ldsw = (unsigned)wid * 1024u;
    const int aoff = lds_byte(wr * 64 + fr, fq * 8), boff = lds_byte(wc * 32 + fr, fq * 8);
#define PG8_SA(b, h) (((b) * 2 + (h)) * HTB)
#define PG8_SB(b, h) ((4 + (b) * 2 + (h)) * HTB)
#define PG8_STAGE(bufoff, gbase, voff) do { _Pragma("unroll") for (int _i = 0; _i < 2; ++_i) \
        __builtin_amdgcn_global_load_lds((const unsigned*)((const char*)(gbase) + (voff)[_i]), (PG8_LAS unsigned*)(lds + (bufoff) + ldsw + _i * 8192), 16, 0, 0); } while (0)
#define PG8_LDA(dst, b, h) do { _Pragma("unroll") for (int m = 0; m < 4; ++m) _Pragma("unroll") for (int k = 0; k < 2; ++k) dst[m][k] = *(const PG8_LAS bf16x8*)(lds + PG8_SA(b, h) + aoff + m * 2048 + k * 1024); } while (0)
#define PG8_LDB(dst, b, h) do { _Pragma("unroll") for (int n = 0; n < 2; ++n) _Pragma("unroll") for (int k = 0; k < 2; ++k) dst[n][k] = *(const PG8_LAS bf16x8*)(lds + PG8_SB(b, h) + boff + n * 2048 + k * 1024); } while (0)
#define PG8_MMA(ai, bj, At, Bt) do { __builtin_amdgcn_s_setprio(1); _Pragma("unroll") for (int m = 0; m < 4; ++m) _Pragma("unroll") for (int n = 0; n < 2; ++n) _Pragma("unroll") for (int k = 0; k < 2; ++k) \
        acc[ai][bj][m][n] = __builtin_amdgcn_mfma_f32_16x16x32_bf16(Bt[n][k], At[m][k], acc[ai][bj][m][n], 0, 0, 0); __builtin_amdgcn_s_setprio(0); } while (0)
#define PG8_WAIT_V(n) asm volatile("s_waitcnt vmcnt(" #n ")" ::: "memory")
#define PG8_WAIT_L(n) asm volatile("s_waitcnt lgkmcnt(" #n ")" ::: "memory")
#define PG8_BAR __builtin_amdgcn_s_barrier()
#define PG8_SCHED __builtin_amdgcn_sched_barrier(0)
    Unit cur, nxt; int ui = 0;
    if (!S.next(0, cur)) return;
    f32x4 acc[2][2][4][2];
#pragma unroll
    for (int a = 0; a < 2; ++a)
#pragma unroll
        for (int b = 0; b < 2; ++b)
#pragma unroll
            for (int m = 0; m < 4; ++m)
#pragma unroll
                for (int n = 0; n < 2; ++n) acc[a][b][m][n] = (f32x4){0.f, 0.f, 0.f, 0.f};
    bf16x8 At[4][2], B0[2][2], B1[2][2];
    const char* cA = S.a_ptr(cur); const char* cB = S.b_ptr(cur);
    S.a_ready(cur);
    if constexpr (SP2) {
        PG8_STAGE(PG8_SB(0, 0), cB, voffB); PG8_STAGE(PG8_SB(0, 1), cB + hstep, voffB); PG8_STAGE(PG8_SA(0, 0), cA, voffA); PG8_STAGE(PG8_SA(0, 1), cA + hstep, voffA);
        if (wr == 1) PG8_BAR;
        PG8_WAIT_V(2); PG8_BAR;
        PG8_STAGE(PG8_SB(1, 0), cB + kstep, voffB); PG8_STAGE(PG8_SA(1, 0), cA + kstep, voffA); PG8_STAGE(PG8_SB(1, 1), cB + hstep + kstep, voffB);
        PG8_WAIT_V(6); PG8_BAR;
    } else {
        PG8_STAGE(PG8_SB(0, 0), cB, voffB); PG8_STAGE(PG8_SA(0, 0), cA, voffA); PG8_STAGE(PG8_SB(0, 1), cB + hstep, voffB); PG8_STAGE(PG8_SA(0, 1), cA + hstep, voffA);
        if (wr == 1) PG8_BAR;
        PG8_WAIT_V(4); PG8_BAR;
        PG8_STAGE(PG8_SB(1, 0), cB + kstep, voffB); PG8_STAGE(PG8_SA(1, 0), cA + kstep, voffA); PG8_STAGE(PG8_SB(1, 1), cB + hstep + kstep, voffB);
        PG8_WAIT_V(6); PG8_BAR;
    }
    for (;;) {
        const bool has_next = S.next(ui + 1, nxt);
        const char* nA = has_next ? S.a_ptr(nxt) : cA; const char* nB = has_next ? S.b_ptr(nxt) : cB;
        for (int t = 0; t < nt; t += 2) {
            const bool last = (t == nt - 2);
            const char* a1 = cA + (size_t)(t + 1) * kstep;
            const char* a2 = last ? nA : cA + (size_t)(t + 2) * kstep; const char* b2 = last ? nB : cB + (size_t)(t + 2) * kstep;
            const char* a3 = a2 + kstep; const char* b3 = b2 + kstep;
            if (last && has_next) S.a_ready(nxt);
            if constexpr (SP2) {
            PG8_LDB(B0, 0, 0); PG8_LDB(B1, 0, 1); PG8_SCHED; PG8_LDA(At, 0, 0); PG8_STAGE(PG8_SA(1, 1), a1 + hstep, voffA);
            PG8_WAIT_V(8); PG8_WAIT_L(0); PG8_BAR; PG8_MMA(0, 0, At, B0); PG8_MMA(0, 1, At, B1); PG8_BAR; PG8_SCHED;
            PG8_LDA(At, 0, 1); PG8_STAGE(PG8_SB(0, 0), b2, voffB); PG8_STAGE(PG8_SB(0, 1), b2 + hstep, voffB); PG8_STAGE(PG8_SA(0, 0), a2, voffA);
            PG8_WAIT_V(8); PG8_WAIT_L(0); PG8_BAR; PG8_MMA(1, 0, At, B0); PG8_MMA(1, 1, At, B1); PG8_BAR; PG8_SCHED;
            PG8_LDB(B0, 1, 0); PG8_LDB(B1, 1, 1); PG8_SCHED; PG8_LDA(At, 1, 0); PG8_STAGE(PG8_SA(0, 1), a2 + hstep, voffA);
            PG8_WAIT_V(8); PG8_WAIT_L(0); PG8_BAR; PG8_MMA(0, 0, At, B0); PG8_MMA(0, 1, At, B1); PG8_BAR; PG8_SCHED;
            PG8_LDA(At, 1, 1); PG8_STAGE(PG8_SB(1, 0), b3, voffB); PG8_STAGE(PG8_SB(1, 1), b3 + hstep, voffB); PG8_STAGE(PG8_SA(1, 0), a3, voffA);
            PG8_WAIT_V(8); PG8_WAIT_L(0); PG8_BAR; PG8_MMA(1, 0, At, B0); PG8_MMA(1, 1, At, B1); PG8_BAR; PG8_SCHED;
            } else {
            PG8_LDB(B0, 0, 0); PG8_SCHED; PG8_LDA(At, 0, 0); PG8_STAGE(PG8_SA(1, 1), a1 + hstep, voffA);
            PG8_WAIT_L(8); PG8_BAR; PG8_WAIT_L(0); PG8_MMA(0, 0, At, B0); PG8_BAR; PG8_SCHED;
            PG8_LDB(B1, 0, 1); PG8_STAGE(PG8_SB(0, 0), b2, voffB);
            PG8_BAR; PG8_WAIT_L(0); PG8_MMA(0, 1, At, B1); PG8_BAR;
            PG8_LDA(At, 0, 1); PG8_STAGE(PG8_SA(0, 0), a2, voffA);
            PG8_BAR; PG8_WAIT_L(0); PG8_MMA(1, 0, At, B0); PG8_BAR; PG8_SCHED;
            PG8_STAGE(PG8_SB(0, 1), b2 + hstep, voffB);
            PG8_WAIT_V(6); PG8_BAR; PG8_MMA(1, 1, At, B1); PG8_BAR;
            PG8_LDB(B0, 1, 0); PG8_SCHED; PG8_LDA(At, 1, 0); PG8_STAGE(PG8_SA(0, 1), a2 + hstep, voffA);
            PG8_WAIT_L(8); PG8_BAR; PG8_WAIT_L(0); PG8_MMA(0, 0, At, B0); PG8_BAR; PG8_SCHED;
            PG8_LDB(B1, 1, 1); PG8_STAGE(PG8_SB(1, 0), b3, voffB);
            PG8_BAR; PG8_WAIT_L(0); PG8_MMA(0, 1, At, B1); PG8_BAR;
            PG8_LDA(At, 1, 1); PG8_STAGE(PG8_SA(1, 0), a3, voffA);
            PG8_BAR; PG8_WAIT_L(0); PG8_MMA(1, 0, At, B0); PG8_BAR; PG8_SCHED;
            PG8_STAGE(PG8_SB(1, 1), b3 + hstep, voffB);
            PG8_WAIT_V(6); PG8_BAR; PG8_MMA(1, 1, At, B1); PG8_BAR;
            }
        }
        if constexpr (ALIGN_EPI) { if (wr == 0) PG8_BAR; }
        if constexpr (!Epi::AFTER_DRAIN) { E(acc, cur, wr, wc, fr, fq); S.done(cur); }
        if (!has_next) break;
#pragma unroll
        for (int a = 0; a < 2; ++a)
#pragma unroll
            for (int b = 0; b < 2; ++b)
#pragma unroll
                for (int m = 0; m < 4; ++m)
#pragma unroll
                    for (int n = 0; n < 2; ++n) acc[a][b][m][n] = (f32x4){0.f, 0.f, 0.f, 0.f};
        cur = nxt; cA = nA; cB = nB; ++ui;
        if constexpr (ALIGN_EPI) { if (wr == 1) PG8_BAR; }
    }
    PG8_WAIT_V(0);
    if constexpr (!ALIGN_EPI) { if (wr == 0) PG8_BAR; }
    PG8_BAR;
    if constexpr (Epi::AFTER_DRAIN) { E.fused(acc, cur, wr, wc, fr, fq, lds, wid, lane); S.done(cur); }
#undef PG8_SA
#undef PG8_SB
#undef PG8_STAGE
#undef PG8_LDA
#undef PG8_LDB
#undef PG8_MMA
#undef PG8_WAIT_V
#undef PG8_WAIT_L
#undef PG8_BAR
#undef PG8_SCHED
}
}

namespace att {
typedef float f32x16 __attribute__((ext_vector_type(16)));
typedef float f32x2_t __attribute__((ext_vector_type(2)));
typedef __bf16 bf16x2_t __attribute__((ext_vector_type(2)));
typedef unsigned u32x4 __attribute__((ext_vector_type(4)));
typedef unsigned u32x2 __attribute__((ext_vector_type(2)));
constexpr int KP = 72, VP = 68;
constexpr int BUF_K = 0, BUF_V = 64 * KP * 2, BUF_B = BUF_V + 64 * VP * 2, BUF_BYTES = BUF_B + 256;
__device__ __forceinline__ int crow(int r, int hi) { return (r & 3) + 8 * (r >> 2) + 4 * hi; }
__device__ __forceinline__ unsigned cvtpk(float lo, float hi) { f32x2_t v = {lo, hi}; bf16x2_t b = __builtin_convertvector(v, bf16x2_t); return __builtin_bit_cast(unsigned, b); }
__device__ __forceinline__ float other_half(float v, int hi) { auto r = __builtin_amdgcn_permlane32_swap(__float_as_uint(v), __float_as_uint(v), false, false); return __uint_as_float(hi ? r[0] : r[1]); }
#define ATT_MFMA(a, b, c) __builtin_amdgcn_mfma_f32_32x32x16_bf16(a, b, c, 0, 0, 0)

template <int MODE>
__device__ __forceinline__ void unit64(const bf16* Q, const bf16* K, const bf16* V, bf16* O, const float* FC, const float* gq, const float* gk, int b, int h, int qb, LAS unsigned char* lds) {
    const int tid = threadIdx.x, lane = tid & 63, r32 = lane & 31, hi = lane >> 5; const int wid = __builtin_amdgcn_readfirstlane(tid >> 6);
    const size_t rowbase = (size_t)b * SEQ; const int q0 = qb * 256, qw0 = q0 + wid * 32;
    bf16x8 qf[4];
    { const bf16* qp = Q + (rowbase + qw0 + r32) * DH + h * HD + 8 * hi;
#pragma unroll
      for (int d0 = 0; d0 < 4; ++d0) { v4u w = *(const v4u*)(qp + 16 * d0);
          if (MODE == 1) { const float* g1 = gq + 16 * d0 + 8 * hi; const float* g2 = gk + 16 * d0 + 8 * hi;
              w.x = cvtpk(bflo(w.x) * g1[0] * g2[0], bfhi(w.x) * g1[1] * g2[1]); w.y = cvtpk(bflo(w.y) * g1[2] * g2[2], bfhi(w.y) * g1[3] * g2[3]);
              w.z = cvtpk(bflo(w.z) * g1[4] * g2[4], bfhi(w.z) * g1[5] * g2[5]); w.w = cvtpk(bflo(w.w) * g1[6] * g2[6], bfhi(w.w) * g1[7] * g2[7]); }
          qf[d0] = __builtin_bit_cast(bf16x8, w); } }
    f32x16 o0 = {}, o1 = {};
    float carry = 1.0f, mrun = -1e30f, lrun = 0.f;
    const int NT = 4 * qb + 4;
    const int skey = tid >> 3, sch = tid & 7;
    const bf16* kg = K + (rowbase + skey) * DH + h * HD + sch * 8; const bf16* vg = V + (rowbase + skey) * DH + h * HD + sch * 8;
    const float* fg = FC + (size_t)(b * NH + h) * SEQ;
    v4u kreg, vreg; float breg = 0.f;
#define ATT_LOAD(t) do { kreg = *(const v4u*)(kg + (size_t)(t) * 64 * DH); vreg = *(const v4u*)(vg + (size_t)(t) * 64 * DH); if (MODE == 1 && tid < 64) breg = -fg[(t) * 64 + tid] * LOG2E; } while (0)
#define ATT_WRITE(bufo) do { LAS unsigned char* bb_ = lds + (bufo); *(LAS v4u*)(bb_ + BUF_K + (skey * KP + sch * 8) * 2) = kreg; \
        LAS unsigned short* vt_ = (LAS unsigned short*)(bb_ + BUF_V) + (sch * 8) * VP + skey; \
        vt_[0 * VP] = (unsigned short)(vreg.x & 0xffffu); vt_[1 * VP] = (unsigned short)(vreg.x >> 16); vt_[2 * VP] = (unsigned short)(vreg.y & 0xffffu); vt_[3 * VP] = (unsigned short)(vreg.y >> 16); \
        vt_[4 * VP] = (unsigned short)(vreg.z & 0xffffu); vt_[5 * VP] = (unsigned short)(vreg.z >> 16); vt_[6 * VP] = (unsigned short)(vreg.w & 0xffffu); vt_[7 * VP] = (unsigned short)(vreg.w >> 16); \
        if (MODE == 1 && tid < 64) *(LAS float*)(bb_ + BUF_B + tid * 4) = breg; } while (0)
    ATT_LOAD(NT - 1); ATT_WRITE(0); __syncthreads();
    for (int it = 0; it < NT; ++it) {
        const int kt = NT - 1 - it, cur = (it & 1) * BUF_BYTES, nxt = BUF_BYTES - cur;
        if (it + 1 < NT) ATT_LOAD(kt - 1);
        const int key0 = kt * 64;
        if (key0 <= qw0 + 31) {
            const LAS unsigned char* bb = lds + cur;
            f32x16 p0, p1;
            if (MODE == 1) { const LAS float* nb = (const LAS float*)(bb + BUF_B) + 4 * hi;
#pragma unroll
                for (int g = 0; g < 4; ++g) { const f32x4 a = *(const LAS f32x4*)(nb + 8 * g), c = *(const LAS f32x4*)(nb + 32 + 8 * g);
                    p0[4 * g] = a[0]; p0[4 * g + 1] = a[1]; p0[4 * g + 2] = a[2]; p0[4 * g + 3] = a[3]; p1[4 * g] = c[0]; p1[4 * g + 1] = c[1]; p1[4 * g + 2] = c[2]; p1[4 * g + 3] = c[3]; } }
            else { p0 = f32x16{}; p1 = f32x16{}; }
            { const LAS unsigned char* kb = bb + BUF_K + (r32 * KP + 8 * hi) * 2;
#pragma unroll
              for (int d0 = 0; d0 < 4; ++d0) { const bf16x8 a0 = *(const LAS bf16x8*)(kb + d0 * 32), a1 = *(const LAS bf16x8*)(kb + 32 * KP * 2 + d0 * 32);
                  p0 = ATT_MFMA(a0, qf[d0], p0); p1 = ATT_MFMA(a1, qf[d0], p1); } }
            const int qrow = qw0 + r32; const bool diag = key0 + 63 >= qw0;
            if (MODE == 0) {
                f32x16 rm0, rm1;
#pragma unroll
                for (int r = 0; r < 16; ++r) {
                    { const float z = p0[r], t = __builtin_amdgcn_exp2f(-__builtin_fabsf(z)), rc = __builtin_amdgcn_rcpf(1.0f + t), sm = t * rc; const bool pos = z >= 0.f; float be = pos ? rc : sm, re = pos ? sm : rc;
                      if (diag && key0 + crow(r, hi) >= qrow) { be = 0.f; re = 1.0f; } p0[r] = be; rm0[r] = re; }
                    { const float z = p1[r], t = __builtin_amdgcn_exp2f(-__builtin_fabsf(z)), rc = __builtin_amdgcn_rcpf(1.0f + t), sm = t * rc; const bool pos = z >= 0.f; float be = pos ? rc : sm, re = pos ? sm : rc;
                      if (diag && key0 + 32 + crow(r, hi) >= qrow) { be = 0.f; re = 1.0f; } p1[r] = be; rm1[r] = re; }
                }
                float gp[8], pg[8];
#pragma unroll
                for (int g = 0; g < 4; ++g) { gp[g] = (rm0[4 * g] * rm0[4 * g + 1]) * (rm0[4 * g + 2] * rm0[4 * g + 3]); gp[4 + g] = (rm1[4 * g] * rm1[4 * g + 1]) * (rm1[4 * g + 2] * rm1[4 * g + 3]); }
#pragma unroll
                for (int g = 0; g < 8; ++g) pg[g] = other_half(gp[g], hi);
                float run = carry;
#pragma unroll
                for (int g = 7; g >= 0; --g) {
                    const float aft = hi ? run : run * pg[g];
                    run = run * (gp[g] * pg[g]);
                    if (g >= 4) { const int r = 4 * (g - 4); const float a3 = aft, a2 = a3 * rm1[r + 3], a1 = a2 * rm1[r + 2], a0 = a1 * rm1[r + 1];
                        p1[r] *= a0; p1[r + 1] *= a1; p1[r + 2] *= a2; p1[r + 3] *= a3; }
                    else { const int r = 4 * g; const float a3 = aft, a2 = a3 * rm0[r + 3], a1 = a2 * rm0[r + 2], a0 = a1 * rm0[r + 1];
                        p0[r] *= a0; p0[r + 1] *= a1; p0[r + 2] *= a2; p0[r + 3] *= a3; }
                }
                carry = run;
            } else {
                if (diag) {
#pragma unroll
                    for (int r = 0; r < 16; ++r) { if (key0 + crow(r, hi) > qrow) p0[r] = -1e30f; if (key0 + 32 + crow(r, hi) > qrow) p1[r] = -1e30f; } }
                float mx = fmaxf(p0[0], p1[0]);
#pragma unroll
                for (int r = 1; r < 16; ++r) mx = fmaxf(mx, fmaxf(p0[r], p1[r]));
                mx = fmaxf(mx, other_half(mx, hi));
                const float mn = fmaxf(mrun, mx);
                if (__any(mn > mrun)) { const float al = __builtin_amdgcn_exp2f(mrun - mn); lrun *= al;
#pragma unroll
                    for (int r = 0; r < 16; ++r) { o0[r] *= al; o1[r] *= al; } }
                mrun = mn; float ls = 0.f;
#pragma unroll
                for (int r = 0; r < 16; ++r) { p0[r] = __builtin_amdgcn_exp2f(p0[r] - mn); p1[r] = __builtin_amdgcn_exp2f(p1[r] - mn); ls += p0[r] + p1[r]; }
                lrun += ls;
            }
            const LAS unsigned char* vb = bb + BUF_V + (r32 * VP + 4 * hi) * 2;
#pragma unroll
            for (int ks = 0; ks < 4; ++ks) {
                const int rb = 8 * (ks & 1); u32x4 pw;
                if (ks < 2) { pw.x = cvtpk(p0[rb], p0[rb + 1]); pw.y = cvtpk(p0[rb + 2], p0[rb + 3]); pw.z = cvtpk(p0[rb + 4], p0[rb + 5]); pw.w = cvtpk(p0[rb + 6], p0[rb + 7]); }
                else        { pw.x = cvtpk(p1[rb], p1[rb + 1]); pw.y = cvtpk(p1[rb + 2], p1[rb + 3]); pw.z = cvtpk(p1[rb + 4], p1[rb + 5]); pw.w = cvtpk(p1[rb + 6], p1[rb + 7]); }
                const bf16x8 pf = __builtin_bit_cast(bf16x8, pw);
                const int koff = (16 * ks) * 2;
                const u32x2 a0l = *(const LAS u32x2*)(vb + koff), a0h = *(const LAS u32x2*)(vb + koff + 16);
                const u32x2 a1l = *(const LAS u32x2*)(vb + 32 * VP * 2 + koff), a1h = *(const LAS u32x2*)(vb + 32 * VP * 2 + koff + 16);
                const u32x4 a0 = {a0l.x, a0l.y, a0h.x, a0h.y}, a1 = {a1l.x, a1l.y, a1h.x, a1h.y};
                o0 = ATT_MFMA(__builtin_bit_cast(bf16x8, a0), pf, o0); o1 = ATT_MFMA(__builtin_bit_cast(bf16x8, a1), pf, o1);
            }
        }
        if (it + 1 < NT) ATT_WRITE(nxt);
        __syncthreads();
    }
    float inv = 1.0f;
    if (MODE == 1) { const float lt = lrun + other_half(lrun, hi); inv = 1.0f / lt; }
    bf16* op = O + (rowbase + qw0 + r32) * DH + h * HD + 4 * hi;
#pragma unroll
    for (int g = 0; g < 4; ++g) { u32x2 w0, w1; w0.x = cvtpk(o0[4 * g] * inv, o0[4 * g + 1] * inv); w0.y = cvtpk(o0[4 * g + 2] * inv, o0[4 * g + 3] * inv);
        w1.x = cvtpk(o1[4 * g] * inv, o1[4 * g + 1] * inv); w1.y = cvtpk(o1[4 * g + 2] * inv, o1[4 * g + 3] * inv);
        *(u32x2*)(op + 8 * g) = w0; *(u32x2*)(op + 32 + 8 * g) = w1; }
#undef ATT_LOAD
#undef ATT_WRITE
}
}

constexpr int N_PHASES = 9;
#ifndef OPT_P1
#define OPT_P1 1
#endif
#ifndef OPT_P3
#define OPT_P3 1
#endif
#ifndef OPT_ATT
#define OPT_ATT 1
#endif
#ifndef OPT_P4
#define OPT_P4 1
#endif
#ifndef OPT_P5
#define OPT_P5 1
#endif
#ifndef OPT_P6
#define OPT_P6 1
#endif
#ifndef MK_N_LAUNCHES
#define MK_N_LAUNCHES 1
#endif
constexpr int N_LAUNCHES = MK_N_LAUNCHES;
struct Args { const float* in[18]; float* out; unsigned char* ws; int ph_lo, ph_hi, li, pad; };

__global__ void __launch_bounds__(NTHREADS, 2) skel_fwd(Args args) {
    extern __shared__ __attribute__((aligned(16))) unsigned char lds[];
    Frame F;
    F.lds = (LAS unsigned char*)lds;
    F.MISC = (volatile LAS unsigned*)(F.lds + MISC_OFF);
    F.tid = threadIdx.x; F.lane = F.tid & 63; F.wave = __builtin_amdgcn_readfirstlane(F.tid >> 6);
    F.G = gridDim.x; { const int bx = blockIdx.x; F.vcu = (F.G % 8 == 0) ? (bx % 8) * (F.G / 8) + bx / 8 : bx; }
    unsigned char* ws = args.ws;
    F.ctl = (gu32*)(ws + WS_CTL);
    F.x = args.in[0]; F.mem = args.in[1]; F.g_mix = args.in[2]; F.g_memn = args.in[3]; F.w_in = args.in[4]; F.b_forget = args.in[5]; F.g_fq = args.in[6]; F.g_fk = args.in[7];
    F.g_mq = args.in[8]; F.g_mk = args.in[9]; F.w_mkv = args.in[10]; F.w_bsb = args.in[11]; F.w_bfx = args.in[12]; F.w_bmm = args.in[13]; F.w_out = args.in[14]; F.g_mlp = args.in[15];
    F.w_up = args.in[16]; F.w_dn = args.in[17]; F.out = args.out;
    F.logf = (float*)(ws + WS_LOGF); F.FC = (float*)(ws + WS_FC); F.ssq = (float*)(ws + WS_SSQ); F.MKf = (float*)(ws + WS_MKF);
    F.Win_t = (bf16*)(ws + WS_WIN); F.Wmkv_t = (bf16*)(ws + WS_WMKV); F.Wbr_t = (bf16*)(ws + WS_WBR); F.Wout_t = (bf16*)(ws + WS_WOUT); F.Wup_t = (bf16*)(ws + WS_WUP); F.Wdn_t = (bf16*)(ws + WS_WDN);
    F.MHb = (bf16*)(ws + WS_MH); F.MV = (bf16*)(ws + WS_MV); F.XN = (bf16*)(ws + WS_XN);
    F.SBQ = (bf16*)(ws + WS_SBQ); F.SBK = (bf16*)(ws + WS_SBK); F.SBV = (bf16*)(ws + WS_SBV); F.FXQ = (bf16*)(ws + WS_FXQ); F.FXK = (bf16*)(ws + WS_FXK); F.FXV = (bf16*)(ws + WS_FXV); F.MQ = (bf16*)(ws + WS_MQ);
    F.G0 = (bf16*)args.out; F.G1 = (bf16*)args.out + (size_t)M * D; F.G2 = (bf16*)(ws + WS_G2); F.MRG = (bf16*)(ws + WS_MRG); F.U = (bf16*)(ws + WS_U);
    for (int u = F.tid; u < (LDS_BYTES - LDSCTL_OFF) / 4; u += NTHREADS) ((LAS unsigned*)(F.lds + LDSCTL_OFF))[u] = 0u;
    __syncthreads();
    XcdBarrier bar; bar.bar = (unsigned*)(F.ctl + CW_BAR); bar.x = 0; bar.st = nullptr;
    if (N_LAUNCHES == 1) bar = xcd_barrier_post((unsigned*)(F.ctl + CW_BAR), F.MISC + 8);
#define GRID_BAR() do { if (N_LAUNCHES == 1) xcd_barrier(bar); } while (0)
    const int lo = args.ph_lo, hi = args.ph_hi;
#define IN(k) (lo <= (k) && (k) < hi)
#define BOTH(k) (IN(k) && IN((k) + 1))
    const int wg = (int)blockIdx.x, nwg = F.G;

    if (IN(0)) { p0_prologue(F); if (BOTH(0)) GRID_BAR(); }
    if (IN(1)) {
        fcumsum(F); VM_WAIT();
#if OPT_P1
        { pg8::EpiProj E{F.SBQ, F.G0, F.G2, F.MKf, F.MV};
          pg8::SchedP1 S{F.G, (int)blockIdx.x, (const char*)F.XN, (const char*)F.Win_t};
          pg8::gemm_phase<pg8::EpiProj, pg8::SchedP1, false, true>(F.lds, D, S, E); }
#else
        { EpiProjN E{F.SBQ, F.G0, F.G2}; ngemm(F.XN, D, F.Win_t, D, M, NPROJ, D, E, wg, nwg); }
        { EpiMkvN E{F.MKf, F.MV}; ngemm(F.MHb, D, F.Wmkv_t, D, MROWS, 1024, D, E, wg, nwg); }
#endif
        if (BOTH(1)) GRID_BAR();
    }
    if (IN(2)) {
#if !OPT_P1
        headnorm_naive(F);
#endif
        if (BOTH(2)) { if (!OPT_P1) GRID_BAR(); } }
    if (IN(3)) {
#if OPT_ATT
        for (int v = F.vcu; v < 256; v += F.G) { const int bh = v >> 2, s4 = v & 3;
            att::unit64<0>(F.SBQ, F.SBK, F.SBV, F.SBQ, F.FC, F.g_fq, F.g_fk, bh >> 3, bh & 7, 7 - s4, F.lds); __syncthreads();
            att::unit64<0>(F.SBQ, F.SBK, F.SBV, F.SBQ, F.FC, F.g_fq, F.g_fk, bh >> 3, bh & 7, s4, F.lds); __syncthreads();
            att::unit64<1>(F.FXQ, F.FXK, F.FXV, F.FXQ, F.FC, F.g_fq, F.g_fk, bh >> 3, bh & 7, 7 - s4, F.lds); __syncthreads();
            att::unit64<1>(F.FXQ, F.FXK, F.FXV, F.FXQ, F.FC, F.g_fq, F.g_fk, bh >> 3, bh & 7, s4, F.lds); __syncthreads(); }
#else
        nattn64<0>(F.SBQ, F.SBK, F.SBV, F.SBQ, F.FC, F.g_fq, F.g_fk, wg, nwg);
        nattn64<1>(F.FXQ, F.FXK, F.FXV, F.FXQ, F.FC, F.g_fq, F.g_fk, wg, nwg);
#endif
        nattn_mem(F, wg, nwg);
        if (BOTH(3)) GRID_BAR();
    }
    if (IN(4)) {
#if OPT_P3
        { pg8::EpiMerged E{F.G0, F.G2, (float*)(ws + WS_T1), (float*)(ws + WS_T2), F.MRG};
          for (int br = 0; br < 3; ++br) { pg8::SchedP3 S{F.G, (int)blockIdx.x, (const char*)F.SBQ, (const char*)F.Wbr_t, br};
              pg8::gemm_phase<pg8::EpiMerged, pg8::SchedP3, false, true>(F.lds, DH, S, E); } }
#else
        nmerged(F, wg, nwg);
#endif
        if (BOTH(4)) GRID_BAR(); }
    if (IN(5)) {
#if OPT_P4
        { pg8::SchedPlain S{64, 4, F.G, (int)blockIdx.x, (const char*)F.MRG, (const char*)F.Wout_t, (size_t)256 * D * 2};
          pg8::EpiOut E{F.x, F.out, F.XN, F.ssq};
          pg8::gemm_phase<pg8::EpiOut, pg8::SchedPlain, false, true>(F.lds, D, S, E); }
#else
        { EpiOutN E{F.x, F.out, F.XN}; ngemm(F.MRG, D, F.Wout_t, D, M, D, D, E, wg, nwg); }
#endif
        if (BOTH(5)) GRID_BAR(); }
    if (IN(6)) {
        ssq_naive(F);
        if (BOTH(6)) { GRID_BAR(); } }
    if (IN(7)) {
#if OPT_P5
        { pg8::SchedPlain S{64, 16, F.G, (int)blockIdx.x, (const char*)F.XN, (const char*)F.Wup_t, (size_t)256 * D * 2};
          pg8::EpiUp E{F.U};
          pg8::gemm_phase<pg8::EpiUp, pg8::SchedPlain, false, true>(F.lds, D, S, E); }
#else
        { EpiUpN E{F.ssq, F.U}; ngemm(F.XN, D, F.Wup_t, D, M, FF, D, E, wg, nwg); }
#endif
        if (BOTH(7)) GRID_BAR(); }
    if (IN(8)) {
#if OPT_P6
        { pg8::SchedPlain S{64, 4, F.G, (int)blockIdx.x, (const char*)F.U, (const char*)F.Wdn_t, (size_t)256 * FF * 2};
          pg8::EpiDown E{F.out, F.ssq};
          pg8::gemm_phase<pg8::EpiDown, pg8::SchedPlain, false, true>(F.lds, FF, S, E); }
#else
        { EpiDnN E{F.out, F.ssq}; ngemm(F.U, FF, F.Wdn_t, FF, M, D, FF, E, wg, nwg); }
#endif
    }
#undef IN
#undef BOTH
}

extern "C" void kernel_launch(void* const* d_in, const int* in_sizes, int n_in, void* d_out, int out_size, void* d_ws, size_t ws_size, hipStream_t stream) {
    static int grid = 0;
    if (grid == 0) {
        if (n_in != 18 || in_sizes[0] != M * D || out_size != M * D || ws_size < WS_END) { fprintf(stderr, "kernel_launch: unexpected shapes (n_in %d, in0 %d, out %d, ws %zu); nothing launched\n", n_in, n_in > 0 ? in_sizes[0] : -1, out_size, ws_size); grid = -1; return; }
        int dev = 0, cus = 0, per_cu = 0;
        if (hipGetDevice(&dev) != hipSuccess || hipDeviceGetAttribute(&cus, hipDeviceAttributeMultiprocessorCount, dev) != hipSuccess) { grid = -1; return; }
        if (hipFuncSetAttribute((const void*)skel_fwd, hipFuncAttributeMaxDynamicSharedMemorySize, LDS_BYTES) != hipSuccess) { fprintf(stderr, "kernel_launch: hipFuncSetAttribute failed\n"); grid = -1; return; }
        if (hipOccupancyMaxActiveBlocksPerMultiprocessor(&per_cu, (const void*)skel_fwd, NTHREADS, LDS_BYTES) != hipSuccess || per_cu < 1) fprintf(stderr, "kernel_launch: occupancy query reports %d\n", per_cu);
        (void)hipGetLastError();
        grid = cus;
    }
    if (grid < 0) return;
    if (hipMemsetAsync((char*)d_ws + WS_CTL, 0, CTL_ZERO_BYTES, stream) != hipSuccess) return;
    Args a{};
    for (int i = 0; i < 18; ++i) a.in[i] = (const float*)d_in[i];
    a.out = (float*)d_out; a.ws = (unsigned char*)d_ws;
    for (int li = 0; li < N_LAUNCHES; ++li) {
        a.ph_lo = (N_LAUNCHES == 1) ? 0 : li; a.ph_hi = (N_LAUNCHES == 1) ? N_PHASES : li + 1; a.li = li;
        hipLaunchKernelGGL(skel_fwd, dim3(grid), dim3(NTHREADS), LDS_BYTES, stream, a);
        if (hipPeekAtLastError() != hipSuccess) break;
    }
}
```

```cpp
#include <hip/hip_runtime.h>
#include <cstdio>
#include <cstdint>

#define GAS __attribute__((address_space(1)))
#define LAS __attribute__((address_space(3)))
typedef unsigned short bf16;
typedef short bf16x8 __attribute__((ext_vector_type(8)));
typedef float f32x4 __attribute__((ext_vector_type(4)));
typedef unsigned v4u __attribute__((ext_vector_type(4)));
typedef GAS unsigned gu32;
#define RLX_AGENT __ATOMIC_RELAXED, __HIP_MEMORY_SCOPE_AGENT
#define LDS_WAIT() asm volatile("s_waitcnt lgkmcnt(0)" ::: "memory")
#define VM_WAIT() asm volatile("s_waitcnt vmcnt(0)" ::: "memory")

constexpr int NWAVES = 8, NTHREADS = 512;
constexpr int BATCH = 8, SEQ = 2048, M = BATCH * SEQ, D = 1024, MEMLEN = 256, MROWS = BATCH * MEMLEN;
constexpr int HD = 64, NH = 8, MNH = 4, MHD = 128, DH = 512, FF = 4096;
constexpr int DIN = 6664, NPROJ = 6656;
constexpr float EPS = 1e-6f, LOG2E = 1.4426950408889634f, LN2 = 0.6931471805599453f;
constexpr float C2 = 0.125f * LOG2E;
constexpr float C2M = 0.08838834764831845f * LOG2E;

constexpr size_t MiB = 1u << 20;
constexpr size_t WS_CTL = 0, CTL_ZERO_BYTES = 65536;
constexpr size_t WS_LOGF = 1 * MiB, WS_FC = 1 * MiB + 512 * 1024, WS_SSQ = 2 * MiB;
constexpr size_t WS_WIN = 3 * MiB, WS_WMKV = 16 * MiB, WS_WBR = 18 * MiB, WS_WOUT = 21 * MiB, WS_WUP = 23 * MiB, WS_WDN = 31 * MiB;
constexpr size_t WS_MV = 39 * MiB, WS_XN = 44 * MiB, WS_MH = 76 * MiB;
constexpr size_t WS_T1 = 96 * MiB, WS_T2 = 144 * MiB;
constexpr size_t WS_SBQ = 80 * MiB, WS_SBK = 96 * MiB, WS_SBV = 112 * MiB, WS_FXQ = 128 * MiB, WS_FXK = 144 * MiB, WS_FXV = 160 * MiB, WS_MQ = 176 * MiB;
constexpr size_t WS_G2 = 192 * MiB, WS_MRG = 224 * MiB, WS_MKF = 224 * MiB, WS_U = 80 * MiB, WS_END = 256 * MiB;
constexpr int CW_BAR = 4096;

constexpr int RING_BYTES = 131072, LDSCTL_OFF = RING_BYTES, MISC_OFF = LDSCTL_OFF + 320, LDS_BYTES = 147456;

__device__ __forceinline__ unsigned f2bf(float f) { unsigned u = __builtin_bit_cast(unsigned, f); return (u + 0x7fffu + ((u >> 16) & 1u)) >> 16; }
__device__ __forceinline__ unsigned pk2(float lo, float hi) { return f2bf(lo) | (f2bf(hi) << 16); }
__device__ __forceinline__ float bf2f(unsigned b) { return __uint_as_float(b << 16); }
__device__ __forceinline__ float bflo(unsigned w) { return __uint_as_float(w << 16); }
__device__ __forceinline__ float bfhi(unsigned w) { return __uint_as_float(w & 0xffff0000u); }
__device__ __forceinline__ float wave_sum(float v) {
#pragma unroll
    for (int o = 1; o < 64; o <<= 1) v += __shfl_xor(v, o);
    return v;
}
__device__ __forceinline__ float log_sigmoid_f(float x) { return fminf(x, 0.f) - log1pf(expf(-fabsf(x))); }

#define XB_TMO      128
#define XB_XCNT(j)  (256  + 64 * (j))
#define XB_XSUB(j)  (1280 + 64 * (j))
#define XB_XGEN(j)  (2304 + 64 * (j))
#define XB_TOP      3328
#define XB_TOPGEN   3392
#define XCD_BAR_WORDS 3456
#define XB_SPIN_CAP (1u << 18)
__device__ __forceinline__ unsigned xb_ld(unsigned* p)              { return __hip_atomic_load(p, __ATOMIC_RELAXED, __HIP_MEMORY_SCOPE_AGENT); }
__device__ __forceinline__ unsigned xb_add(unsigned* p, unsigned v) { return __hip_atomic_fetch_add(p, v, __ATOMIC_RELAXED, __HIP_MEMORY_SCOPE_AGENT); }
__device__ __forceinline__ unsigned xb_xcc_id() { return (unsigned)__builtin_amdgcn_s_getreg((3 << 11) | 20) & 0xFu; }
#define XB_SPIN(cond, bar) do { unsigned _sp = 0; while (cond) { __builtin_amdgcn_s_sleep(1); \
    if ((++_sp & 255u) == 0u) { if (xb_ld(&(bar)[XB_TMO])) break; if (_sp > XB_SPIN_CAP) { atomicAdd(&(bar)[XB_TMO], 1u); break; } } } } while (0)
struct XcdBarrier { unsigned* bar; unsigned x; volatile LAS unsigned* st; };
__device__ __forceinline__ XcdBarrier xcd_barrier_post(unsigned* bar, volatile LAS unsigned* st) {
    XcdBarrier b; b.bar = bar; b.x = xb_xcc_id(); b.st = st;
    if (threadIdx.x == 0) (void)xb_add(&bar[XB_XCNT(b.x)], 1u);
    return b;
}
__device__ __forceinline__ void xcd_barrier_complete(unsigned* bar, unsigned x, unsigned& nloc, unsigned& nx) {
    const unsigned G = gridDim.x * gridDim.y * gridDim.z;
    unsigned sum, cnt, mine, sp = 0u;
    for (;;) {
        sum = 0u; cnt = 0u; mine = 0u;
#pragma unroll
        for (unsigned j = 0; j < 16; ++j) { const unsigned c = xb_ld(&bar[XB_XCNT(j)]); sum += c; cnt += (c > 0u) ? 1u : 0u; mine = (j == x) ? c : mine; }
        if (sum == G) break;
        __builtin_amdgcn_s_sleep(1);
        if ((++sp & 255u) == 0u) { if (xb_ld(&bar[XB_TMO])) break; if (sp > XB_SPIN_CAP) { atomicAdd(&bar[XB_TMO], 1u); break; } }
    }
    nloc = mine > 0u ? mine : 1u; nx = cnt > 0u ? cnt : 1u;
}
__device__ __forceinline__ void xcd_barrier(const XcdBarrier& b) {
    asm volatile("s_waitcnt vmcnt(0)" ::: "memory");
    __syncthreads();
    if (threadIdx.x == 0) {
        unsigned* bar = b.bar;
        __builtin_amdgcn_s_waitcnt(0);
        unsigned nloc = b.st[0], nx = b.st[1];
        if (nloc == 0u) { xcd_barrier_complete(bar, b.x, nloc, nx); b.st[0] = nloc; b.st[1] = nx; }
        const unsigned old = xb_add(&bar[XB_XSUB(b.x)], 1u);
        const unsigned gen = old / nloc;
        if (old + 1u == (gen + 1u) * nloc) {
            __builtin_amdgcn_fence(__ATOMIC_RELEASE, "agent");
            asm volatile("s_waitcnt vmcnt(0)" ::: "memory");
            const unsigned og = xb_add(&bar[XB_TOP], 1u);
            const unsigned tg = og / nx;
            if (og + 1u == (tg + 1u) * nx) xb_add(&bar[XB_TOPGEN], 1u);
            else XB_SPIN(xb_ld(&bar[XB_TOPGEN]) == tg, bar);
            __builtin_amdgcn_fence(__ATOMIC_ACQUIRE, "agent");
            xb_add(&bar[XB_XGEN(b.x)], 1u);
            asm volatile("s_waitcnt vmcnt(0)" ::: "memory");
        } else {
            XB_SPIN(xb_ld(&bar[XB_XGEN(b.x)]) == gen, bar);
            __builtin_amdgcn_fence(__ATOMIC_ACQUIRE, "agent");
            asm volatile("s_waitcnt vmcnt(0)" ::: "memory");
        }
    }
    __syncthreads();
}

struct Frame {
    LAS unsigned char* lds;
    volatile LAS unsigned* MISC;
    gu32* ctl;
    int tid, lane, wave, vcu, G;
    const float *x, *mem, *g_mix, *g_memn, *w_in, *b_forget, *g_fq, *g_fk, *g_mq, *g_mk, *w_mkv, *w_bsb, *w_bfx, *w_bmm, *w_out, *g_mlp, *w_up, *w_dn;
    float* out;
    float *logf, *FC, *ssq, *MKf;
    bf16 *Win_t, *Wmkv_t, *Wbr_t, *Wout_t, *Wup_t, *Wdn_t, *MHb, *MV, *XN, *SBQ, *SBK, *SBV, *FXQ, *FXK, *FXV, *MQ, *G0, *G1, *G2, *MRG, *U;
};

__device__ __forceinline__ void tr_item(const float* W, int ldw, int K, bf16* WT, int src_c0, int dst_r0, int k0, LAS float* scr, int lane, const float* kgain = nullptr) {
#pragma unroll 8
    for (int i = 0; i < 32; ++i) { const int kk = 2 * i + (lane >> 5); float w = W[(size_t)(k0 + kk) * ldw + src_c0 + (lane & 31)]; if (kgain) w *= kgain[k0 + kk]; scr[kk * 33 + (lane & 31)] = w; }
    LDS_WAIT(); asm volatile("" ::: "memory");
    const int c = lane & 7;
#pragma unroll
    for (int j = 0; j < 4; ++j) { const int n = (lane >> 3) + 8 * j; const LAS float* s = scr + (8 * c) * 33 + n;
        v4u o; o.x = pk2(s[0 * 33], s[1 * 33]); o.y = pk2(s[2 * 33], s[3 * 33]); o.z = pk2(s[4 * 33], s[5 * 33]); o.w = pk2(s[6 * 33], s[7 * 33]);
        *(GAS v4u*)(WT + (size_t)(dst_r0 + n) * K + k0 + 8 * c) = o; }
    LDS_WAIT(); asm volatile("" ::: "memory");
}
__host__ __device__ __forceinline__ int proj_src_col(int n) {
    const int pn = n >> 8, j = n & 255;
    if (pn < 12) { const int T = pn >> 1, bj = j >> 7, wc = (j >> 5) & 3, e = j & 31; return T * 512 + ((pn & 1) * 4 + wc) * 64 + bj * 32 + e; }
    if (pn < 14) return 3080 + (n - 12 * 256);
    return 3592 + (n - 14 * 256);
}
template <bool IS_X>
__device__ __forceinline__ void p0_rows(Frame& F, const float* srcb, const float* g, bf16* dstb, int nrows, LAS float* wf, int gw, int NGW) {
    const GAS f32x4* gr = (const GAS f32x4*)g + F.lane;
    for (int m = gw; m < nrows; m += NGW) {
        const GAS f32x4* xr = (const GAS f32x4*)(srcb + (size_t)m * D) + F.lane;
        f32x4 v[4]; float s = 0.f;
#pragma unroll
        for (int j = 0; j < 4; ++j) { v[j] = xr[64 * j]; s += (v[j].x * v[j].x + v[j].y * v[j].y) + (v[j].z * v[j].z + v[j].w * v[j].w); }
        const float rstd = 1.0f / sqrtf(wave_sum(s) * (1.f / D) + EPS);
#pragma unroll
        for (int j = 0; j < 4; ++j) { const f32x4 gg = gr[64 * j]; v[j] = v[j] * rstd * gg; }
        GAS unsigned long long* o8 = (GAS unsigned long long*)(dstb + (size_t)m * D) + F.lane;
#pragma unroll
        for (int j = 0; j < 4; ++j) o8[64 * j] = (unsigned long long)pk2(v[j].x, v[j].y) | ((unsigned long long)pk2(v[j].z, v[j].w) << 32);
        if (IS_X) {
            float fl[8];
#pragma unroll
            for (int c = 0; c < 8; ++c) fl[c] = 0.f;
#pragma unroll
            for (int j = 0; j < 4; ++j)
#pragma unroll
                for (int e = 0; e < 4; ++e) { const int d = 256 * j + 4 * F.lane + e; const float hv = v[j][e];
                    const f32x4 w0 = *(const LAS f32x4*)(wf + d * 8), w1 = *(const LAS f32x4*)(wf + d * 8 + 4);
                    fl[0] += hv * w0.x; fl[1] += hv * w0.y; fl[2] += hv * w0.z; fl[3] += hv * w0.w; fl[4] += hv * w1.x; fl[5] += hv * w1.y; fl[6] += hv * w1.z; fl[7] += hv * w1.w; }
            float mine = 0.f;
#pragma unroll
            for (int c = 0; c < 8; ++c) { const float t = wave_sum(fl[c]); if (F.lane == c) mine = t; }
            if (F.lane < 8) F.logf[(size_t)m * 8 + F.lane] = log_sigmoid_f(mine + F.b_forget[F.lane]);
        }
    }
}
__device__ __forceinline__ void p0_prologue(Frame& F) {
    LAS float* scr = (LAS float*)(F.lds + F.wave * 8448);
    LAS float* wf = (LAS float*)(F.lds + 8 * 8448);
    for (int i = F.tid; i < D * 8; i += NTHREADS) wf[i] = F.w_in[(size_t)(i >> 3) * DIN + 3072 + (i & 7)];
    const int gw = F.vcu * NWAVES + F.wave, NGW = F.G * NWAVES;
    constexpr int I_IN = 16 * 208, I_MKV = 16 * 32, I_BR = 8 * 32, I_OUT = 16 * 32, I_UP = 16 * 128, I_DN = 64 * 32;
    constexpr int NITEMS = I_IN + I_MKV + 3 * I_BR + I_OUT + I_UP + I_DN;
    for (int it = gw; it < NITEMS; it += NGW) {
        int r = it;
        if (r < I_IN) { const int kb = r / 208, gi = r % 208; tr_item(F.w_in, DIN, D, F.Win_t, proj_src_col(32 * gi), 32 * gi, 64 * kb, scr, F.lane); continue; } r -= I_IN;
        if (r < I_MKV) { const int kb = r / 32, gi = r % 32; tr_item(F.w_mkv, 1024, D, F.Wmkv_t, 32 * gi, 32 * gi, 64 * kb, scr, F.lane); continue; } r -= I_MKV;
        if (r < I_BR) { const int kb = r / 32, gi = r % 32; tr_item(F.w_bsb, D, DH, F.Wbr_t, 32 * gi, 32 * gi, 64 * kb, scr, F.lane); continue; } r -= I_BR;
        if (r < I_BR) { const int kb = r / 32, gi = r % 32; tr_item(F.w_bfx, D, DH, F.Wbr_t + (size_t)D * DH, 32 * gi, 32 * gi, 64 * kb, scr, F.lane); continue; } r -= I_BR;
        if (r < I_BR) { const int kb = r / 32, gi = r % 32; tr_item(F.w_bmm, D, DH, F.Wbr_t + (size_t)2 * D * DH, 32 * gi, 32 * gi, 64 * kb, scr, F.lane); continue; } r -= I_BR;
        if (r < I_OUT) { const int kb = r / 32, gi = r % 32; tr_item(F.w_out, D, D, F.Wout_t, 32 * gi, 32 * gi, 64 * kb, scr, F.lane); continue; } r -= I_OUT;
        if (r < I_UP) { const int kb = r / 128, gi = r % 128; tr_item(F.w_up, FF, D, F.Wup_t, 32 * gi, 32 * gi, 64 * kb, scr, F.lane, F.g_mlp); continue; } r -= I_UP;
        { const int kb = r / 32, gi = r % 32; tr_item(F.w_dn, D, FF, F.Wdn_t, 32 * gi, 32 * gi, 64 * kb, scr, F.lane); }
    }
    __syncthreads();
    p0_rows<true>(F, F.x, F.g_mix, F.XN, M, wf, gw, NGW);
    p0_rows<false>(F, F.mem, F.g_memn, F.MHb, MROWS, wf, gw, NGW);
}

template <class Epi>
__device__ __forceinline__ void ngemm(const bf16* A, int lda, const bf16* Bt, int ldb, int Mr, int Nc, int K, const Epi& E, int wg, int nwg) {
    const int tid = threadIdx.x, lane = tid & 63, wid = tid >> 6, wm = wid >> 1, wn = wid & 1;
    const int tilesN = Nc / 128, ntiles = (Mr / 128) * tilesN;
    for (int t = wg; t < ntiles; t += nwg) {
        const int tm = t / tilesN, tn = t % tilesN, r0 = tm * 128 + wm * 32, c0 = tn * 128 + wn * 64;
        f32x4 acc[2][4];
#pragma unroll
        for (int m = 0; m < 2; ++m)
#pragma unroll
            for (int n = 0; n < 4; ++n) acc[m][n] = (f32x4){0.f, 0.f, 0.f, 0.f};
        const bf16* ap = A + (size_t)(r0 + (lane & 15)) * lda + 8 * (lane >> 4);
        const bf16* bp = Bt + (size_t)(c0 + (lane & 15)) * ldb + 8 * (lane >> 4);
        for (int k0 = 0; k0 < K; k0 += 32) {
            bf16x8 a[2], b[4];
#pragma unroll
            for (int m = 0; m < 2; ++m) a[m] = *(const bf16x8*)(ap + (size_t)(m * 16) * lda + k0);
#pragma unroll
            for (int n = 0; n < 4; ++n) b[n] = *(const bf16x8*)(bp + (size_t)(n * 16) * ldb + k0);
#pragma unroll
            for (int m = 0; m < 2; ++m)
#pragma unroll
                for (int n = 0; n < 4; ++n) acc[m][n] = __builtin_amdgcn_mfma_f32_16x16x32_bf16(a[m], b[n], acc[m][n], 0, 0, 0);
        }
#pragma unroll
        for (int m = 0; m < 2; ++m)
#pragma unroll
            for (int n = 0; n < 4; ++n)
#pragma unroll
                for (int j = 0; j < 4; ++j) E(r0 + m * 16 + (lane >> 4) * 4 + j, c0 + n * 16 + (lane & 15), acc[m][n][j]);
    }
}

struct EpiProjN {
    bf16 *SBQ, *G0, *G2;
    __device__ __forceinline__ void operator()(int row, int n, float v) const {
        const int pn = n >> 8, j = n & 255;
        if (pn < 12) { const int T = pn >> 1, bj = j >> 7, wc = (j >> 5) & 3, e = j & 31, c = ((pn & 1) * 4 + wc) * 64 + bj * 32 + e;
            if (T == 0) v *= C2;
            (SBQ + (size_t)T * M * DH)[(size_t)row * DH + c] = (bf16)f2bf(v); }
        else if (pn < 14) { (SBQ + (size_t)6 * M * DH)[(size_t)row * DH + (n - 12 * 256)] = (bf16)f2bf(v); }
        else { const int g = (pn - 14) >> 2, c = n - (14 + 4 * g) * 256; bf16* G = g < 2 ? G0 + (size_t)g * M * D : G2;
            G[(size_t)row * D + c] = (bf16)f2bf(1.0f / (1.0f + expf(-v))); }
    }
};
struct EpiMkvN { float* MKf; bf16* MV;
    __device__ __forceinline__ void operator()(int row, int n, float v) const { if (n < DH) MKf[(size_t)row * DH + n] = v; else MV[(size_t)row * DH + (n - DH)] = (bf16)f2bf(v); } };
struct EpiOutN { const float* x; float* x1; bf16* A2;
    __device__ __forceinline__ void operator()(int row, int n, float v) const { const size_t o = (size_t)row * D + n; const float r = x[o] + v; x1[o] = r; A2[o] = (bf16)f2bf(r); } };
struct EpiUpN { const float* ssq; bf16* U;
    __device__ __forceinline__ void operator()(int row, int n, float v) const {
        const f32x4* p = (const f32x4*)(ssq + (size_t)row * 16); const f32x4 a = p[0], b = p[1], c = p[2], d = p[3];
        const float ss = ((a.x + a.y) + (a.z + a.w)) + ((b.x + b.y) + (b.z + b.w)) + ((c.x + c.y) + (c.z + c.w)) + ((d.x + d.y) + (d.z + d.w));
        (void)ss; const float r = fmaxf(v, 0.f); U[(size_t)row * FF + n] = (bf16)f2bf(r * r); } };
struct EpiDnN { float* out; const float* ssq;
    __device__ __forceinline__ void operator()(int row, int n, float v) const { const size_t o = (size_t)row * D + n;
        const f32x4* p = (const f32x4*)(ssq + (size_t)row * 16); const f32x4 a = p[0], b = p[1], c = p[2], d = p[3];
        const float ss = ((a.x + a.y) + (a.z + a.w)) + ((b.x + b.y) + (b.z + b.w)) + ((c.x + c.y) + (c.z + c.w)) + ((d.x + d.y) + (d.z + d.w));
        out[o] = out[o] + v / (ss * (1.f / D) + EPS); } };

__device__ __forceinline__ void fcumsum(Frame& F) {
    const int gw = F.vcu * NWAVES + F.wave;
    if (gw >= BATCH * NH) return;
    const int b = gw >> 3, h = gw & 7;
    const float* src = F.logf + ((size_t)b * SEQ + 32 * F.lane) * 8 + h;
    float tot = 0.f;
    for (int i = 0; i < 32; ++i) tot += src[i * 8];
    float incl = tot;
#pragma unroll
    for (int off = 1; off < 64; off <<= 1) { const float y = __shfl_up(incl, off); if (F.lane >= off) incl += y; }
    float run = incl - tot;
    float* dst = F.FC + (size_t)gw * SEQ + 32 * F.lane;
    for (int i = 0; i < 32; ++i) { run += src[i * 8]; dst[i] = run; }
}

__device__ __forceinline__ void headnorm_naive(Frame& F) {
    const int gw = F.vcu * NWAVES + F.wave, NGW = F.G * NWAVES;
    for (int it = gw; it < 2 * M; it += NGW) {
        const int which = it / M, row = it % M;
        bf16* p = F.FXQ + (size_t)which * M * DH + (size_t)row * DH + 8 * F.lane;
        const v4u w = *(const v4u*)p; float v[8] = {bflo(w.x), bfhi(w.x), bflo(w.y), bfhi(w.y), bflo(w.z), bfhi(w.z), bflo(w.w), bfhi(w.w)};
        float s = 0.f;
#pragma unroll
        for (int i = 0; i < 8; ++i) s += v[i] * v[i];
        s += __shfl_xor(s, 1); s += __shfl_xor(s, 2); s += __shfl_xor(s, 4);
        const float sc = (1.0f / sqrtf(s * (1.f / HD) + EPS)) * (which == 0 ? C2 : 1.0f);
#pragma unroll
        for (int i = 0; i < 8; ++i) v[i] = v[i] * sc;
        v4u o; o.x = pk2(v[0], v[1]); o.y = pk2(v[2], v[3]); o.z = pk2(v[4], v[5]); o.w = pk2(v[6], v[7]);
        *(v4u*)p = o;
    }
}

template <int MODE>
__device__ __forceinline__ void nattn64(const bf16* Q, const bf16* K, const bf16* V, bf16* O, const float* FC, const float* gq, const float* gk, int wg, int nwg) {
    const int tid = threadIdx.x, half = tid & 1;
    for (int u = wg; u < 512; u += nwg) {
        const int b = u >> 6, h = (u >> 3) & 7, blk = u & 7, t = blk * 256 + (tid >> 1); const size_t row = (size_t)b * SEQ + t;
        float q[32], o[32];
        { const v4u* qp = (const v4u*)(Q + row * DH + h * HD + half * 32);
#pragma unroll
          for (int i = 0; i < 4; ++i) { const v4u w = qp[i]; q[8 * i] = bflo(w.x); q[8 * i + 1] = bfhi(w.x); q[8 * i + 2] = bflo(w.y); q[8 * i + 3] = bfhi(w.y); q[8 * i + 4] = bflo(w.z); q[8 * i + 5] = bfhi(w.z); q[8 * i + 6] = bflo(w.w); q[8 * i + 7] = bfhi(w.w); } }
        if (MODE == 1) {
#pragma unroll
            for (int d = 0; d < 32; ++d) q[d] *= gq[half * 32 + d] * gk[half * 32 + d]; }
#pragma unroll
        for (int d = 0; d < 32; ++d) o[d] = 0.f;
        const int kend = blk * 256 + 256;
        const bf16* Kb = K + (size_t)b * SEQ * DH + h * HD + half * 32; const bf16* Vb = V + (size_t)b * SEQ * DH + h * HD + half * 32;
        const float* Fs = FC + (size_t)(b * NH + h) * SEQ;
        float carry = 0.f, mrun = -1e30f, lrun = 0.f;
        for (int i = 0; i < kend; ++i) {
            const int s = MODE == 0 ? kend - 1 - i : i;
            const v4u* kp = (const v4u*)(Kb + (size_t)s * DH); const v4u* vp = (const v4u*)(Vb + (size_t)s * DH);
            float z = 0.f;
#pragma unroll
            for (int c = 0; c < 4; ++c) { const v4u w = kp[c];
                z += q[8 * c] * bflo(w.x) + q[8 * c + 1] * bfhi(w.x) + q[8 * c + 2] * bflo(w.y) + q[8 * c + 3] * bfhi(w.y) + q[8 * c + 4] * bflo(w.z) + q[8 * c + 5] * bfhi(w.z) + q[8 * c + 6] * bflo(w.w) + q[8 * c + 7] * bfhi(w.w); }
            z += __shfl_xor(z, 1);
            float wgt;
            if (MODE == 0) {
                const float zn = z * LN2; const bool strict = s < t;
                const float lr = log_sigmoid_f(-zn), ls = zn + lr;
                wgt = strict ? expf(ls + carry) : 0.f; carry += strict ? lr : 0.f;
            } else {
                const float z2 = (s <= t) ? z - Fs[s] * LOG2E : -1e30f;
                const float mn = fmaxf(mrun, z2), al = exp2f(mrun - mn); wgt = (s <= t) ? exp2f(z2 - mn) : 0.f;
                lrun = lrun * al + wgt; mrun = mn;
#pragma unroll
                for (int d = 0; d < 32; ++d) o[d] *= al;
            }
#pragma unroll
            for (int c = 0; c < 4; ++c) { const v4u w = vp[c];
                o[8 * c] += wgt * bflo(w.x); o[8 * c + 1] += wgt * bfhi(w.x); o[8 * c + 2] += wgt * bflo(w.y); o[8 * c + 3] += wgt * bfhi(w.y); o[8 * c + 4] += wgt * bflo(w.z); o[8 * c + 5] += wgt * bfhi(w.z); o[8 * c + 6] += wgt * bflo(w.w); o[8 * c + 7] += wgt * bfhi(w.w); }
        }
        const float inv = MODE == 0 ? 1.0f : 1.0f / lrun;
        v4u* op = (v4u*)(O + row * DH + h * HD + half * 32);
#pragma unroll
        for (int i = 0; i < 4; ++i) { v4u w; w.x = pk2(o[8 * i] * inv, o[8 * i + 1] * inv); w.y = pk2(o[8 * i + 2] * inv, o[8 * i + 3] * inv); w.z = pk2(o[8 * i + 4] * inv, o[8 * i + 5] * inv); w.w = pk2(o[8 * i + 6] * inv, o[8 * i + 7] * inv); op[i] = w; }
    }
}
__device__ __forceinline__ void nattn_mem(Frame& F, int wg, int nwg) {
    const int tid = threadIdx.x, qt = tid & 3;
    for (int u = wg; u < 512; u += nwg) {
        const int b = u >> 6, hm = (u >> 4) & 3, blk = u & 15, t = blk * 128 + (tid >> 2); const size_t row = (size_t)b * SEQ + t;
        float q[32], o[32];
        { const v4u* qp = (const v4u*)(F.MQ + row * DH + hm * MHD + qt * 32);
#pragma unroll
          for (int i = 0; i < 4; ++i) { const v4u w = qp[i]; q[8 * i] = bflo(w.x); q[8 * i + 1] = bfhi(w.x); q[8 * i + 2] = bflo(w.y); q[8 * i + 3] = bfhi(w.y); q[8 * i + 4] = bflo(w.z); q[8 * i + 5] = bfhi(w.z); q[8 * i + 6] = bflo(w.w); q[8 * i + 7] = bfhi(w.w); } }
        float ss = 0.f;
#pragma unroll
        for (int d = 0; d < 32; ++d) ss += q[d] * q[d];
        ss += __shfl_xor(ss, 1); ss += __shfl_xor(ss, 2);
        const float rq = (1.0f / sqrtf(ss * (1.f / MHD) + EPS)) * C2M;
#pragma unroll
        for (int d = 0; d < 32; ++d) { q[d] = q[d] * rq * F.g_mq[qt * 32 + d] * F.g_mk[qt * 32 + d]; o[d] = 0.f; }
        float mrun = -1e30f, lrun = 0.f;
        for (int key = 0; key < MEMLEN; ++key) {
            const f32x4* kp = (const f32x4*)(F.MKf + (size_t)(b * MEMLEN + key) * DH + hm * MHD + qt * 32);
            const v4u* vp = (const v4u*)(F.MV + (size_t)(b * MEMLEN + key) * DH + hm * MHD + qt * 32);
            float dot = 0.f, kss = 0.f;
#pragma unroll
            for (int c = 0; c < 8; ++c) { const f32x4 k4 = kp[c]; dot += q[4 * c] * k4.x + q[4 * c + 1] * k4.y + q[4 * c + 2] * k4.z + q[4 * c + 3] * k4.w; kss += k4.x * k4.x + k4.y * k4.y + k4.z * k4.z + k4.w * k4.w; }
            dot += __shfl_xor(dot, 1); dot += __shfl_xor(dot, 2); kss += __shfl_xor(kss, 1); kss += __shfl_xor(kss, 2);
            const float z2 = dot * (1.0f / sqrtf(kss * (1.f / MHD) + EPS));
            const float mn = fmaxf(mrun, z2), al = exp2f(mrun - mn), wgt = exp2f(z2 - mn);
            lrun = lrun * al + wgt; mrun = mn;
#pragma unroll
            for (int c = 0; c < 4; ++c) { const v4u w = vp[c];
                o[8 * c] = o[8 * c] * al + wgt * bflo(w.x); o[8 * c + 1] = o[8 * c + 1] * al + wgt * bfhi(w.x); o[8 * c + 2] = o[8 * c + 2] * al + wgt * bflo(w.y); o[8 * c + 3] = o[8 * c + 3] * al + wgt * bfhi(w.y);
                o[8 * c + 4] = o[8 * c + 4] * al + wgt * bflo(w.z); o[8 * c + 5] = o[8 * c + 5] * al + wgt * bfhi(w.z); o[8 * c + 6] = o[8 * c + 6] * al + wgt * bflo(w.w); o[8 * c + 7] = o[8 * c + 7] * al + wgt * bfhi(w.w); }
        }
        const float inv = 1.0f / lrun;
        v4u* op = (v4u*)(F.MQ + row * DH + hm * MHD + qt * 32);
#pragma unroll
        for (int i = 0; i < 4; ++i) { v4u w; w.x = pk2(o[8 * i] * inv, o[8 * i + 1] * inv); w.y = pk2(o[8 * i + 2] * inv, o[8 * i + 3] * inv); w.z = pk2(o[8 * i + 4] * inv, o[8 * i + 5] * inv); w.w = pk2(o[8 * i + 6] * inv, o[8 * i + 7] * inv); op[i] = w; }
    }
}

__device__ __forceinline__ void nmerged(Frame& F, int wg, int nwg) {
    const int tid = threadIdx.x, lane = tid & 63, wid = tid >> 6, wm = wid >> 1, wn = wid & 1;
    const int tilesN = D / 128, ntiles = (M / 128) * tilesN;
    for (int t = wg; t < ntiles; t += nwg) {
        const int tm = t / tilesN, tn = t % tilesN, r0 = tm * 128 + wm * 32, c0 = tn * 128 + wn * 64;
        f32x4 tot[2][4];
#pragma unroll
        for (int m = 0; m < 2; ++m)
#pragma unroll
            for (int n = 0; n < 4; ++n) tot[m][n] = (f32x4){0.f, 0.f, 0.f, 0.f};
#pragma unroll 1
        for (int br = 0; br < 3; ++br) {
            const bf16* A = F.SBQ + (size_t)br * 3 * M * DH; const bf16* Bt = F.Wbr_t + (size_t)br * D * DH; const bf16* G = br < 2 ? F.G0 + (size_t)br * M * D : F.G2;
            f32x4 acc[2][4];
#pragma unroll
            for (int m = 0; m < 2; ++m)
#pragma unroll
                for (int n = 0; n < 4; ++n) acc[m][n] = (f32x4){0.f, 0.f, 0.f, 0.f};
            const bf16* ap = A + (size_t)(r0 + (lane & 15)) * DH + 8 * (lane >> 4);
            const bf16* bp = Bt + (size_t)(c0 + (lane & 15)) * DH + 8 * (lane >> 4);
            for (int k0 = 0; k0 < DH; k0 += 32) {
                bf16x8 a[2], b[4];
#pragma unroll
                for (int m = 0; m < 2; ++m) a[m] = *(const bf16x8*)(ap + (size_t)(m * 16) * DH + k0);
#pragma unroll
                for (int n = 0; n < 4; ++n) b[n] = *(const bf16x8*)(bp + (size_t)(n * 16) * DH + k0);
#pragma unroll
                for (int m = 0; m < 2; ++m)
#pragma unroll
                    for (int n = 0; n < 4; ++n) acc[m][n] = __builtin_amdgcn_mfma_f32_16x16x32_bf16(a[m], b[n], acc[m][n], 0, 0, 0);
            }
#pragma unroll
            for (int m = 0; m < 2; ++m)
#pragma unroll
                for (int n = 0; n < 4; ++n)
#pragma unroll
                    for (int j = 0; j < 4; ++j) tot[m][n][j] += bf2f(G[(size_t)(r0 + m * 16 + (lane >> 4) * 4 + j) * D + c0 + n * 16 + (lane & 15)]) * acc[m][n][j];
        }
#pragma unroll
        for (int m = 0; m < 2; ++m)
#pragma unroll
            for (int n = 0; n < 4; ++n)
#pragma unroll
                for (int j = 0; j < 4; ++j) F.MRG[(size_t)(r0 + m * 16 + (lane >> 4) * 4 + j) * D + c0 + n * 16 + (lane & 15)] = (bf16)f2bf(tot[m][n][j]);
    }
}
__device__ __forceinline__ void ssq_naive(Frame& F) {
    const int gw = F.vcu * NWAVES + F.wave, NGW = F.G * NWAVES;
    for (int m = gw; m < M; m += NGW) {
        const GAS f32x4* xr = (const GAS f32x4*)(F.out + (size_t)m * D) + F.lane; float s = 0.f;
#pragma unroll
        for (int j = 0; j < 4; ++j) { const f32x4 v = xr[64 * j]; s += (v.x * v.x + v.y * v.y) + (v.z * v.z + v.w * v.w); }
        s = wave_sum(s);
        if (F.lane < 16) F.ssq[(size_t)m * 16 + F.lane] = F.lane == 0 ? s : 0.f;

    }
}

namespace pg8 {
#define PG8_LAS __attribute__((address_space(3)))
typedef unsigned short bf16_t;
typedef unsigned u32x4 __attribute__((ext_vector_type(4)));
typedef unsigned u32x2 __attribute__((ext_vector_type(2)));
constexpr int BM = 256, BK = 64, HALF = 128, HTB = HALF * BK * 2, STAGE_BYTES = 8 * HTB, NXCD = 8, WGM = 8;
__host__ __device__ __forceinline__ int lds_byte(int r, int c) { const int st = (r >> 4) * 2 + (c >> 5), rr = r & 15, cc = c & 31, ob = rr * 64 + cc * 2; return st * 1024 + (ob ^ (((ob >> 9) & 1) << 5)); }
__host__ __device__ __forceinline__ void stage_rc(int b, int& R, int& C) { const int st = b / 1024, sb = b % 1024, swz = sb ^ (((sb >> 9) & 1) << 5); R = (st >> 1) * 16 + swz / 64; C = (st & 1) * 32 + (swz % 64) / 2; }
__host__ __device__ __forceinline__ int perm32(int rho) { const int n = rho >> 4, i = rho & 15; return 8 * (i >> 2) + 4 * n + (i & 3); }
struct Unit { int pm, pn, br; };
__device__ __forceinline__ unsigned cvt_pk_bf16(float lo, float hi) { unsigned r; asm volatile("v_cvt_pk_bf16_f32 %0, %1, %2" : "=v"(r) : "v"(lo), "v"(hi)); return r; }
__device__ __forceinline__ float bflo(unsigned w) { return __uint_as_float(w << 16); }
__device__ __forceinline__ float bfhi(unsigned w) { return __uint_as_float(w & 0xffff0000u); }

__device__ __forceinline__ float xsum16(float v) { auto r = __builtin_amdgcn_permlane16_swap(__float_as_uint(v), __float_as_uint(v), false, false); return __uint_as_float(r[0]) + __uint_as_float(r[1]); }
__device__ __forceinline__ float xsum32(float v) { auto r = __builtin_amdgcn_permlane32_swap(__float_as_uint(v), __float_as_uint(v), false, false); return __uint_as_float(r[0]) + __uint_as_float(r[1]); }
__device__ __forceinline__ void static_tile(int L, int nM, int nN, int& pm, int& pn) {
    const int nwg = nM * nN; int wgid = L;
    { const int q = nwg / NXCD, r = nwg % NXCD, xcd = wgid % NXCD, off = wgid / NXCD; wgid = (xcd < r ? xcd * (q + 1) : r * (q + 1) + (xcd - r) * q) + off; }
    const int nig = WGM * nN, gid = wgid / nig, fm = gid * WGM, gsz = (nM - fm) < WGM ? (nM - fm) : WGM;
    pm = fm + ((wgid % nig) % gsz); pn = (wgid % nig) / gsz;
}
struct SchedPlain {
    int nM, nN, G, c; const char* A; const char* B; size_t tstep;
    __device__ __forceinline__ bool next(int i, Unit& u) const { const long L = (long)i * G + c; if (L >= (long)nM * nN) return false; static_tile((int)L, nM, nN, u.pm, u.pn); u.br = 0; return true; }
    __device__ __forceinline__ const char* a_ptr(const Unit& u) const { return A + (size_t)u.pm * tstep; }
    __device__ __forceinline__ const char* b_ptr(const Unit& u) const { return B + (size_t)u.pn * tstep; }
    __device__ __forceinline__ void a_ready(const Unit&) const {}
    __device__ __forceinline__ void done(const Unit&) const {}
};
struct SchedP1 {
    int G, c; const char* A; const char* B;
    __device__ __forceinline__ bool next(int i, Unit& u) const { const long L = (long)i * G + c; if (L >= 1696) return false;
        if (L < 1664) static_tile((int)L, 64, 26, u.pm, u.pn); else { const int r = (int)L - 1664; u.pm = 64 + (r >> 2); u.pn = 26 + (r & 3); } u.br = 0; return true; }
    __device__ __forceinline__ const char* a_ptr(const Unit& u) const { return A + (size_t)u.pm * (256 * 1024 * 2); }
    __device__ __forceinline__ const char* b_ptr(const Unit& u) const { return B + (size_t)u.pn * (256 * 1024 * 2); }
    __device__ __forceinline__ void a_ready(const Unit&) const {}
    __device__ __forceinline__ void done(const Unit&) const {}
};
struct SchedP3 {
    int G, c; const char* A; const char* B; int br;
    __device__ __forceinline__ bool next(int i, Unit& u) const { if (i >= 1 || c >= 256) return false; static_tile(c, 64, 4, u.pm, u.pn); u.br = br; return true; }
    __device__ __forceinline__ const char* a_ptr(const Unit& u) const { return A + (size_t)u.br * ((size_t)3 * M * DH * 2) + (size_t)u.pm * (256 * 512 * 2); }
    __device__ __forceinline__ const char* b_ptr(const Unit& u) const { return B + (size_t)u.br * ((size_t)D * DH * 2) + (size_t)u.pn * (256 * 512 * 2); }
    __device__ __forceinline__ void a_ready(const Unit&) const {}
    __device__ __forceinline__ void done(const Unit&) const {}
};

typedef f32x4 acc_t[2][2][4][2];
__device__ __forceinline__ u32x4 pack8(const f32x4 a, const f32x4 b) { u32x4 w; w.x = cvt_pk_bf16(a[0], a[1]); w.y = cvt_pk_bf16(a[2], a[3]); w.z = cvt_pk_bf16(b[0], b[1]); w.w = cvt_pk_bf16(b[2], b[3]); return w; }
__device__ __forceinline__ float sigm(float x) { return __builtin_amdgcn_rcpf(1.0f + __builtin_amdgcn_exp2f(-LOG2E * x)); }

struct EpiProj {
    static constexpr bool PERM = true, AFTER_DRAIN = false;
    bf16_t* SBQ; bf16_t* G0; bf16_t* G2; float* MKf; bf16_t* MV;
    __device__ __forceinline__ void operator()(const acc_t& acc, const Unit& u, int wr, int wc, int fr, int fq) const {
        const int pn = u.pn; const int row0 = u.pm * BM + wr * 64 + fr;
        if (pn < 12) {
            const int T = pn >> 1, hd = (pn & 1) * 4 + wc;
            bf16_t* base = SBQ + (size_t)T * M * DH + (size_t)row0 * DH + hd * 64 + 8 * fq;
            if (T == 3 || T == 4) {
                const float qs = T == 3 ? C2 : 1.0f;
#pragma unroll
                for (int ai = 0; ai < 2; ++ai)
#pragma unroll
                    for (int m = 0; m < 4; ++m) {
                        float ss = 0.f;
#pragma unroll
                        for (int bj = 0; bj < 2; ++bj)
#pragma unroll
                            for (int n = 0; n < 2; ++n) { const f32x4 x = acc[ai][bj][m][n]; ss += (x[0] * x[0] + x[1] * x[1]) + (x[2] * x[2] + x[3] * x[3]); }
                        ss = xsum16(ss); ss = xsum32(ss);
                        const float sc = qs / sqrtf(ss * (1.0f / HD) + EPS);
                        bf16_t* rowp = base + (size_t)(ai * HALF + m * 16) * DH;
#pragma unroll
                        for (int bj = 0; bj < 2; ++bj) *(u32x4*)(rowp + 32 * bj) = pack8(acc[ai][bj][m][0] * sc, acc[ai][bj][m][1] * sc);
                    }
            } else {
                const float sc = T == 0 ? C2 : 1.0f;
#pragma unroll
                for (int ai = 0; ai < 2; ++ai)
#pragma unroll
                    for (int m = 0; m < 4; ++m) { bf16_t* rowp = base + (size_t)(ai * HALF + m * 16) * DH;
#pragma unroll
                        for (int bj = 0; bj < 2; ++bj) *(u32x4*)(rowp + 32 * bj) = pack8(acc[ai][bj][m][0] * sc, acc[ai][bj][m][1] * sc); }
            }
        } else if (pn < 14) {
            bf16_t* base = SBQ + (size_t)6 * M * DH + (size_t)row0 * DH + (pn - 12) * 256 + wc * 32 + 8 * fq;
#pragma unroll
            for (int ai = 0; ai < 2; ++ai)
#pragma unroll
                for (int m = 0; m < 4; ++m) { bf16_t* rowp = base + (size_t)(ai * HALF + m * 16) * DH;
#pragma unroll
                    for (int bj = 0; bj < 2; ++bj) *(u32x4*)(rowp + HALF * bj) = pack8(acc[ai][bj][m][0], acc[ai][bj][m][1]); }
        } else if (pn < 26) {
            const int g = (pn - 14) >> 2; bf16_t* G = g < 2 ? G0 + (size_t)g * M * D : G2;
            bf16_t* base = G + (size_t)row0 * D + ((pn - 14) & 3) * 256 + wc * 32 + 8 * fq;
#pragma unroll
            for (int ai = 0; ai < 2; ++ai)
#pragma unroll
                for (int m = 0; m < 4; ++m) { bf16_t* rowp = base + (size_t)(ai * HALF + m * 16) * D;
#pragma unroll
                    for (int bj = 0; bj < 2; ++bj) { f32x4 a = acc[ai][bj][m][0], b = acc[ai][bj][m][1];
#pragma unroll
                        for (int e = 0; e < 4; ++e) { a[e] = sigm(a[e]); b[e] = sigm(b[e]); }
                        *(u32x4*)(rowp + HALF * bj) = pack8(a, b); } }
        } else {
            const int mrow0 = (u.pm - 64) * BM + wr * 64 + fr, pl = pn - 26;
            if (pl < 2) { float* base = MKf + (size_t)mrow0 * DH + pl * 256 + wc * 32 + 8 * fq;
#pragma unroll
                for (int ai = 0; ai < 2; ++ai)
#pragma unroll
                    for (int m = 0; m < 4; ++m) { float* rowp = base + (size_t)(ai * HALF + m * 16) * DH;
#pragma unroll
                        for (int bj = 0; bj < 2; ++bj) { *(f32x4*)(rowp + HALF * bj) = acc[ai][bj][m][0]; *(f32x4*)(rowp + HALF * bj + 4) = acc[ai][bj][m][1]; } }
            } else { bf16_t* base = MV + (size_t)mrow0 * DH + (pl - 2) * 256 + wc * 32 + 8 * fq;
#pragma unroll
                for (int ai = 0; ai < 2; ++ai)
#pragma unroll
                    for (int m = 0; m < 4; ++m) { bf16_t* rowp = base + (size_t)(ai * HALF + m * 16) * DH;
#pragma unroll
                        for (int bj = 0; bj < 2; ++bj) *(u32x4*)(rowp + HALF * bj) = pack8(acc[ai][bj][m][0], acc[ai][bj][m][1]); } }
        }
    }
};
struct EpiMerged {
    static constexpr bool PERM = true, AFTER_DRAIN = true;
    const bf16_t* G0; const bf16_t* G2; float* T1; float* T2; bf16_t* MRG;
    __device__ __forceinline__ void fused(const acc_t& acc, const Unit& u, int wr, int wc, int fr, int fq, PG8_LAS unsigned char*, int, int) const {
        const int br = u.br; const int row0 = u.pm * BM + wr * 64 + fr, col0 = u.pn * BM + wc * 32 + 8 * fq;
        const bf16_t* G = (br < 2 ? G0 + (size_t)br * M * D : G2) + (size_t)row0 * D + col0;
        float* T = (u.pn < 2 ? T1 : T2) + (size_t)row0 * 512 + (col0 & 511);
        bf16_t* O = MRG + (size_t)row0 * D + col0;
#pragma unroll
        for (int ai = 0; ai < 2; ++ai)
#pragma unroll
            for (int m = 0; m < 4; ++m) { const size_t ro = (size_t)(ai * HALF + m * 16);
#pragma unroll
                for (int bj = 0; bj < 2; ++bj) {
                    const u32x4 gw = *(const u32x4*)(G + ro * D + HALF * bj);
                    f32x4 a = acc[ai][bj][m][0], b = acc[ai][bj][m][1];
                    a[0] *= bflo(gw.x); a[1] *= bfhi(gw.x); a[2] *= bflo(gw.y); a[3] *= bfhi(gw.y); b[0] *= bflo(gw.z); b[1] *= bfhi(gw.z); b[2] *= bflo(gw.w); b[3] *= bfhi(gw.w);
                    float* tp = T + ro * 512 + HALF * bj;
                    if (br > 0) { a += *(const f32x4*)tp; b += *(const f32x4*)(tp + 4); }
                    if (br < 2) { *(f32x4*)tp = a; *(f32x4*)(tp + 4) = b; } else *(u32x4*)(O + ro * D + HALF * bj) = pack8(a, b);
                }
                if (m & 1) asm volatile("" ::: "memory"); }
    }
};
struct EpiOut {
    static constexpr bool PERM = false, AFTER_DRAIN = true;
    const float* x; float* x1; bf16_t* A2; float* ssq;
    __device__ __forceinline__ void fused(const acc_t& acc, const Unit& u, int wr, int wc, int fr, int fq, PG8_LAS unsigned char*, int, int) const {
        const int row0 = u.pm * BM + wr * 64 + fr, col0 = u.pn * BM + wc * 32 + 4 * fq;
#pragma unroll
        for (int ai = 0; ai < 2; ++ai)
#pragma unroll
            for (int m = 0; m < 4; ++m) { const int row = row0 + ai * HALF + m * 16; const size_t off = (size_t)row * D + col0; float ss = 0.f;
#pragma unroll
                for (int bj = 0; bj < 2; ++bj)
#pragma unroll
                    for (int n = 0; n < 2; ++n) { const size_t o = off + bj * HALF + n * 16; const f32x4 r = *(const f32x4*)(x + o) + acc[ai][bj][m][n];
                        *(f32x4*)(x1 + o) = r; ss += (r[0] * r[0] + r[1] * r[1]) + (r[2] * r[2] + r[3] * r[3]);
                        u32x2 w; w.x = cvt_pk_bf16(r[0], r[1]); w.y = cvt_pk_bf16(r[2], r[3]); *(u32x2*)(A2 + o) = w; }
                (void)ss;
                if (m & 1) asm volatile("" ::: "memory"); }
    }
};
struct EpiUp {
    static constexpr bool PERM = true, AFTER_DRAIN = false;
    bf16_t* U;
    __device__ __forceinline__ void operator()(const acc_t& acc, const Unit& u, int wr, int wc, int fr, int fq) const {
        const int row0 = u.pm * BM + wr * 64 + fr; bf16_t* base = U + (size_t)row0 * FF + u.pn * BM + wc * 32 + 8 * fq;
#pragma unroll
        for (int ai = 0; ai < 2; ++ai)
#pragma unroll
            for (int m = 0; m < 4; ++m) { bf16_t* rowp = base + (size_t)(ai * HALF + m * 16) * FF;
#pragma unroll
                for (int bj = 0; bj < 2; ++bj) { f32x4 a = acc[ai][bj][m][0], b = acc[ai][bj][m][1];
#pragma unroll
                    for (int e = 0; e < 4; ++e) { const float ta = fmaxf(a[e], 0.f), tb = fmaxf(b[e], 0.f); a[e] = ta * ta; b[e] = tb * tb; }
                    *(u32x4*)(rowp + HALF * bj) = pack8(a, b); } }
    }
};
struct EpiDown {
    static constexpr bool PERM = false, AFTER_DRAIN = true;
    float* out; const float* ssq;
    __device__ __forceinline__ void fused(const acc_t& acc, const Unit& u, int wr, int wc, int fr, int fq, PG8_LAS unsigned char*, int, int) const {
        const int row0 = u.pm * BM + wr * 64 + fr, col0 = u.pn * BM + wc * 32 + 4 * fq;
#pragma unroll
        for (int ai = 0; ai < 2; ++ai)
#pragma unroll
            for (int m = 0; m < 4; ++m) { const int row = row0 + ai * HALF + m * 16; const size_t off = (size_t)row * D + col0;
                const f32x4* p = (const f32x4*)(ssq + (size_t)row * 16); const f32x4 a = p[0], b = p[1], c = p[2], d = p[3];
                const float ss = ((a[0] + a[1]) + (a[2] + a[3])) + ((b[0] + b[1]) + (b[2] + b[3])) + ((c[0] + c[1]) + (c[2] + c[3])) + ((d[0] + d[1]) + (d[2] + d[3]));
                const float r2 = 1.0f / (ss * (1.0f / D) + EPS);
#pragma unroll
                for (int bj = 0; bj < 2; ++bj)
#pragma unroll
                    for (int n = 0; n < 2; ++n) { float* q = out + off + bj * HALF + n * 16; *(f32x4*)q = *(const f32x4*)q + acc[ai][bj][m][n] * r2; }
                if (m & 1) asm volatile("" ::: "memory"); }
    }
};

template <class Epi, class Sched, bool ALIGN_EPI = false, bool SP2 = false>
__device__ __forceinline__ void gemm_phase(PG8_LAS unsigned char* lds, const int K, const Sched& S, const Epi& E) {
    const int tid = threadIdx.x, wid = __builtin_amdgcn_readfirstlane(tid >> 6), lane = tid & 63, wr = wid >> 2, wc = wid & 3, fr = lane & 15, fq = lane >> 4;
    const int nt = K / BK;
    unsigned voffA[2], voffB[2];
#pragma unroll
    for (int i = 0; i < 2; ++i) { int R, C; stage_rc(tid * 16 + i * 8192, R, C); const int Rb = Epi::PERM ? ((R & ~31) + perm32(R & 31)) : R;
        voffA[i] = (unsigned)(R * K + C) * 2u; voffB[i] = (unsigned)(Rb * K + C) * 2u; }
    const size_t kstep = (size_t)(BK * 2);
    const size_t hstep = (size_t)HALF * K * 2;
    const unsigned ldsw = (unsigned)wid * 1024u;
    const int aoff = lds_byte(wr * 64 + fr, fq * 8), boff = lds_byte(wc * 32 + fr, fq * 8);
#define PG8_SA(b, h) (((b) * 2 + (h)) * HTB)
#define PG8_SB(b, h) ((4 + (b) * 2 + (h)) * HTB)
#define PG8_STAGE(bufoff, gbase, voff) do { _Pragma("unroll") for (int _i = 0; _i < 2; ++_i) \
        __builtin_amdgcn_global_load_lds((const unsigned*)((const char*)(gbase) + (voff)[_i]), (PG8_LAS unsigned*)(lds + (bufoff) + ldsw + _i * 8192), 16, 0, 0); } while (0)
#define PG8_LDA(dst, b, h) do { _Pragma("unroll") for (int m = 0; m < 4; ++m) _Pragma("unroll") for (int k = 0; k < 2; ++k) dst[m][k] = *(const PG8_LAS bf16x8*)(lds + PG8_SA(b, h) + aoff + m * 2048 + k * 1024); } while (0)
#define PG8_LDB(dst, b, h) do { _Pragma("unroll") for (int n = 0; n < 2; ++n) _Pragma("unroll") for (int k = 0; k < 2; ++k) dst[n][k] = *(const PG8_LAS bf16x8*)(lds + PG8_SB(b, h) + boff + n * 2048 + k * 1024); } while (0)
#define PG8_MMA(ai, bj, At, Bt) do { __builtin_amdgcn_s_setprio(1); _Pragma("unroll") for (int m = 0; m < 4; ++m) _Pragma("unroll") for (int n = 0; n < 2; ++n) _Pragma("unroll") for (int k = 0; k < 2; ++k) \
        acc[ai][bj][m][n] = __builtin_amdgcn_mfma_f32_16x16x32_bf16(Bt[n][k], At[m][k], acc[ai][bj][m][n], 0, 0, 0); __builtin_amdgcn_s_setprio(0); } while (0)
#define PG8_WAIT_V(n) asm volatile("s_waitcnt vmcnt(" #n ")" ::: "memory")
#define PG8_WAIT_L(n) asm volatile("s_waitcnt lgkmcnt(" #n ")" ::: "memory")
#define PG8_BAR __builtin_amdgcn_s_barrier()
#define PG8_SCHED __builtin_amdgcn_sched_barrier(0)
    Unit cur, nxt; int ui = 0;
    if (!S.next(0, cur)) return;
    f32x4 acc[2][2][4][2];
#pragma unroll
    for (int a = 0; a < 2; ++a)
#pragma unroll
        for (int b = 0; b < 2; ++b)
#pragma unroll
            for (int m = 0; m < 4; ++m)
#pragma unroll
                for (int n = 0; n < 2; ++n) acc[a][b][m][n] = (f32x4){0.f, 0.f, 0.f, 0.f};
    bf16x8 At[4][2], B0[2][2], B1[2][2];
    const char* cA = S.a_ptr(cur); const char* cB = S.b_ptr(cur);
    S.a_ready(cur);
    if constexpr (SP2) {
        PG8_STAGE(PG8_SB(0, 0), cB, voffB); PG8_STAGE(PG8_SB(0, 1), cB + hstep, voffB); PG8_STAGE(PG8_SA(0, 0), cA, voffA); PG8_STAGE(PG8_SA(0, 1), cA + hstep, voffA);
        if (wr == 1) PG8_BAR;
        PG8_WAIT_V(2); PG8_BAR;
        PG8_STAGE(PG8_SB(1, 0), cB + kstep, voffB); PG8_STAGE(PG8_SA(1, 0), cA + kstep, voffA); PG8_STAGE(PG8_SB(1, 1), cB + hstep + kstep, voffB);
        PG8_WAIT_V(6); PG8_BAR;
    } else {
        PG8_STAGE(PG8_SB(0, 0), cB, voffB); PG8_STAGE(PG8_SA(0, 0), cA, voffA); PG8_STAGE(PG8_SB(0, 1), cB + hstep, voffB); PG8_STAGE(PG8_SA(0, 1), cA + hstep, voffA);
        if (wr == 1) PG8_BAR;
        PG8_WAIT_V(4); PG8_BAR;
        PG8_STAGE(PG8_SB(1, 0), cB + kstep, voffB); PG8_STAGE(PG8_SA(1, 0), cA + kstep, voffA); PG8_STAGE(PG8_SB(1, 1), cB + hstep + kstep, voffB);
        PG8_WAIT_V(6); PG8_BAR;
    }
    for (;;) {
        const bool has_next = S.next(ui + 1, nxt);
        const char* nA = has_next ? S.a_ptr(nxt) : cA; const char* nB = has_next ? S.b_ptr(nxt) : cB;
        for (int t = 0; t < nt; t += 2) {
            const bool last = (t == nt - 2);
            const char* a1 = cA + (size_t)(t + 1) * kstep;
            const char* a2 = last ? nA : cA + (size_t)(t + 2) * kstep; const char* b2 = last ? nB : cB + (size_t)(t + 2) * kstep;
            const char* a3 = a2 + kstep; const char* b3 = b2 + kstep;
            if (last && has_next) S.a_ready(nxt);
            if constexpr (SP2) {
            PG8_LDB(B0, 0, 0); PG8_LDB(B1, 0, 1); PG8_SCHED; PG8_LDA(At, 0, 0); PG8_STAGE(PG8_SA(1, 1), a1 + hstep, voffA);
            PG8_WAIT_V(8); PG8_WAIT_L(0); PG8_BAR; PG8_MMA(0, 0, At, B0); PG8_MMA(0, 1, At, B1); PG8_BAR; PG8_SCHED;
            PG8_LDA(At, 0, 1); PG8_STAGE(PG8_SB(0, 0), b2, voffB); PG8_STAGE(PG8_SB(0, 1), b2 + hstep, voffB); PG8_STAGE(PG8_SA(0, 0), a2, voffA);
            PG8_WAIT_V(8); PG8_WAIT_L(0); PG8_BAR; PG8_MMA(1, 0, At, B0); PG8_MMA(1, 1, At, B1); PG8_BAR; PG8_SCHED;
            PG8_LDB(B0, 1, 0); PG8_LDB(B1, 1, 1); PG8_SCHED; PG8_LDA(At, 1, 0); PG8_STAGE(PG8_SA(0, 1), a2 + hstep, voffA);
            PG8_WAIT_V(8); PG8_WAIT_L(0); PG8_BAR; PG8_MMA(0, 0, At, B0); PG8_MMA(0, 1, At, B1); PG8_BAR; PG8_SCHED;
            PG8_LDA(At, 1, 1); PG8_STAGE(PG8_SB(1, 0), b3, voffB); PG8_STAGE(PG8_SB(1, 1), b3 + hstep, voffB); PG8_STAGE(PG8_SA(1, 0), a3, voffA);
            PG8_WAIT_V(8); PG8_WAIT_L(0); PG8_BAR; PG8_MMA(1, 0, At, B0); PG8_MMA(1, 1, At, B1); PG8_BAR; PG8_SCHED;
            } else {
            PG8_LDB(B0, 0, 0); PG8_SCHED; PG8_LDA(At, 0, 0); PG8_STAGE(PG8_SA(1, 1), a1 + hstep, voffA);
            PG8_WAIT_L(8); PG8_BAR; PG8_WAIT_L(0); PG8_MMA(0, 0, At, B0); PG8_BAR; PG8_SCHED;
            PG8_LDB(B1, 0, 1); PG8_STAGE(PG8_SB(0, 0), b2, voffB);
            PG8_BAR; PG8_WAIT_L(0); PG8_MMA(0, 1, At, B1); PG8_BAR;
            PG8_LDA(At, 0, 1); PG8_STAGE(PG8_SA(0, 0), a2, voffA);
            PG8_BAR; PG8_WAIT_L(0); PG8_MMA(1, 0, At, B0); PG8_BAR; PG8_SCHED;
            PG8_STAGE(PG8_SB(0, 1), b2 + hstep, voffB);
            PG8_WAIT_V(6); PG8_BAR; PG8_MMA(1, 1, At, B1); PG8_BAR;
            PG8_LDB(B0, 1, 0); PG8_SCHED; PG8_LDA(At, 1, 0); PG8_STAGE(PG8_SA(0, 1), a2 + hstep, voffA);
            PG8_WAIT_L(8); PG8_BAR; PG8_WAIT_L(0); PG8_MMA(0, 0, At, B0); PG8_BAR; PG8_SCHED;
            PG8_LDB(B1, 1, 1); PG8_STAGE(PG8_SB(1, 0), b3, voffB);
            PG8_BAR; PG8_WAIT_L(0); PG8_MMA(0, 1, At, B1); PG8_BAR;
            PG8_LDA(At, 1, 1); PG8_STAGE(PG8_SA(1, 0), a3, voffA);
            PG8_BAR; PG8_WAIT_L(0); PG8_MMA(1, 0, At, B0); PG8_BAR; PG8_SCHED;
            PG8_STAGE(PG8_SB(1, 1), b3 + hstep, voffB);
            PG8_WAIT_V(6); PG8_BAR; PG8_MMA(1, 1, At, B1); PG8_BAR;
            }
        }
        if constexpr (ALIGN_EPI) { if (wr == 0) PG8_BAR; }
        if constexpr (!Epi::AFTER_DRAIN) { E(acc, cur, wr, wc, fr, fq); S.done(cur); }
        if (!has_next) break;
#pragma unroll
        for (int a = 0; a < 2; ++a)
#pragma unroll
            for (int b = 0; b < 2; ++b)
#pragma unroll
                for (int m = 0; m < 4; ++m)
#pragma unroll
                    for (int n = 0; n < 2; ++n) acc[a][b][m][n] = (f32x4){0.f, 0.f, 0.f, 0.f};
        cur = nxt; cA = nA; cB = nB; ++ui;
        if constexpr (ALIGN_EPI) { if (wr == 1) PG8_BAR; }
    }
    PG8_WAIT_V(0);
    if constexpr (!ALIGN_EPI) { if (wr == 0) PG8_BAR; }
    PG8_BAR;
    if constexpr (Epi::AFTER_DRAIN) { E.fused(acc, cur, wr, wc, fr, fq, lds, wid, lane); S.done(cur); }
#undef PG8_SA
#undef PG8_SB
#undef PG8_STAGE
#undef PG8_LDA
#undef PG8_LDB
#undef PG8_MMA
#undef PG8_WAIT_V
#undef PG8_WAIT_L
#undef PG8_BAR
#undef PG8_SCHED
}
}

namespace att {
typedef float f32x16 __attribute__((ext_vector_type(16)));
typedef float f32x2_t __attribute__((ext_vector_type(2)));
typedef __bf16 bf16x2_t __attribute__((ext_vector_type(2)));
typedef unsigned u32x4 __attribute__((ext_vector_type(4)));
typedef unsigned u32x2 __attribute__((ext_vector_type(2)));
constexpr int KP = 72, VP = 68;
constexpr int BUF_K = 0, BUF_V = 64 * KP * 2, BUF_B = BUF_V + 64 * VP * 2, BUF_BYTES = BUF_B + 256;
__device__ __forceinline__ int crow(int r, int hi) { return (r & 3) + 8 * (r >> 2) + 4 * hi; }
__device__ __forceinline__ unsigned cvtpk(float lo, float hi) { f32x2_t v = {lo, hi}; bf16x2_t b = __builtin_convertvector(v, bf16x2_t); return __builtin_bit_cast(unsigned, b); }
__device__ __forceinline__ float other_half(float v, int hi) { auto r = __builtin_amdgcn_permlane32_swap(__float_as_uint(v), __float_as_uint(v), false, false); return __uint_as_float(hi ? r[0] : r[1]); }
#define ATT_MFMA(a, b, c) __builtin_amdgcn_mfma_f32_32x32x16_bf16(a, b, c, 0, 0, 0)

template <int MODE>
__device__ __forceinline__ void unit64(const bf16* Q, const bf16* K, const bf16* V, bf16* O, const float* FC, const float* gq, const float* gk, int b, int h, int qb, LAS unsigned char* lds) {
    const int tid = threadIdx.x, lane = tid & 63, r32 = lane & 31, hi = lane >> 5; const int wid = __builtin_amdgcn_readfirstlane(tid >> 6);
    const size_t rowbase = (size_t)b * SEQ; const int q0 = qb * 256, qw0 = q0 + wid * 32;
    bf16x8 qf[4];
    { const bf16* qp = Q + (rowbase + qw0 + r32) * DH + h * HD + 8 * hi;
#pragma unroll
      for (int d0 = 0; d0 < 4; ++d0) { v4u w = *(const v4u*)(qp + 16 * d0);
          if (MODE == 1) { const float* g1 = gq + 16 * d0 + 8 * hi; const float* g2 = gk + 16 * d0 + 8 * hi;
              w.x = cvtpk(bflo(w.x) * g1[0] * g2[0], bfhi(w.x) * g1[1] * g2[1]); w.y = cvtpk(bflo(w.y) * g1[2] * g2[2], bfhi(w.y) * g1[3] * g2[3]);
              w.z = cvtpk(bflo(w.z) * g1[4] * g2[4], bfhi(w.z) * g1[5] * g2[5]); w.w = cvtpk(bflo(w.w) * g1[6] * g2[6], bfhi(w.w) * g1[7] * g2[7]); }
          qf[d0] = __builtin_bit_cast(bf16x8, w); } }
    f32x16 o0 = {}, o1 = {};
    float carry = 1.0f, mrun = -1e30f, lrun = 0.f;
    const int NT = 4 * qb + 4;
    const int skey = tid >> 3, sch = tid & 7;
    const bf16* kg = K + (rowbase + skey) * DH + h * HD + sch * 8; const bf16* vg = V + (rowbase + skey) * DH + h * HD + sch * 8;
    const float* fg = FC + (size_t)(b * NH + h) * SEQ;
    v4u kreg, vreg; float breg = 0.f;
#define ATT_LOAD(t) do { kreg = *(const v4u*)(kg + (size_t)(t) * 64 * DH); vreg = *(const v4u*)(vg + (size_t)(t) * 64 * DH); if (MODE == 1 && tid < 64) breg = -fg[(t) * 64 + tid] * LOG2E; } while (0)
#define ATT_WRITE(bufo) do { LAS unsigned char* bb_ = lds + (bufo); *(LAS v4u*)(bb_ + BUF_K + (skey * KP + sch * 8) * 2) = kreg; \
        LAS unsigned short* vt_ = (LAS unsigned short*)(bb_ + BUF_V) + (sch * 8) * VP + skey; \
        vt_[0 * VP] = (unsigned short)(vreg.x & 0xffffu); vt_[1 * VP] = (unsigned short)(vreg.x >> 16); vt_[2 * VP] = (unsigned short)(vreg.y & 0xffffu); vt_[3 * VP] = (unsigned short)(vreg.y >> 16); \
        vt_[4 * VP] = (unsigned short)(vreg.z & 0xffffu); vt_[5 * VP] = (unsigned short)(vreg.z >> 16); vt_[6 * VP] = (unsigned short)(vreg.w & 0xffffu); vt_[7 * VP] = (unsigned short)(vreg.w >> 16); \
        if (MODE == 1 && tid < 64) *(LAS float*)(bb_ + BUF_B + tid * 4) = breg; } while (0)
    ATT_LOAD(NT - 1); ATT_WRITE(0); __syncthreads();
    for (int it = 0; it < NT; ++it) {
        const int kt = NT - 1 - it, cur = (it & 1) * BUF_BYTES, nxt = BUF_BYTES - cur;
        if (it + 1 < NT) ATT_LOAD(kt - 1);
        const int key0 = kt * 64;
        if (key0 <= qw0 + 31) {
            const LAS unsigned char* bb = lds + cur;
            f32x16 p0, p1;
            if (MODE == 1) { const LAS float* nb = (const LAS float*)(bb + BUF_B) + 4 * hi;
#pragma unroll
                for (int g = 0; g < 4; ++g) { const f32x4 a = *(const LAS f32x4*)(nb + 8 * g), c = *(const LAS f32x4*)(nb + 32 + 8 * g);
                    p0[4 * g] = a[0]; p0[4 * g + 1] = a[1]; p0[4 * g + 2] = a[2]; p0[4 * g + 3] = a[3]; p1[4 * g] = c[0]; p1[4 * g + 1] = c[1]; p1[4 * g + 2] = c[2]; p1[4 * g + 3] = c[3]; } }
            else { p0 = f32x16{}; p1 = f32x16{}; }
            { const LAS unsigned char* kb = bb + BUF_K + (r32 * KP + 8 * hi) * 2;
#pragma unroll
              for (int d0 = 0; d0 < 4; ++d0) { const bf16x8 a0 = *(const LAS bf16x8*)(kb + d0 * 32), a1 = *(const LAS bf16x8*)(kb + 32 * KP * 2 + d0 * 32);
                  p0 = ATT_MFMA(a0, qf[d0], p0); p1 = ATT_MFMA(a1, qf[d0], p1); } }
            const int qrow = qw0 + r32; const bool diag = key0 + 63 >= qw0;
            if (MODE == 0) {
                f32x16 rm0, rm1;
#pragma unroll
                for (int r = 0; r < 16; ++r) {
                    { const float z = p0[r], t = __builtin_amdgcn_exp2f(-__builtin_fabsf(z)), rc = __builtin_amdgcn_rcpf(1.0f + t), sm = t * rc; const bool pos = z >= 0.f; float be = pos ? rc : sm, re = pos ? sm : rc;
                      if (diag && key0 + crow(r, hi) >= qrow) { be = 0.f; re = 1.0f; } p0[r] = be; rm0[r] = re; }
                    { const float z = p1[r], t = __builtin_amdgcn_exp2f(-__builtin_fabsf(z)), rc = __builtin_amdgcn_rcpf(1.0f + t), sm = t * rc; const bool pos = z >= 0.f; float be = pos ? rc : sm, re = pos ? sm : rc;
                      if (diag && key0 + 32 + crow(r, hi) >= qrow) { be = 0.f; re = 1.0f; } p1[r] = be; rm1[r] = re; }
                }
                float gp[8], pg[8];
#pragma unroll
                for (int g = 0; g < 4; ++g) { gp[g] = (rm0[4 * g] * rm0[4 * g + 1]) * (rm0[4 * g + 2] * rm0[4 * g + 3]); gp[4 + g] = (rm1[4 * g] * rm1[4 * g + 1]) * (rm1[4 * g + 2] * rm1[4 * g + 3]); }
#pragma unroll
                for (int g = 0; g < 8; ++g) pg[g] = other_half(gp[g], hi);
                float run = carry;
#pragma unroll
                for (int g = 7; g >= 0; --g) {
                    const float aft = hi ? run : run * pg[g];
                    run = run * (gp[g] * pg[g]);
                    if (g >= 4) { const int r = 4 * (g - 4); const float a3 = aft, a2 = a3 * rm1[r + 3], a1 = a2 * rm1[r + 2], a0 = a1 * rm1[r + 1];
                        p1[r] *= a0; p1[r + 1] *= a1; p1[r + 2] *= a2; p1[r + 3] *= a3; }
                    else { const int r = 4 * g; const float a3 = aft, a2 = a3 * rm0[r + 3], a1 = a2 * rm0[r + 2], a0 = a1 * rm0[r + 1];
                        p0[r] *= a0; p0[r + 1] *= a1; p0[r + 2] *= a2; p0[r + 3] *= a3; }
                }
                carry = run;
            } else {
                if (diag) {
#pragma unroll
                    for (int r = 0; r < 16; ++r) { if (key0 + crow(r, hi) > qrow) p0[r] = -1e30f; if (key0 + 32 + crow(r, hi) > qrow) p1[r] = -1e30f; } }
                float mx = fmaxf(p0[0], p1[0]);
#pragma unroll
                for (int r = 1; r < 16; ++r) mx = fmaxf(mx, fmaxf(p0[r], p1[r]));
                mx = fmaxf(mx, other_half(mx, hi));
                const float mn = fmaxf(mrun, mx);
                if (__any(mn > mrun)) { const float al = __builtin_amdgcn_exp2f(mrun - mn); lrun *= al;
#pragma unroll
                    for (int r = 0; r < 16; ++r) { o0[r] *= al; o1[r] *= al; } }
                mrun = mn; float ls = 0.f;
#pragma unroll
                for (int r = 0; r < 16; ++r) { p0[r] = __builtin_amdgcn_exp2f(p0[r] - mn); p1[r] = __builtin_amdgcn_exp2f(p1[r] - mn); ls += p0[r] + p1[r]; }
                lrun += ls;
            }
            const LAS unsigned char* vb = bb + BUF_V + (r32 * VP + 4 * hi) * 2;
#pragma unroll
            for (int ks = 0; ks < 4; ++ks) {
                const int rb = 8 * (ks & 1); u32x4 pw;
                if (ks < 2) { pw.x = cvtpk(p0[rb], p0[rb + 1]); pw.y = cvtpk(p0[rb + 2], p0[rb + 3]); pw.z = cvtpk(p0[rb + 4], p0[rb + 5]); pw.w = cvtpk(p0[rb + 6], p0[rb + 7]); }
                else        { pw.x = cvtpk(p1[rb], p1[rb + 1]); pw.y = cvtpk(p1[rb + 2], p1[rb + 3]); pw.z = cvtpk(p1[rb + 4], p1[rb + 5]); pw.w = cvtpk(p1[rb + 6], p1[rb + 7]); }
                const bf16x8 pf = __builtin_bit_cast(bf16x8, pw);
                const int koff = (16 * ks) * 2;
                const u32x2 a0l = *(const LAS u32x2*)(vb + koff), a0h = *(const LAS u32x2*)(vb + koff + 16);
                const u32x2 a1l = *(const LAS u32x2*)(vb + 32 * VP * 2 + koff), a1h = *(const LAS u32x2*)(vb + 32 * VP * 2 + koff + 16);
                const u32x4 a0 = {a0l.x, a0l.y, a0h.x, a0h.y}, a1 = {a1l.x, a1l.y, a1h.x, a1h.y};
                o0 = ATT_MFMA(__builtin_bit_cast(bf16x8, a0), pf, o0); o1 = ATT_MFMA(__builtin_bit_cast(bf16x8, a1), pf, o1);
            }
        }
        if (it + 1 < NT) ATT_WRITE(nxt);
        __syncthreads();
    }
    float inv = 1.0f;
    if (MODE == 1) { const float lt = lrun + other_half(lrun, hi); inv = 1.0f / lt; }
    bf16* op = O + (rowbase + qw0 + r32) * DH + h * HD + 4 * hi;
#pragma unroll
    for (int g = 0; g < 4; ++g) { u32x2 w0, w1; w0.x = cvtpk(o0[4 * g] * inv, o0[4 * g + 1] * inv); w0.y = cvtpk(o0[4 * g + 2] * inv, o0[4 * g + 3] * inv);
        w1.x = cvtpk(o1[4 * g] * inv, o1[4 * g + 1] * inv); w1.y = cvtpk(o1[4 * g + 2] * inv, o1[4 * g + 3] * inv);
        *(u32x2*)(op + 8 * g) = w0; *(u32x2*)(op + 32 + 8 * g) = w1; }
#undef ATT_LOAD
#undef ATT_WRITE
}
constexpr int MKP = 136, MVP = 68;
constexpr int MBUF_K = 0, MBUF_V = 64 * MKP * 2, MBUF_BYTES = MBUF_V + 128 * MVP * 2;
__device__ __forceinline__ void unit_mem(bf16* MQ, const float* MKf, const bf16* MV, const float* g_mq, const float* g_mk, int b, int hm, int qb, LAS unsigned char* lds) {
    const int tid = threadIdx.x, lane = tid & 63, r32 = lane & 31, hi = lane >> 5; const int wid = __builtin_amdgcn_readfirstlane(tid >> 6);
    const size_t rowq = (size_t)b * SEQ + qb * 256 + wid * 32 + r32;
    bf16x8 qf[8];
    { const bf16* qp = MQ + rowq * DH + hm * MHD + 8 * hi; v4u w[8]; float ss = 0.f;
#pragma unroll
      for (int d0 = 0; d0 < 8; ++d0) { w[d0] = *(const v4u*)(qp + 16 * d0);
          const float a0 = bflo(w[d0].x), a1 = bfhi(w[d0].x), a2 = bflo(w[d0].y), a3 = bfhi(w[d0].y), a4 = bflo(w[d0].z), a5 = bfhi(w[d0].z), a6 = bflo(w[d0].w), a7 = bfhi(w[d0].w);
          ss += (a0 * a0 + a1 * a1) + (a2 * a2 + a3 * a3) + (a4 * a4 + a5 * a5) + (a6 * a6 + a7 * a7); }
      ss += other_half(ss, hi);
      const float rq = 1.0f / sqrtf(ss * (1.0f / MHD) + EPS);
#pragma unroll
      for (int d0 = 0; d0 < 8; ++d0) { v4u o; o.x = cvtpk(bflo(w[d0].x) * rq, bfhi(w[d0].x) * rq); o.y = cvtpk(bflo(w[d0].y) * rq, bfhi(w[d0].y) * rq);
          o.z = cvtpk(bflo(w[d0].z) * rq, bfhi(w[d0].z) * rq); o.w = cvtpk(bflo(w[d0].w) * rq, bfhi(w[d0].w) * rq); qf[d0] = __builtin_bit_cast(bf16x8, o); } }
    f32x16 o0 = {}, o1 = {}, o2 = {}, o3 = {};
    float mrun = -1e30f, lrun = 0.f;
    const int skey = tid >> 3, sch = tid & 7;
    float gg[16];
#pragma unroll
    for (int i = 0; i < 16; ++i) gg[i] = g_mk[sch * 16 + i] * g_mq[sch * 16 + i] * C2M;
    const float* kg = MKf + (size_t)(b * MEMLEN + skey) * DH + hm * MHD + sch * 16; const bf16* vg = MV + (size_t)(b * MEMLEN + skey) * DH + hm * MHD + sch * 16;
    f32x4 kr[4]; v4u vr[2];
#define MATT_LOAD(t) do { const f32x4* kp_ = (const f32x4*)(kg + (size_t)(t) * 64 * DH); kr[0] = kp_[0]; kr[1] = kp_[1]; kr[2] = kp_[2]; kr[3] = kp_[3]; \
        const v4u* vp_ = (const v4u*)(vg + (size_t)(t) * 64 * DH); vr[0] = vp_[0]; vr[1] = vp_[1]; } while (0)
#define MATT_WRITE(bufo) do { LAS unsigned char* bb_ = lds + (bufo); float ss_ = 0.f; \
        _Pragma("unroll") for (int i_ = 0; i_ < 4; ++i_) ss_ += (kr[i_][0] * kr[i_][0] + kr[i_][1] * kr[i_][1]) + (kr[i_][2] * kr[i_][2] + kr[i_][3] * kr[i_][3]); \
        ss_ += __shfl_xor(ss_, 1); ss_ += __shfl_xor(ss_, 2); ss_ += __shfl_xor(ss_, 4); \
        const float rk_ = 1.0f / sqrtf(ss_ * (1.0f / MHD) + EPS); v4u k0_, k1_; \
        k0_.x = cvtpk(kr[0][0] * rk_ * gg[0], kr[0][1] * rk_ * gg[1]); k0_.y = cvtpk(kr[0][2] * rk_ * gg[2], kr[0][3] * rk_ * gg[3]); k0_.z = cvtpk(kr[1][0] * rk_ * gg[4], kr[1][1] * rk_ * gg[5]); k0_.w = cvtpk(kr[1][2] * rk_ * gg[6], kr[1][3] * rk_ * gg[7]); \
        k1_.x = cvtpk(kr[2][0] * rk_ * gg[8], kr[2][1] * rk_ * gg[9]); k1_.y = cvtpk(kr[2][2] * rk_ * gg[10], kr[2][3] * rk_ * gg[11]); k1_.z = cvtpk(kr[3][0] * rk_ * gg[12], kr[3][1] * rk_ * gg[13]); k1_.w = cvtpk(kr[3][2] * rk_ * gg[14], kr[3][3] * rk_ * gg[15]); \
        LAS v4u* kd_ = (LAS v4u*)(bb_ + MBUF_K + (skey * MKP + sch * 16) * 2); kd_[0] = k0_; kd_[1] = k1_; \
        LAS unsigned short* vt_ = (LAS unsigned short*)(bb_ + MBUF_V) + (sch * 16) * MVP + skey; \
        _Pragma("unroll") for (int i_ = 0; i_ < 2; ++i_) { const v4u v_ = vr[i_]; LAS unsigned short* q_ = vt_ + (8 * i_) * MVP; \
            q_[0 * MVP] = (unsigned short)(v_.x & 0xffffu); q_[1 * MVP] = (unsigned short)(v_.x >> 16); q_[2 * MVP] = (unsigned short)(v_.y & 0xffffu); q_[3 * MVP] = (unsigned short)(v_.y >> 16); \
            q_[4 * MVP] = (unsigned short)(v_.z & 0xffffu); q_[5 * MVP] = (unsigned short)(v_.z >> 16); q_[6 * MVP] = (unsigned short)(v_.w & 0xffffu); q_[7 * MVP] = (unsigned short)(v_.w >> 16); } } while (0)
    MATT_LOAD(0); MATT_WRITE(0); __syncthreads();
#pragma unroll 1
    for (int kt = 0; kt < 4; ++kt) {
        const int cur = (kt & 1) * MBUF_BYTES, nxt = MBUF_BYTES - cur;
        if (kt + 1 < 4) MATT_LOAD(kt + 1);
        const LAS unsigned char* bb = lds + cur;
        f32x16 p0 = {}, p1 = {};
        { const LAS unsigned char* kb = bb + MBUF_K + (r32 * MKP + 8 * hi) * 2;
#pragma unroll
          for (int d0 = 0; d0 < 8; ++d0) { const bf16x8 a0 = *(const LAS bf16x8*)(kb + d0 * 32), a1 = *(const LAS bf16x8*)(kb + 32 * MKP * 2 + d0 * 32);
              p0 = ATT_MFMA(a0, qf[d0], p0); p1 = ATT_MFMA(a1, qf[d0], p1); } }
        float mx = fmaxf(p0[0], p1[0]);
#pragma unroll
        for (int r = 1; r < 16; ++r) mx = fmaxf(mx, fmaxf(p0[r], p1[r]));
        mx = fmaxf(mx, other_half(mx, hi));
        const float mn = fmaxf(mrun, mx);
        if (__any(mn > mrun)) { const float al = __builtin_amdgcn_exp2f(mrun - mn); lrun *= al;
#pragma unroll
            for (int r = 0; r < 16; ++r) { o0[r] *= al; o1[r] *= al; o2[r] *= al; o3[r] *= al; } }
        mrun = mn; float ls = 0.f;
#pragma unroll
        for (int r = 0; r < 16; ++r) { p0[r] = __builtin_amdgcn_exp2f(p0[r] - mn); p1[r] = __builtin_amdgcn_exp2f(p1[r] - mn); ls += p0[r] + p1[r]; }
        lrun += ls;
        const LAS unsigned char* vb = bb + MBUF_V + (r32 * MVP + 4 * hi) * 2;
#pragma unroll
        for (int ks = 0; ks < 4; ++ks) {
            const int rb = 8 * (ks & 1); u32x4 pw;
            if (ks < 2) { pw.x = cvtpk(p0[rb], p0[rb + 1]); pw.y = cvtpk(p0[rb + 2], p0[rb + 3]); pw.z = cvtpk(p0[rb + 4], p0[rb + 5]); pw.w = cvtpk(p0[rb + 6], p0[rb + 7]); }
            else        { pw.x = cvtpk(p1[rb], p1[rb + 1]); pw.y = cvtpk(p1[rb + 2], p1[rb + 3]); pw.z = cvtpk(p1[rb + 4], p1[rb + 5]); pw.w = cvtpk(p1[rb + 6], p1[rb + 7]); }
            const bf16x8 pf = __builtin_bit_cast(bf16x8, pw);
            const int koff = (16 * ks) * 2;
#define MATT_PV(ob, db) do { const u32x2 l_ = *(const LAS u32x2*)(vb + (db) * 32 * MVP * 2 + koff), h_ = *(const LAS u32x2*)(vb + (db) * 32 * MVP * 2 + koff + 16); \
                const u32x4 a_ = {l_.x, l_.y, h_.x, h_.y}; ob = ATT_MFMA(__builtin_bit_cast(bf16x8, a_), pf, ob); } while (0)
            MATT_PV(o0, 0); MATT_PV(o1, 1); MATT_PV(o2, 2); MATT_PV(o3, 3);
#undef MATT_PV
        }
        if (kt + 1 < 4) MATT_WRITE(nxt);
        __syncthreads();
    }
    const float inv = 1.0f / (lrun + other_half(lrun, hi));
    bf16* op = MQ + rowq * DH + hm * MHD + 4 * hi;
#pragma unroll
    for (int g = 0; g < 4; ++g) {
#define MATT_ST(ob, db) do { u32x2 w_; w_.x = cvtpk(ob[4 * g] * inv, ob[4 * g + 1] * inv); w_.y = cvtpk(ob[4 * g + 2] * inv, ob[4 * g + 3] * inv); *(u32x2*)(op + 32 * (db) + 8 * g) = w_; } while (0)
        MATT_ST(o0, 0); MATT_ST(o1, 1); MATT_ST(o2, 2); MATT_ST(o3, 3);
#undef MATT_ST
    }
#undef MATT_LOAD
#undef MATT_WRITE
}
}

constexpr int N_PHASES = 9;
#ifndef OPT_P1
#define OPT_P1 1
#endif
#ifndef OPT_P3
#define OPT_P3 1
#endif
#ifndef OPT_ATT
#define OPT_ATT 1
#endif
#ifndef OPT_P4
#define OPT_P4 1
#endif
#ifndef OPT_P5
#define OPT_P5 1
#endif
#ifndef OPT_P6
#define OPT_P6 1
#endif
#ifndef MK_N_LAUNCHES
#define MK_N_LAUNCHES 1
#endif
constexpr int N_LAUNCHES = MK_N_LAUNCHES;
struct Args { const float* in[18]; float* out; unsigned char* ws; int ph_lo, ph_hi, li, pad; };

__global__ void __launch_bounds__(NTHREADS, 2) skel_fwd(Args args) {
    extern __shared__ __attribute__((aligned(16))) unsigned char lds[];
    Frame F;
    F.lds = (LAS unsigned char*)lds;
    F.MISC = (volatile LAS unsigned*)(F.lds + MISC_OFF);
    F.tid = threadIdx.x; F.lane = F.tid & 63; F.wave = __builtin_amdgcn_readfirstlane(F.tid >> 6);
    F.G = gridDim.x; { const int bx = blockIdx.x; F.vcu = (F.G % 8 == 0) ? (bx % 8) * (F.G / 8) + bx / 8 : bx; }
    unsigned char* ws = args.ws;
    F.ctl = (gu32*)(ws + WS_CTL);
    F.x = args.in[0]; F.mem = args.in[1]; F.g_mix = args.in[2]; F.g_memn = args.in[3]; F.w_in = args.in[4]; F.b_forget = args.in[5]; F.g_fq = args.in[6]; F.g_fk = args.in[7];
    F.g_mq = args.in[8]; F.g_mk = args.in[9]; F.w_mkv = args.in[10]; F.w_bsb = args.in[11]; F.w_bfx = args.in[12]; F.w_bmm = args.in[13]; F.w_out = args.in[14]; F.g_mlp = args.in[15];
    F.w_up = args.in[16]; F.w_dn = args.in[17]; F.out = args.out;
    F.logf = (float*)(ws + WS_LOGF); F.FC = (float*)(ws + WS_FC); F.ssq = (float*)(ws + WS_SSQ); F.MKf = (float*)(ws + WS_MKF);
    F.Win_t = (bf16*)(ws + WS_WIN); F.Wmkv_t = (bf16*)(ws + WS_WMKV); F.Wbr_t = (bf16*)(ws + WS_WBR); F.Wout_t = (bf16*)(ws + WS_WOUT); F.Wup_t = (bf16*)(ws + WS_WUP); F.Wdn_t = (bf16*)(ws + WS_WDN);
    F.MHb = (bf16*)(ws + WS_MH); F.MV = (bf16*)(ws + WS_MV); F.XN = (bf16*)(ws + WS_XN);
    F.SBQ = (bf16*)(ws + WS_SBQ); F.SBK = (bf16*)(ws + WS_SBK); F.SBV = (bf16*)(ws + WS_SBV); F.FXQ = (bf16*)(ws + WS_FXQ); F.FXK = (bf16*)(ws + WS_FXK); F.FXV = (bf16*)(ws + WS_FXV); F.MQ = (bf16*)(ws + WS_MQ);
    F.G0 = (bf16*)args.out; F.G1 = (bf16*)args.out + (size_t)M * D; F.G2 = (bf16*)(ws + WS_G2); F.MRG = (bf16*)(ws + WS_MRG); F.U = (bf16*)(ws + WS_U);
    for (int u = F.tid; u < (LDS_BYTES - LDSCTL_OFF) / 4; u += NTHREADS) ((LAS unsigned*)(F.lds + LDSCTL_OFF))[u] = 0u;
    __syncthreads();
    XcdBarrier bar; bar.bar = (unsigned*)(F.ctl + CW_BAR); bar.x = 0; bar.st = nullptr;
    if (N_LAUNCHES == 1) bar = xcd_barrier_post((unsigned*)(F.ctl + CW_BAR), F.MISC + 8);
#define GRID_BAR() do { if (N_LAUNCHES == 1) xcd_barrier(bar); } while (0)
    const int lo = args.ph_lo, hi = args.ph_hi;
#define IN(k) (lo <= (k) && (k) < hi)
#define BOTH(k) (IN(k) && IN((k) + 1))
    const int wg = (int)blockIdx.x, nwg = F.G;

    if (IN(0)) { p0_prologue(F); if (BOTH(0)) GRID_BAR(); }
    if (IN(1)) {
        fcumsum(F); VM_WAIT();
#if OPT_P1
        { pg8::EpiProj E{F.SBQ, F.G0, F.G2, F.MKf, F.MV};
          pg8::SchedP1 S{F.G, (int)blockIdx.x, (const char*)F.XN, (const char*)F.Win_t};
          pg8::gemm_phase<pg8::EpiProj, pg8::SchedP1, false, true>(F.lds, D, S, E); }
#else
        { EpiProjN E{F.SBQ, F.G0, F.G2}; ngemm(F.XN, D, F.Win_t, D, M, NPROJ, D, E, wg, nwg); }
        { EpiMkvN E{F.MKf, F.MV}; ngemm(F.MHb, D, F.Wmkv_t, D, MROWS, 1024, D, E, wg, nwg); }
#endif
        if (BOTH(1)) GRID_BAR();
    }
    if (IN(2)) {
#if !OPT_P1
        headnorm_naive(F);
#endif
        if (BOTH(2)) { if (!OPT_P1) GRID_BAR(); } }
    if (IN(3)) {
#if OPT_ATT
        for (int v = F.vcu; v < 256; v += F.G) { const int bh = v >> 2, s4 = v & 3;
            att::unit64<0>(F.SBQ, F.SBK, F.SBV, F.SBQ, F.FC, F.g_fq, F.g_fk, bh >> 3, bh & 7, 7 - s4, F.lds); __syncthreads();
            att::unit64<0>(F.SBQ, F.SBK, F.SBV, F.SBQ, F.FC, F.g_fq, F.g_fk, bh >> 3, bh & 7, s4, F.lds); __syncthreads();
            att::unit64<1>(F.FXQ, F.FXK, F.FXV, F.FXQ, F.FC, F.g_fq, F.g_fk, bh >> 3, bh & 7, 7 - s4, F.lds); __syncthreads();
            att::unit64<1>(F.FXQ, F.FXK, F.FXV, F.FXQ, F.FC, F.g_fq, F.g_fk, bh >> 3, bh & 7, s4, F.lds); __syncthreads(); }
#else
        nattn64<0>(F.SBQ, F.SBK, F.SBV, F.SBQ, F.FC, F.g_fq, F.g_fk, wg, nwg);
        nattn64<1>(F.FXQ, F.FXK, F.FXV, F.FXQ, F.FC, F.g_fq, F.g_fk, wg, nwg);
#endif
#if OPT_ATT
        for (int v = F.vcu; v < 256; v += F.G) { att::unit_mem(F.MQ, F.MKf, F.MV, F.g_mq, F.g_mk, v >> 5, (v >> 3) & 3, v & 7, F.lds); __syncthreads(); }
#else
        nattn_mem(F, wg, nwg);
#endif
        if (BOTH(3)) GRID_BAR();
    }
    if (IN(4)) {
#if OPT_P3
        { pg8::EpiMerged E{F.G0, F.G2, (float*)(ws + WS_T1), (float*)(ws + WS_T2), F.MRG};
          for (int br = 0; br < 3; ++br) { pg8::SchedP3 S{F.G, (int)blockIdx.x, (const char*)F.SBQ, (const char*)F.Wbr_t, br};
              pg8::gemm_phase<pg8::EpiMerged, pg8::SchedP3, false, true>(F.lds, DH, S, E); } }
#else
        nmerged(F, wg, nwg);
#endif
        if (BOTH(4)) GRID_BAR(); }
    if (IN(5)) {
#if OPT_P4
        { pg8::SchedPlain S{64, 4, F.G, (int)blockIdx.x, (const char*)F.MRG, (const char*)F.Wout_t, (size_t)256 * D * 2};
          pg8::EpiOut E{F.x, F.out, F.XN, F.ssq};
          pg8::gemm_phase<pg8::EpiOut, pg8::SchedPlain, false, true>(F.lds, D, S, E); }
#else
        { EpiOutN E{F.x, F.out, F.XN}; ngemm(F.MRG, D, F.Wout_t, D, M, D, D, E, wg, nwg); }
#endif
        if (BOTH(5)) GRID_BAR(); }
    if (IN(6)) {
        ssq_naive(F);
        if (BOTH(6)) { GRID_BAR(); } }
    if (IN(7)) {
#if OPT_P5
        { pg8::SchedPlain S{64, 16, F.G, (int)blockIdx.x, (const char*)F.XN, (const char*)F.Wup_t, (size_t)256 * D * 2};
          pg8::EpiUp E{F.U};
          pg8::gemm_phase<pg8::EpiUp, pg8::SchedPlain, false, true>(F.lds, D, S, E); }
#else
        { EpiUpN E{F.ssq, F.U}; ngemm(F.XN, D, F.Wup_t, D, M, FF, D, E, wg, nwg); }
#endif
        if (BOTH(7)) GRID_BAR(); }
    if (IN(8)) {
#if OPT_P6
        { pg8::SchedPlain S{64, 4, F.G, (int)blockIdx.x, (const char*)F.U, (const char*)F.Wdn_t, (size_t)256 * FF * 2};
          pg8::EpiDown E{F.out, F.ssq};
          pg8::gemm_phase<pg8::EpiDown, pg8::SchedPlain, false, true>(F.lds, FF, S, E); }
#else
        { EpiDnN E{F.out, F.ssq}; ngemm(F.U, FF, F.Wdn_t, FF, M, D, FF, E, wg, nwg); }
#endif
    }
#undef IN
#undef BOTH
}

extern "C" void kernel_launch(void* const* d_in, const int* in_sizes, int n_in, void* d_out, int out_size, void* d_ws, size_t ws_size, hipStream_t stream) {
    static int grid = 0;
    if (grid == 0) {
        if (n_in != 18 || in_sizes[0] != M * D || out_size != M * D || ws_size < WS_END) { fprintf(stderr, "kernel_launch: unexpected shapes (n_in %d, in0 %d, out %d, ws %zu); nothing launched\n", n_in, n_in > 0 ? in_sizes[0] : -1, out_size, ws_size); grid = -1; return; }
        int dev = 0, cus = 0, per_cu = 0;
        if (hipGetDevice(&dev) != hipSuccess || hipDeviceGetAttribute(&cus, hipDeviceAttributeMultiprocessorCount, dev) != hipSuccess) { grid = -1; return; }
        if (hipFuncSetAttribute((const void*)skel_fwd, hipFuncAttributeMaxDynamicSharedMemorySize, LDS_BYTES) != hipSuccess) { fprintf(stderr, "kernel_launch: hipFuncSetAttribute failed\n"); grid = -1; return; }
        if (hipOccupancyMaxActiveBlocksPerMultiprocessor(&per_cu, (const void*)skel_fwd, NTHREADS, LDS_BYTES) != hipSuccess || per_cu < 1) fprintf(stderr, "kernel_launch: occupancy query reports %d\n", per_cu);
        (void)hipGetLastError();
        grid = cus;
    }
    if (grid < 0) return;
    if (hipMemsetAsync((char*)d_ws + WS_CTL, 0, CTL_ZERO_BYTES, stream) != hipSuccess) return;
    Args a{};
    for (int i = 0; i < 18; ++i) a.in[i] = (const float*)d_in[i];
    a.out = (float*)d_out; a.ws = (unsigned char*)d_ws;
    for (int li = 0; li < N_LAUNCHES; ++li) {
        a.ph_lo = (N_LAUNCHES == 1) ? 0 : li; a.ph_hi = (N_LAUNCHES == 1) ? N_PHASES : li + 1; a.li = li;
        hipLaunchKernelGGL(skel_fwd, dim3(grid), dim3(NTHREADS), LDS_BYTES, stream, a);
        if (hipPeekAtLastError() != hipSuccess) break;
    }
}
```

```cpp
#include <hip/hip_runtime.h>
#include <cstdio>
#include <cstdint>
#ifndef TIMING_PHASE
#ifndef GPROBE
#define GPROBE 0
#endif
#ifndef GPSEL
#define GPSEL 0
#endif
#ifndef GPOFF
#define GPOFF 0.f
#endif
#ifndef GPSCALE
#define GPSCALE 1.f
#endif
#define TIMING_PHASE -1
#endif

#define GAS __attribute__((address_space(1)))
#define LAS __attribute__((address_space(3)))
typedef unsigned short bf16;
typedef short bf16x8 __attribute__((ext_vector_type(8)));
typedef float f32x4 __attribute__((ext_vector_type(4)));
typedef unsigned v4u __attribute__((ext_vector_type(4)));
typedef GAS unsigned gu32;
#define RLX_AGENT __ATOMIC_RELAXED, __HIP_MEMORY_SCOPE_AGENT
#define LDS_WAIT() asm volatile("s_waitcnt lgkmcnt(0)" ::: "memory")
#define VM_WAIT() asm volatile("s_waitcnt vmcnt(0)" ::: "memory")

constexpr int NWAVES = 8, NTHREADS = 512;
constexpr int BATCH = 8, SEQ = 2048, M = BATCH * SEQ, D = 1024, MEMLEN = 256, MROWS = BATCH * MEMLEN;
constexpr int HD = 64, NH = 8, MNH = 4, MHD = 128, DH = 512, FF = 4096;
constexpr int DIN = 6664, NPROJ = 6656;
constexpr float EPS = 1e-6f, LOG2E = 1.4426950408889634f, LN2 = 0.6931471805599453f;
constexpr float C2 = 0.125f * LOG2E;
constexpr float C2M = 0.08838834764831845f * LOG2E;

constexpr size_t MiB = 1u << 20;
constexpr size_t WS_CTL = 0, CTL_ZERO_BYTES = 65536;
constexpr size_t WS_LOGF = 1 * MiB, WS_FC = 1 * MiB + 512 * 1024, WS_SSQ = 2 * MiB;
constexpr size_t WS_WIN = 3 * MiB, WS_WMKV = 16 * MiB, WS_WBR = 18 * MiB, WS_WOUT = 21 * MiB, WS_WUP = 23 * MiB, WS_WDN = 31 * MiB;
constexpr size_t WS_MV = 39 * MiB, WS_XN = 44 * MiB, WS_MH = 76 * MiB;
constexpr size_t WS_T1 = 96 * MiB, WS_T2 = 144 * MiB;
constexpr size_t WS_SBQ = 80 * MiB, WS_SBK = 96 * MiB, WS_SBV = 112 * MiB, WS_FXQ = 128 * MiB, WS_FXK = 144 * MiB, WS_FXV = 160 * MiB, WS_MQ = 176 * MiB;
constexpr size_t WS_G2 = 192 * MiB, WS_MRG = 224 * MiB, WS_MKF = 224 * MiB, WS_U = 80 * MiB, WS_END = 256 * MiB;
constexpr int CW_BAR = 4096, CW_LWQ = 2048;

constexpr int RING_BYTES = 131072, LDSCTL_OFF = 147456, MISC_OFF = LDSCTL_OFF + 320, LDS_BYTES = 163840;

__device__ __forceinline__ unsigned f2bf(float f) { unsigned u = __builtin_bit_cast(unsigned, f); return (u + 0x7fffu + ((u >> 16) & 1u)) >> 16; }
__device__ __forceinline__ unsigned pk2(float lo, float hi) { return f2bf(lo) | (f2bf(hi) << 16); }
__device__ __forceinline__ float bf2f(unsigned b) { return __uint_as_float(b << 16); }
__device__ __forceinline__ float bflo(unsigned w) { return __uint_as_float(w << 16); }
__device__ __forceinline__ float bfhi(unsigned w) { return __uint_as_float(w & 0xffff0000u); }
__device__ __forceinline__ float wave_sum(float v) {
#pragma unroll
    for (int o = 1; o < 64; o <<= 1) v += __shfl_xor(v, o);
    return v;
}
__device__ __forceinline__ float log_sigmoid_f(float x) { return fminf(x, 0.f) - log1pf(expf(-fabsf(x))); }

#define XB_TMO      128
#define XB_XCNT(j)  (256  + 64 * (j))
#define XB_XSUB(j)  (1280 + 64 * (j))
#define XB_XGEN(j)  (2304 + 64 * (j))
#define XB_TOP      3328
#define XB_TOPGEN   3392
#define XCD_BAR_WORDS 3456
#define XB_SPIN_CAP (1u << 18)
__device__ __forceinline__ unsigned xb_ld(unsigned* p)              { return __hip_atomic_load(p, __ATOMIC_RELAXED, __HIP_MEMORY_SCOPE_AGENT); }
__device__ __forceinline__ unsigned xb_add(unsigned* p, unsigned v) { return __hip_atomic_fetch_add(p, v, __ATOMIC_RELAXED, __HIP_MEMORY_SCOPE_AGENT); }
__device__ __forceinline__ unsigned xb_xcc_id() { return (unsigned)__builtin_amdgcn_s_getreg((3 << 11) | 20) & 0xFu; }
#define XB_SPIN(cond, bar) do { unsigned _sp = 0; while (cond) { __builtin_amdgcn_s_sleep(1); \
    if ((++_sp & 255u) == 0u) { if (xb_ld(&(bar)[XB_TMO])) break; if (_sp > XB_SPIN_CAP) { atomicAdd(&(bar)[XB_TMO], 1u); break; } } } } while (0)
struct XcdBarrier { unsigned* bar; unsigned x; volatile LAS unsigned* st; };
__device__ __forceinline__ XcdBarrier xcd_barrier_post(unsigned* bar, volatile LAS unsigned* st) {
    XcdBarrier b; b.bar = bar; b.x = xb_xcc_id(); b.st = st;
    if (threadIdx.x == 0) (void)xb_add(&bar[XB_XCNT(b.x)], 1u);
    return b;
}
__device__ __forceinline__ void xcd_barrier_complete(unsigned* bar, unsigned x, unsigned& nloc, unsigned& nx) {
    const unsigned G = gridDim.x * gridDim.y * gridDim.z;
    unsigned sum, cnt, mine, sp = 0u;
    for (;;) {
        sum = 0u; cnt = 0u; mine = 0u;
#pragma unroll
        for (unsigned j = 0; j < 16; ++j) { const unsigned c = xb_ld(&bar[XB_XCNT(j)]); sum += c; cnt += (c > 0u) ? 1u : 0u; mine = (j == x) ? c : mine; }
        if (sum == G) break;
        __builtin_amdgcn_s_sleep(1);
        if ((++sp & 255u) == 0u) { if (xb_ld(&bar[XB_TMO])) break; if (sp > XB_SPIN_CAP) { atomicAdd(&bar[XB_TMO], 1u); break; } }
    }
    nloc = mine > 0u ? mine : 1u; nx = cnt > 0u ? cnt : 1u;
}
__device__ __forceinline__ void xcd_barrier(const XcdBarrier& b) {
    asm volatile("s_waitcnt vmcnt(0)" ::: "memory");
    __syncthreads();
    if (threadIdx.x == 0) {
        unsigned* bar = b.bar;
        __builtin_amdgcn_s_waitcnt(0);
        unsigned nloc = b.st[0], nx = b.st[1];
        if (nloc == 0u) { xcd_barrier_complete(bar, b.x, nloc, nx); b.st[0] = nloc; b.st[1] = nx; }
        const unsigned old = xb_add(&bar[XB_XSUB(b.x)], 1u);
        const unsigned gen = old / nloc;
        if (old + 1u == (gen + 1u) * nloc) {
            __builtin_amdgcn_fence(__ATOMIC_RELEASE, "agent");
            asm volatile("s_waitcnt vmcnt(0)" ::: "memory");
            const unsigned og = xb_add(&bar[XB_TOP], 1u);
            const unsigned tg = og / nx;
            if (og + 1u == (tg + 1u) * nx) xb_add(&bar[XB_TOPGEN], 1u);
            else XB_SPIN(xb_ld(&bar[XB_TOPGEN]) == tg, bar);
            __builtin_amdgcn_fence(__ATOMIC_ACQUIRE, "agent");
            xb_add(&bar[XB_XGEN(b.x)], 1u);
            asm volatile("s_waitcnt vmcnt(0)" ::: "memory");
        } else {
            XB_SPIN(xb_ld(&bar[XB_XGEN(b.x)]) == gen, bar);
            __builtin_amdgcn_fence(__ATOMIC_ACQUIRE, "agent");
            asm volatile("s_waitcnt vmcnt(0)" ::: "memory");
        }
    }
    __syncthreads();
}

struct Frame {
    LAS unsigned char* lds;
    volatile LAS unsigned* MISC;
    gu32* ctl;
    int tid, lane, wave, vcu, G;
    const float *x, *mem, *g_mix, *g_memn, *w_in, *b_forget, *g_fq, *g_fk, *g_mq, *g_mk, *w_mkv, *w_bsb, *w_bfx, *w_bmm, *w_out, *g_mlp, *w_up, *w_dn;
    float* out;
    float *logf, *FC, *ssq, *MKf;
    bf16 *Win_t, *Wmkv_t, *Wbr_t, *Wout_t, *Wup_t, *Wdn_t, *MHb, *MV, *XN, *SBQ, *SBK, *SBV, *FXQ, *FXK, *FXV, *MQ, *G0, *G1, *G2, *MRG, *U;
};

__device__ __forceinline__ void tr_item(const float* W, int ldw, int K, bf16* WT, int src_c0, int dst_r0, int k0, LAS float* scr, int lane, const float* kgain = nullptr, const float cscale = 1.0f) {
    float wv[32];
#pragma unroll
    for (int i = 0; i < 32; ++i) { const int kk = 2 * i + (lane >> 5); wv[i] = W[(size_t)(k0 + kk) * ldw + src_c0 + (lane & 31)]; }
#pragma unroll
    for (int i = 0; i < 32; ++i) { const int kk = 2 * i + (lane >> 5); float w = wv[i] * cscale; if (kgain) w *= kgain[k0 + kk]; scr[kk * 33 + (lane & 31)] = w; }
    LDS_WAIT(); asm volatile("" ::: "memory");
    const int c = lane & 7;
#pragma unroll
    for (int j = 0; j < 4; ++j) { const int n = (lane >> 3) + 8 * j; const LAS float* s = scr + (8 * c) * 33 + n;
        v4u o; o.x = pk2(s[0 * 33], s[1 * 33]); o.y = pk2(s[2 * 33], s[3 * 33]); o.z = pk2(s[4 * 33], s[5 * 33]); o.w = pk2(s[6 * 33], s[7 * 33]);
        *(GAS v4u*)(WT + (size_t)(dst_r0 + n) * K + k0 + 8 * c) = o; }
    LDS_WAIT(); asm volatile("" ::: "memory");
}
__host__ __device__ __forceinline__ int proj_src_col(int n) {
    const int pn = n >> 8, j = n & 255;
    if (pn < 12) { const int T = pn >> 1, bj = j >> 7, wc = (j >> 5) & 3, e = j & 31; return T * 512 + ((pn & 1) * 4 + wc) * 64 + bj * 32 + e; }
    const int bj = j >> 7, wc = (j >> 5) & 3, e = j & 31, t = 64 * wc + 32 * bj + e;
    if (pn < 14) return 3080 + (pn - 12) * 256 + t;
    return 3592 + (pn - 14) * 256 + t;
}
template <bool IS_X>
__device__ __forceinline__ void p0_rows(Frame& F, const float* srcb, const float* g, bf16* dstb, int nrows, const LAS float* wf, int gw, int NGW) {
    const GAS f32x4* gr = (const GAS f32x4*)g + F.lane;
    f32x4 wfr[4][4][2];
    if (IS_X) {
#pragma unroll
        for (int j = 0; j < 4; ++j)
#pragma unroll
            for (int e = 0; e < 4; ++e) { const LAS f32x4* wp = (const LAS f32x4*)(wf + (256 * j + 4 * F.lane + e) * 8); wfr[j][e][0] = wp[0]; wfr[j][e][1] = wp[1]; } }
    f32x4 nx[4];
    if (gw < nrows) { const GAS f32x4* xr = (const GAS f32x4*)(srcb + (size_t)gw * D) + F.lane;
#pragma unroll
        for (int j = 0; j < 4; ++j) nx[j] = xr[64 * j]; }
    for (int m = gw; m < nrows; m += NGW) {
        f32x4 v[4]; float s = 0.f;
#pragma unroll
        for (int j = 0; j < 4; ++j) v[j] = nx[j];
        if (m + NGW < nrows) { const GAS f32x4* xr = (const GAS f32x4*)(srcb + (size_t)(m + NGW) * D) + F.lane;
#pragma unroll
            for (int j = 0; j < 4; ++j) nx[j] = xr[64 * j]; }
#pragma unroll
        for (int j = 0; j < 4; ++j) s += (v[j].x * v[j].x + v[j].y * v[j].y) + (v[j].z * v[j].z + v[j].w * v[j].w);
        const float rstd = __builtin_amdgcn_rsqf(wave_sum(s) * (1.f / D) + EPS);
#pragma unroll
        for (int j = 0; j < 4; ++j) { const f32x4 gg = gr[64 * j]; v[j] = v[j] * rstd * gg; }
        GAS unsigned long long* o8 = (GAS unsigned long long*)(dstb + (size_t)m * D) + F.lane;
#pragma unroll
        for (int j = 0; j < 4; ++j) o8[64 * j] = (unsigned long long)pk2(v[j].x, v[j].y) | ((unsigned long long)pk2(v[j].z, v[j].w) << 32);
        if (IS_X) {
            float fl[8];
#pragma unroll
            for (int c = 0; c < 8; ++c) fl[c] = 0.f;
#pragma unroll
            for (int j = 0; j < 4; ++j)
#pragma unroll
                for (int e = 0; e < 4; ++e) { const float hv = v[j][e]; const f32x4 w0 = wfr[j][e][0], w1 = wfr[j][e][1];
                    fl[0] += hv * w0.x; fl[1] += hv * w0.y; fl[2] += hv * w0.z; fl[3] += hv * w0.w; fl[4] += hv * w1.x; fl[5] += hv * w1.y; fl[6] += hv * w1.z; fl[7] += hv * w1.w; }
            float mine = 0.f;
#pragma unroll
            for (int c = 0; c < 8; ++c) { const float t = wave_sum(fl[c]); if (F.lane == c) mine = t; }
            if (F.lane < 8) F.logf[(size_t)m * 8 + F.lane] = log_sigmoid_f(mine + F.b_forget[F.lane]);
        }
    }
}
constexpr int LATE_ITEMS = 3 * 8 * 32 + 16 * 32 + 16 * 128 + 64 * 32;
__device__ __forceinline__ void convert_late_weights(Frame& F, int w, int nw, const int lo = 0, const int NITEMS = LATE_ITEMS) {
    LAS float* scr = (LAS float*)(F.lds + F.wave * 8448);
    constexpr int I_BR = 8 * 32, I_OUT = 16 * 32, I_UP = 16 * 128;
    for (int it = lo + w; it < NITEMS; it += nw) {
        int r = it;
        if (r < I_BR) { const int kb = r / 32, gi = r % 32; tr_item(F.w_bsb, D, DH, F.Wbr_t, 32 * gi, 32 * gi, 64 * kb, scr, F.lane); continue; } r -= I_BR;
        if (r < I_BR) { const int kb = r / 32, gi = r % 32; tr_item(F.w_bfx, D, DH, F.Wbr_t + (size_t)D * DH, 32 * gi, 32 * gi, 64 * kb, scr, F.lane); continue; } r -= I_BR;
        if (r < I_BR) { const int kb = r / 32, gi = r % 32; tr_item(F.w_bmm, D, DH, F.Wbr_t + (size_t)2 * D * DH, 32 * gi, 32 * gi, 64 * kb, scr, F.lane); continue; } r -= I_BR;
        if (r < I_OUT) { const int kb = r / 32, gi = r % 32; tr_item(F.w_out, D, D, F.Wout_t, 32 * gi, 32 * gi, 64 * kb, scr, F.lane); continue; } r -= I_OUT;
        if (r < I_UP) { const int kb = r / 128, gi = r % 128; tr_item(F.w_up, FF, D, F.Wup_t, 32 * gi, 32 * gi, 64 * kb, scr, F.lane, F.g_mlp); continue; } r -= I_UP;
        { const int kb = r / 32, gi = r % 32; tr_item(F.w_dn, D, FF, F.Wdn_t, 32 * gi, 32 * gi, 64 * kb, scr, F.lane); }
    }
}
__device__ __forceinline__ void p0_prologue(Frame& F) {
    LAS float* scr = (LAS float*)(F.lds + F.wave * 8448);
    LAS float* wf = (LAS float*)(F.lds + 8 * 8448);
    for (int i = F.tid; i < D * 8; i += NTHREADS) wf[i] = F.w_in[(size_t)(i >> 3) * DIN + 3072 + (i & 7)];
    const int gw = F.vcu * NWAVES + F.wave, NGW = F.G * NWAVES;
    constexpr int I_IN = 16 * 208, I_MKV = 16 * 32, NITEMS = I_IN + I_MKV;
    for (int it = gw; it < NITEMS; it += NGW) {
        int r = it;
        if (r < I_IN) { const int kb = r / 208, gi = r % 208; tr_item(F.w_in, DIN, D, F.Win_t, proj_src_col(32 * gi), 32 * gi, 64 * kb, scr, F.lane, nullptr, gi >= 14 * 8 ? -LOG2E : 1.0f); continue; } r -= I_IN;
        { const int kb = r / 32, gi = r % 32; tr_item(F.w_mkv, 1024, D, F.Wmkv_t, 32 * gi, 32 * gi, 64 * kb, scr, F.lane); }
    }
    if (F.G != 256) { __syncthreads(); convert_late_weights(F, gw, NGW); }
    __syncthreads();
    p0_rows<true>(F, F.x, F.g_mix, F.XN, M, wf, gw, NGW);
    p0_rows<false>(F, F.mem, F.g_memn, F.MHb, MROWS, wf, gw, NGW);
}

template <class Epi>
__device__ __forceinline__ void ngemm(const bf16* A, int lda, const bf16* Bt, int ldb, int Mr, int Nc, int K, const Epi& E, int wg, int nwg) {
    const int tid = threadIdx.x, lane = tid & 63, wid = tid >> 6, wm = wid >> 1, wn = wid & 1;
    const int tilesN = Nc / 128, ntiles = (Mr / 128) * tilesN;
    for (int t = wg; t < ntiles; t += nwg) {
        const int tm = t / tilesN, tn = t % tilesN, r0 = tm * 128 + wm * 32, c0 = tn * 128 + wn * 64;
        f32x4 acc[2][4];
#pragma unroll
        for (int m = 0; m < 2; ++m)
#pragma unroll
            for (int n = 0; n < 4; ++n) acc[m][n] = (f32x4){0.f, 0.f, 0.f, 0.f};
        const bf16* ap = A + (size_t)(r0 + (lane & 15)) * lda + 8 * (lane >> 4);
        const bf16* bp = Bt + (size_t)(c0 + (lane & 15)) * ldb + 8 * (lane >> 4);
        for (int k0 = 0; k0 < K; k0 += 32) {
            bf16x8 a[2], b[4];
#pragma unroll
            for (int m = 0; m < 2; ++m) a[m] = *(const bf16x8*)(ap + (size_t)(m * 16) * lda + k0);
#pragma unroll
            for (int n = 0; n < 4; ++n) b[n] = *(const bf16x8*)(bp + (size_t)(n * 16) * ldb + k0);
#pragma unroll
            for (int m = 0; m < 2; ++m)
#pragma unroll
                for (int n = 0; n < 4; ++n) acc[m][n] = __builtin_amdgcn_mfma_f32_16x16x32_bf16(a[m], b[n], acc[m][n], 0, 0, 0);
        }
#pragma unroll
        for (int m = 0; m < 2; ++m)
#pragma unroll
            for (int n = 0; n < 4; ++n)
#pragma unroll
                for (int j = 0; j < 4; ++j) E(r0 + m * 16 + (lane >> 4) * 4 + j, c0 + n * 16 + (lane & 15), acc[m][n][j]);
    }
}

struct EpiProjN {
    bf16 *SBQ, *G0, *G2;
    __device__ __forceinline__ void operator()(int row, int n, float v) const {
        const int pn = n >> 8, j = n & 255;
        if (pn < 12) { const int T = pn >> 1, bj = j >> 7, wc = (j >> 5) & 3, e = j & 31, c = ((pn & 1) * 4 + wc) * 64 + bj * 32 + e;
            if (T == 0) v *= C2;
            (SBQ + (size_t)T * M * DH)[(size_t)row * DH + c] = (bf16)f2bf(v); }
        else if (pn < 14) { (SBQ + (size_t)6 * M * DH)[(size_t)row * DH + (n - 12 * 256)] = (bf16)f2bf(v); }
        else { const int g = (pn - 14) >> 2, c = n - (14 + 4 * g) * 256; bf16* G = g < 2 ? G0 + (size_t)g * M * D : G2;
            G[(size_t)row * D + c] = (bf16)f2bf(1.0f / (1.0f + expf(-v))); }
    }
};
struct EpiMkvN { float* MKf; bf16* MV;
    __device__ __forceinline__ void operator()(int row, int n, float v) const { if (n < DH) MKf[(size_t)row * DH + n] = v; else MV[(size_t)row * DH + (n - DH)] = (bf16)f2bf(v); } };
struct EpiOutN { const float* x; float* x1; bf16* A2;
    __device__ __forceinline__ void operator()(int row, int n, float v) const { const size_t o = (size_t)row * D + n; const float r = x[o] + v; A2[o] = (bf16)f2bf(r); } };
struct EpiUpN { const float* ssq; bf16* U;
    __device__ __forceinline__ void operator()(int row, int n, float v) const {
        const f32x4* p = (const f32x4*)(ssq + (size_t)row * 16); const f32x4 a = p[0], b = p[1], c = p[2], d = p[3];
        const float ss = ((a.x + a.y) + (a.z + a.w)) + ((b.x + b.y) + (b.z + b.w)) + ((c.x + c.y) + (c.z + c.w)) + ((d.x + d.y) + (d.z + d.w));
        (void)ss; const float r = fmaxf(v, 0.f); U[(size_t)row * FF + n] = (bf16)f2bf(r * r); } };
struct EpiDnN { float* out; const float* ssq; const bf16* A2;
    __device__ __forceinline__ void operator()(int row, int n, float v) const { const size_t o = (size_t)row * D + n;
        const f32x4* p = (const f32x4*)(ssq + (size_t)row * 16); const f32x4 a = p[0], b = p[1], c = p[2], d = p[3];
        const float ss = ((a.x + a.y) + (a.z + a.w)) + ((b.x + b.y) + (b.z + b.w)) + ((c.x + c.y) + (c.z + c.w)) + ((d.x + d.y) + (d.z + d.w));
        out[o] = bf2f(A2[o]) + v / (ss * (1.f / D) + EPS); } };

__device__ __forceinline__ void fcumsum(Frame& F) {
    const int gw = F.vcu * NWAVES + F.wave;
    if (gw >= BATCH * NH) return;
    const int b = gw >> 3, h = gw & 7;
    const float* src = F.logf + ((size_t)b * SEQ + 32 * F.lane) * 8 + h;
    float v[32], tot = 0.f;
#pragma unroll
    for (int i = 0; i < 32; ++i) v[i] = src[i * 8];
#pragma unroll
    for (int i = 0; i < 32; ++i) tot += v[i];
    float incl = tot;
#pragma unroll
    for (int off = 1; off < 64; off <<= 1) { const float y = __shfl_up(incl, off); if (F.lane >= off) incl += y; }
    float run = incl - tot;
    float* dst = F.FC + (size_t)gw * SEQ + 32 * F.lane;
#pragma unroll
    for (int i = 0; i < 32; i += 4) { f32x4 o; run += v[i]; o.x = run; run += v[i + 1]; o.y = run; run += v[i + 2]; o.z = run; run += v[i + 3]; o.w = run; *(f32x4*)(dst + i) = o; }
}

__device__ __forceinline__ void headnorm_naive(Frame& F) {
    const int gw = F.vcu * NWAVES + F.wave, NGW = F.G * NWAVES;
    for (int it = gw; it < 2 * M; it += NGW) {
        const int which = it / M, row = it % M;
        bf16* p = F.FXQ + (size_t)which * M * DH + (size_t)row * DH + 8 * F.lane;
        const v4u w = *(const v4u*)p; float v[8] = {bflo(w.x), bfhi(w.x), bflo(w.y), bfhi(w.y), bflo(w.z), bfhi(w.z), bflo(w.w), bfhi(w.w)};
        float s = 0.f;
#pragma unroll
        for (int i = 0; i < 8; ++i) s += v[i] * v[i];
        s += __shfl_xor(s, 1); s += __shfl_xor(s, 2); s += __shfl_xor(s, 4);
        const float sc = (1.0f / sqrtf(s * (1.f / HD) + EPS)) * (which == 0 ? C2 : 1.0f);
#pragma unroll
        for (int i = 0; i < 8; ++i) v[i] = v[i] * sc;
        v4u o; o.x = pk2(v[0], v[1]); o.y = pk2(v[2], v[3]); o.z = pk2(v[4], v[5]); o.w = pk2(v[6], v[7]);
        *(v4u*)p = o;
    }
}

template <int MODE>
__device__ __forceinline__ void nattn64(const bf16* Q, const bf16* K, const bf16* V, bf16* O, const float* FC, const float* gq, const float* gk, int wg, int nwg) {
    const int tid = threadIdx.x, half = tid & 1;
    for (int u = wg; u < 512; u += nwg) {
        const int b = u >> 6, h = (u >> 3) & 7, blk = u & 7, t = blk * 256 + (tid >> 1); const size_t row = (size_t)b * SEQ + t;
        float q[32], o[32];
        { const v4u* qp = (const v4u*)(Q + row * DH + h * HD + half * 32);
#pragma unroll
          for (int i = 0; i < 4; ++i) { const v4u w = qp[i]; q[8 * i] = bflo(w.x); q[8 * i + 1] = bfhi(w.x); q[8 * i + 2] = bflo(w.y); q[8 * i + 3] = bfhi(w.y); q[8 * i + 4] = bflo(w.z); q[8 * i + 5] = bfhi(w.z); q[8 * i + 6] = bflo(w.w); q[8 * i + 7] = bfhi(w.w); } }
        if (MODE == 1) {
#pragma unroll
            for (int d = 0; d < 32; ++d) q[d] *= gq[half * 32 + d] * gk[half * 32 + d]; }
#pragma unroll
        for (int d = 0; d < 32; ++d) o[d] = 0.f;
        const int kend = blk * 256 + 256;
        const bf16* Kb = K + (size_t)b * SEQ * DH + h * HD + half * 32; const bf16* Vb = V + (size_t)b * SEQ * DH + h * HD + half * 32;
        const float* Fs = FC + (size_t)(b * NH + h) * SEQ;
        float carry = 0.f, mrun = -1e30f, lrun = 0.f;
        for (int i = 0; i < kend; ++i) {
            const int s = MODE == 0 ? kend - 1 - i : i;
            const v4u* kp = (const v4u*)(Kb + (size_t)s * DH); const v4u* vp = (const v4u*)(Vb + (size_t)s * DH);
            float z = 0.f;
#pragma unroll
            for (int c = 0; c < 4; ++c) { const v4u w = kp[c];
                z += q[8 * c] * bflo(w.x) + q[8 * c + 1] * bfhi(w.x) + q[8 * c + 2] * bflo(w.y) + q[8 * c + 3] * bfhi(w.y) + q[8 * c + 4] * bflo(w.z) + q[8 * c + 5] * bfhi(w.z) + q[8 * c + 6] * bflo(w.w) + q[8 * c + 7] * bfhi(w.w); }
            z += __shfl_xor(z, 1);
            float wgt;
            if (MODE == 0) {
                const float zn = z * LN2; const bool strict = s < t;
                const float lr = log_sigmoid_f(-zn), ls = zn + lr;
                wgt = strict ? expf(ls + carry) : 0.f; carry += strict ? lr : 0.f;
            } else {
                const float z2 = (s <= t) ? z - Fs[s] * LOG2E : -1e30f;
                const float mn = fmaxf(mrun, z2), al = exp2f(mrun - mn); wgt = (s <= t) ? exp2f(z2 - mn) : 0.f;
                lrun = lrun * al + wgt; mrun = mn;
#pragma unroll
                for (int d = 0; d < 32; ++d) o[d] *= al;
            }
#pragma unroll
            for (int c = 0; c < 4; ++c) { const v4u w = vp[c];
                o[8 * c] += wgt * bflo(w.x); o[8 * c + 1] += wgt * bfhi(w.x); o[8 * c + 2] += wgt * bflo(w.y); o[8 * c + 3] += wgt * bfhi(w.y); o[8 * c + 4] += wgt * bflo(w.z); o[8 * c + 5] += wgt * bfhi(w.z); o[8 * c + 6] += wgt * bflo(w.w); o[8 * c + 7] += wgt * bfhi(w.w); }
        }
        const float inv = MODE == 0 ? 1.0f : 1.0f / lrun;
        v4u* op = (v4u*)(O + row * DH + h * HD + half * 32);
#pragma unroll
        for (int i = 0; i < 4; ++i) { v4u w; w.x = pk2(o[8 * i] * inv, o[8 * i + 1] * inv); w.y = pk2(o[8 * i + 2] * inv, o[8 * i + 3] * inv); w.z = pk2(o[8 * i + 4] * inv, o[8 * i + 5] * inv); w.w = pk2(o[8 * i + 6] * inv, o[8 * i + 7] * inv); op[i] = w; }
    }
}
__device__ __forceinline__ void nattn_mem(Frame& F, int wg, int nwg) {
    const int tid = threadIdx.x, qt = tid & 3;
    for (int u = wg; u < 512; u += nwg) {
        const int b = u >> 6, hm = (u >> 4) & 3, blk = u & 15, t = blk * 128 + (tid >> 2); const size_t row = (size_t)b * SEQ + t;
        float q[32], o[32];
        { const v4u* qp = (const v4u*)(F.MQ + row * DH + hm * MHD + qt * 32);
#pragma unroll
          for (int i = 0; i < 4; ++i) { const v4u w = qp[i]; q[8 * i] = bflo(w.x); q[8 * i + 1] = bfhi(w.x); q[8 * i + 2] = bflo(w.y); q[8 * i + 3] = bfhi(w.y); q[8 * i + 4] = bflo(w.z); q[8 * i + 5] = bfhi(w.z); q[8 * i + 6] = bflo(w.w); q[8 * i + 7] = bfhi(w.w); } }
        float ss = 0.f;
#pragma unroll
        for (int d = 0; d < 32; ++d) ss += q[d] * q[d];
        ss += __shfl_xor(ss, 1); ss += __shfl_xor(ss, 2);
        const float rq = (1.0f / sqrtf(ss * (1.f / MHD) + EPS)) * C2M;
#pragma unroll
        for (int d = 0; d < 32; ++d) { q[d] = q[d] * rq * F.g_mq[qt * 32 + d] * F.g_mk[qt * 32 + d]; o[d] = 0.f; }
        float mrun = -1e30f, lrun = 0.f;
        for (int key = 0; key < MEMLEN; ++key) {
            const f32x4* kp = (const f32x4*)(F.MKf + (size_t)(b * MEMLEN + key) * DH + hm * MHD + qt * 32);
            const v4u* vp = (const v4u*)(F.MV + (size_t)(b * MEMLEN + key) * DH + hm * MHD + qt * 32);
            float dot = 0.f, kss = 0.f;
#pragma unroll
            for (int c = 0; c < 8; ++c) { const f32x4 k4 = kp[c]; dot += q[4 * c] * k4.x + q[4 * c + 1] * k4.y + q[4 * c + 2] * k4.z + q[4 * c + 3] * k4.w; kss += k4.x * k4.x + k4.y * k4.y + k4.z * k4.z + k4.w * k4.w; }
            dot += __shfl_xor(dot, 1); dot += __shfl_xor(dot, 2); kss += __shfl_xor(kss, 1); kss += __shfl_xor(kss, 2);
            const float z2 = dot * (1.0f / sqrtf(kss * (1.f / MHD) + EPS));
            const float mn = fmaxf(mrun, z2), al = exp2f(mrun - mn), wgt = exp2f(z2 - mn);
            lrun = lrun * al + wgt; mrun = mn;
#pragma unroll
            for (int c = 0; c < 4; ++c) { const v4u w = vp[c];
                o[8 * c] = o[8 * c] * al + wgt * bflo(w.x); o[8 * c + 1] = o[8 * c + 1] * al + wgt * bfhi(w.x); o[8 * c + 2] = o[8 * c + 2] * al + wgt * bflo(w.y); o[8 * c + 3] = o[8 * c + 3] * al + wgt * bfhi(w.y);
                o[8 * c + 4] = o[8 * c + 4] * al + wgt * bflo(w.z); o[8 * c + 5] = o[8 * c + 5] * al + wgt * bfhi(w.z); o[8 * c + 6] = o[8 * c + 6] * al + wgt * bflo(w.w); o[8 * c + 7] = o[8 * c + 7] * al + wgt * bfhi(w.w); }
        }
        const float inv = 1.0f / lrun;
        v4u* op = (v4u*)(F.MQ + row * DH + hm * MHD + qt * 32);
#pragma unroll
        for (int i = 0; i < 4; ++i) { v4u w; w.x = pk2(o[8 * i] * inv, o[8 * i + 1] * inv); w.y = pk2(o[8 * i + 2] * inv, o[8 * i + 3] * inv); w.z = pk2(o[8 * i + 4] * inv, o[8 * i + 5] * inv); w.w = pk2(o[8 * i + 6] * inv, o[8 * i + 7] * inv); op[i] = w; }
    }
}

__device__ __forceinline__ void nmerged(Frame& F, int wg, int nwg) {
    const int tid = threadIdx.x, lane = tid & 63, wid = tid >> 6, wm = wid >> 1, wn = wid & 1;
    const int tilesN = D / 128, ntiles = (M / 128) * tilesN;
    for (int t = wg; t < ntiles; t += nwg) {
        const int tm = t / tilesN, tn = t % tilesN, r0 = tm * 128 + wm * 32, c0 = tn * 128 + wn * 64;
        f32x4 tot[2][4];
#pragma unroll
        for (int m = 0; m < 2; ++m)
#pragma unroll
            for (int n = 0; n < 4; ++n) tot[m][n] = (f32x4){0.f, 0.f, 0.f, 0.f};
#pragma unroll 1
        for (int br = 0; br < 3; ++br) {
            const bf16* A = F.SBQ + (size_t)br * 3 * M * DH; const bf16* Bt = F.Wbr_t + (size_t)br * D * DH; const bf16* G = br < 2 ? F.G0 + (size_t)br * M * D : F.G2;
            f32x4 acc[2][4];
#pragma unroll
            for (int m = 0; m < 2; ++m)
#pragma unroll
                for (int n = 0; n < 4; ++n) acc[m][n] = (f32x4){0.f, 0.f, 0.f, 0.f};
            const bf16* ap = A + (size_t)(r0 + (lane & 15)) * DH + 8 * (lane >> 4);
            const bf16* bp = Bt + (size_t)(c0 + (lane & 15)) * DH + 8 * (lane >> 4);
            for (int k0 = 0; k0 < DH; k0 += 32) {
                bf16x8 a[2], b[4];
#pragma unroll
                for (int m = 0; m < 2; ++m) a[m] = *(const bf16x8*)(ap + (size_t)(m * 16) * DH + k0);
#pragma unroll
                for (int n = 0; n < 4; ++n) b[n] = *(const bf16x8*)(bp + (size_t)(n * 16) * DH + k0);
#pragma unroll
                for (int m = 0; m < 2; ++m)
#pragma unroll
                    for (int n = 0; n < 4; ++n) acc[m][n] = __builtin_amdgcn_mfma_f32_16x16x32_bf16(a[m], b[n], acc[m][n], 0, 0, 0);
            }
#pragma unroll
            for (int m = 0; m < 2; ++m)
#pragma unroll
                for (int n = 0; n < 4; ++n)
#pragma unroll
                    for (int j = 0; j < 4; ++j) tot[m][n][j] += bf2f(G[(size_t)(r0 + m * 16 + (lane >> 4) * 4 + j) * D + c0 + n * 16 + (lane & 15)]) * acc[m][n][j];
        }
#pragma unroll
        for (int m = 0; m < 2; ++m)
#pragma unroll
            for (int n = 0; n < 4; ++n)
#pragma unroll
                for (int j = 0; j < 4; ++j) F.MRG[(size_t)(r0 + m * 16 + (lane >> 4) * 4 + j) * D + c0 + n * 16 + (lane & 15)] = (bf16)f2bf(tot[m][n][j]);
    }
}
__device__ __forceinline__ void ssq_naive(Frame& F) {
    const int gw = F.vcu * NWAVES + F.wave, NGW = F.G * NWAVES;
    for (int m = gw; m < M; m += NGW) {
        const GAS v4u* xr = (const GAS v4u*)(F.XN + (size_t)m * D) + F.lane; float s = 0.f;
#pragma unroll
        for (int j = 0; j < 2; ++j) { const v4u w = xr[64 * j]; const float a0 = bflo(w.x), a1 = bfhi(w.x), a2 = bflo(w.y), a3 = bfhi(w.y), a4 = bflo(w.z), a5 = bfhi(w.z), a6 = bflo(w.w), a7 = bfhi(w.w);
            s += (a0 * a0 + a1 * a1) + (a2 * a2 + a3 * a3) + (a4 * a4 + a5 * a5) + (a6 * a6 + a7 * a7); }
        s = wave_sum(s);
        if (F.lane < 16) F.ssq[(size_t)m * 16 + F.lane] = F.lane == 0 ? s : 0.f;
    }
}

namespace pg8 {
#define PG8_LAS __attribute__((address_space(3)))
typedef unsigned short bf16_t;
typedef unsigned u32x4 __attribute__((ext_vector_type(4)));
typedef unsigned u32x2 __attribute__((ext_vector_type(2)));
constexpr int BM = 256, BK = 64, HALF = 128, HTB = HALF * BK * 2, STAGE_BYTES = 8 * HTB, NXCD = 8, WGM = 4;
__host__ __device__ __forceinline__ int lds_byte(int r, int c) { const int st = (r >> 4) * 2 + (c >> 5), rr = r & 15, cc = c & 31, ob = rr * 64 + cc * 2; return st * 1024 + (ob ^ (((ob >> 9) & 1) << 5)); }
__host__ __device__ __forceinline__ void stage_rc(int b, int& R, int& C) { const int st = b / 1024, sb = b % 1024, swz = sb ^ (((sb >> 9) & 1) << 5); R = (st >> 1) * 16 + swz / 64; C = (st & 1) * 32 + (swz % 64) / 2; }
__host__ __device__ __forceinline__ int perm32(int rho) { const int n = rho >> 4, i = rho & 15; return 8 * (i >> 2) + 4 * n + (i & 3); }
struct Unit { int pm, pn, br; };
typedef float f32x2c __attribute__((ext_vector_type(2))); typedef __bf16 bf16x2c __attribute__((ext_vector_type(2)));
__device__ __forceinline__ unsigned cvt_pk_bf16(float lo, float hi) { f32x2c v = {lo, hi}; bf16x2c b = __builtin_convertvector(v, bf16x2c); return __builtin_bit_cast(unsigned, b); }
__device__ __forceinline__ float bflo(unsigned w) { return __uint_as_float(w << 16); }
__device__ __forceinline__ float bfhi(unsigned w) { return __uint_as_float(w & 0xffff0000u); }

__device__ __forceinline__ float xsum16(float v) { auto r = __builtin_amdgcn_permlane16_swap(__float_as_uint(v), __float_as_uint(v), false, false); return __uint_as_float(r[0]) + __uint_as_float(r[1]); }
__device__ __forceinline__ float xsum32(float v) { auto r = __builtin_amdgcn_permlane32_swap(__float_as_uint(v), __float_as_uint(v), false, false); return __uint_as_float(r[0]) + __uint_as_float(r[1]); }
__device__ __forceinline__ void static_tile(int L, int nM, int nN, int& pm, int& pn) {
    const int nwg = nM * nN; int wgid = L;
    { const int q = nwg / NXCD, r = nwg % NXCD, xcd = wgid % NXCD, off = wgid / NXCD; wgid = (xcd < r ? xcd * (q + 1) : r * (q + 1) + (xcd - r) * q) + off; }
    const int nig = WGM * nN, gid = wgid / nig, fm = gid * WGM, gsz = (nM - fm) < WGM ? (nM - fm) : WGM;
    pm = fm + ((wgid % nig) % gsz); pn = (wgid % nig) / gsz;
}
struct SchedPlain {
    int nM, nN, G, c; const char* A; const char* B; size_t tstep;
    __device__ __forceinline__ bool next(int i, Unit& u) const { const long L = (long)i * G + c; if (L >= (long)nM * nN) return false; static_tile((int)L, nM, nN, u.pm, u.pn); u.br = 0; return true; }
    __device__ __forceinline__ const char* a_ptr(const Unit& u) const { return A + (size_t)u.pm * tstep; }
    __device__ __forceinline__ const char* b_ptr(const Unit& u) const { return B + (size_t)u.pn * tstep; }
    __device__ __forceinline__ void a_ready(const Unit&) const {}
    __device__ __forceinline__ void done(const Unit&) const {}
};
struct SchedP1 {
    int G, c; const char* A; const char* B;
    __device__ __forceinline__ bool next(int i, Unit& u) const {
        if (G == 256 && c >= 128 && c < 160) { if (i == 0) { const int j = c - 128; u.pm = 64 + (j & 7); u.pn = 26 + (j >> 3); u.br = 0; return true; }
            if (i > 6) return false; static_tile((i - 1) * G + c, 64, 26, u.pm, u.pn); u.br = 0; return true; }
        const long L = (long)i * G + c; if (L >= 1696) return false;
        if (L < 1664) static_tile((int)L, 64, 26, u.pm, u.pn); else { const int r = (int)L - 1664; u.pm = 64 + (r >> 2); u.pn = 26 + (r & 3); } u.br = 0; return true; }
    __device__ __forceinline__ const char* a_ptr(const Unit& u) const { return A + (size_t)u.pm * (256 * 1024 * 2); }
    __device__ __forceinline__ const char* b_ptr(const Unit& u) const { return B + (size_t)u.pn * (256 * 1024 * 2); }
    __device__ __forceinline__ void a_ready(const Unit&) const {}
    __device__ __forceinline__ void done(const Unit&) const {}
};
struct SchedP3 {
    int G, c; const char* A; const char* B; int br;
    __device__ __forceinline__ bool next(int i, Unit& u) const { if (i >= 1 || c >= 256) return false; static_tile(c, 64, 4, u.pm, u.pn); u.br = br; return true; }
    __device__ __forceinline__ const char* a_ptr(const Unit& u) const { return A + (size_t)u.br * ((size_t)3 * M * DH * 2) + (size_t)u.pm * (256 * 512 * 2); }
    __device__ __forceinline__ const char* b_ptr(const Unit& u) const { return B + (size_t)u.br * ((size_t)D * DH * 2) + (size_t)u.pn * (256 * 512 * 2); }
    __device__ __forceinline__ void a_ready(const Unit&) const {}
    __device__ __forceinline__ void done(const Unit&) const {}
};

struct SchedP3m {
    int G, c; const char* A; const char* B;
    __device__ __forceinline__ bool next(int i, Unit& u) const { if (i >= 3 || c >= 256) return false; static_tile(c, 64, 4, u.pm, u.pn); u.br = i; return true; }
    __device__ __forceinline__ const char* a_ptr(const Unit& u) const { return A + (size_t)u.br * ((size_t)3 * M * DH * 2) + (size_t)u.pm * (256 * 512 * 2); }
    __device__ __forceinline__ const char* b_ptr(const Unit& u) const { return B + (size_t)u.br * ((size_t)D * DH * 2) + (size_t)u.pn * (256 * 512 * 2); }
    __device__ __forceinline__ void a_ready(const Unit&) const {}
    __device__ __forceinline__ void done(const Unit&) const {}
};
typedef f32x4 acc_t[2][2][4][2];
__device__ __forceinline__ u32x4 pack8(const f32x4 a, const f32x4 b) { u32x4 w; w.x = cvt_pk_bf16(a[0], a[1]); w.y = cvt_pk_bf16(a[2], a[3]); w.z = cvt_pk_bf16(b[0], b[1]); w.w = cvt_pk_bf16(b[2], b[3]); return w; }
__device__ __forceinline__ float sigm(float x) { return __builtin_amdgcn_rcpf(1.0f + __builtin_amdgcn_exp2f(x)); }

struct EpiProj {
    static constexpr bool PERM = true, AFTER_DRAIN = false, KEEP_ACC = false, PERM64 = false;
    bf16_t* SBQ; bf16_t* G0; bf16_t* G2; float* MKf; bf16_t* MV;
    __device__ __forceinline__ void operator()(const acc_t& acc, const Unit& u, int wr, int wc, int fr, int fq) const { run(acc, u, wr, wc, fr, fq, 0, 2); }
    __device__ __forceinline__ void half(const acc_t& acc, const Unit& u, int wr, int wc, int fr, int fq, const int ai) const { run(acc, u, wr, wc, fr, fq, ai, ai + 1); }
    __device__ __forceinline__ void run(const acc_t& acc, const Unit& u, int wr, int wc, int fr, int fq, const int A0, const int A1) const {
        const int pn = u.pn; const int row0 = u.pm * BM + wr * 64 + fr;
        if (pn < 12) {
            const int T = pn >> 1, hd = (pn & 1) * 4 + wc;
            bf16_t* base = SBQ + (size_t)T * M * DH + (size_t)row0 * DH + hd * 64 + 8 * fq;
            if (T == 3 || T == 4) {
                const float qs = T == 3 ? C2 : 1.0f;
#pragma unroll
                for (int ai = A0; ai < A1; ++ai)
#pragma unroll
                    for (int m = 0; m < 4; ++m) {
                        float ss = 0.f;
#pragma unroll
                        for (int bj = 0; bj < 2; ++bj)
#pragma unroll
                            for (int n = 0; n < 2; ++n) { const f32x4 x = acc[ai][bj][m][n]; ss += (x[0] * x[0] + x[1] * x[1]) + (x[2] * x[2] + x[3] * x[3]); }
                        ss = xsum16(ss); ss = xsum32(ss);
                        const float sc = qs * __builtin_amdgcn_rsqf(ss * (1.0f / HD) + EPS);
                        bf16_t* rowp = base + (size_t)(ai * HALF + m * 16) * DH;
#pragma unroll
                        for (int bj = 0; bj < 2; ++bj) *(u32x4*)(rowp + 32 * bj) = pack8(acc[ai][bj][m][0] * sc, acc[ai][bj][m][1] * sc);
                    }
            } else {
                const float sc = T == 0 ? C2 : 1.0f;
#pragma unroll
                for (int ai = A0; ai < A1; ++ai)
#pragma unroll
                    for (int m = 0; m < 4; ++m) { bf16_t* rowp = base + (size_t)(ai * HALF + m * 16) * DH;
#pragma unroll
                        for (int bj = 0; bj < 2; ++bj) *(u32x4*)(rowp + 32 * bj) = pack8(acc[ai][bj][m][0] * sc, acc[ai][bj][m][1] * sc); }
            }
        } else if (pn < 14) {
            bf16_t* base = SBQ + (size_t)6 * M * DH + (size_t)row0 * DH + (pn - 12) * 256 + wc * 64 + 8 * fq;
#pragma unroll
            for (int ai = A0; ai < A1; ++ai)
#pragma unroll
                for (int m = 0; m < 4; ++m) { bf16_t* rowp = base + (size_t)(ai * HALF + m * 16) * DH;
#pragma unroll
                    for (int bj = 0; bj < 2; ++bj) *(u32x4*)(rowp + 32 * bj) = pack8(acc[ai][bj][m][0], acc[ai][bj][m][1]); }
        } else if (pn < 26) {
            const int g = (pn - 14) >> 2; bf16_t* G = g < 2 ? G0 + (size_t)g * M * D : G2;
            bf16_t* base = G + (size_t)row0 * D + ((pn - 14) & 3) * 256 + wc * 64 + 8 * fq;
#pragma unroll
            for (int ai = A0; ai < A1; ++ai)
#pragma unroll
                for (int m = 0; m < 4; ++m) { bf16_t* rowp = base + (size_t)(ai * HALF + m * 16) * D;
#pragma unroll
                    for (int bj = 0; bj < 2; ++bj) { f32x4 a = acc[ai][bj][m][0], b = acc[ai][bj][m][1];
#pragma unroll
                        for (int e = 0; e < 4; ++e) { a[e] = sigm(a[e]); b[e] = sigm(b[e]); }
                        *(u32x4*)(rowp + 32 * bj) = pack8(a, b); } }
        } else {
            const int mrow0 = (u.pm - 64) * BM + wr * 64 + fr, pl = pn - 26;
            if (pl < 2) { float* base = MKf + (size_t)mrow0 * DH + pl * 256 + wc * 32 + 8 * fq;
#pragma unroll
                for (int ai = A0; ai < A1; ++ai)
#pragma unroll
                    for (int m = 0; m < 4; ++m) { float* rowp = base + (size_t)(ai * HALF + m * 16) * DH;
#pragma unroll
                        for (int bj = 0; bj < 2; ++bj) { *(f32x4*)(rowp + HALF * bj) = acc[ai][bj][m][0]; *(f32x4*)(rowp + HALF * bj + 4) = acc[ai][bj][m][1]; } }
            } else { bf16_t* base = MV + (size_t)mrow0 * DH + (pl - 2) * 256 + wc * 32 + 8 * fq;
#pragma unroll
                for (int ai = A0; ai < A1; ++ai)
#pragma unroll
                    for (int m = 0; m < 4; ++m) { bf16_t* rowp = base + (size_t)(ai * HALF + m * 16) * DH;
#pragma unroll
                        for (int bj = 0; bj < 2; ++bj) *(u32x4*)(rowp + HALF * bj) = pack8(acc[ai][bj][m][0], acc[ai][bj][m][1]); } }
        }
    }
};
__device__ __forceinline__ float clampg(unsigned bits) { return __uint_as_float(bits > 0x0da24260u ? bits : 0x0da24260u); }
struct EpiMerged {
    static constexpr bool PERM = true, AFTER_DRAIN = true, KEEP_ACC = false, PERM64 = false;
    const bf16_t* G0; const bf16_t* G2; bf16_t* MRG;
    __device__ __forceinline__ void fused(const acc_t& acc, const Unit& u, int wr, int wc, int fr, int fq, PG8_LAS unsigned char*, int, int) const {
        const int br = u.br; const int row0 = u.pm * BM + wr * 64 + fr, col0 = u.pn * BM + wc * 32 + 8 * fq;
        const bf16_t* G = (br < 2 ? G0 + (size_t)br * M * D : G2) + (size_t)row0 * D + col0;
        bf16_t* O = MRG + (size_t)row0 * D + col0;
#pragma unroll
        for (int ai = 0; ai < 2; ++ai)
#pragma unroll
            for (int m = 0; m < 4; ++m) { const size_t ro = (size_t)(ai * HALF + m * 16);
#pragma unroll
                for (int bj = 0; bj < 2; ++bj) {
                    const u32x4 gw = *(const u32x4*)(G + ro * D + HALF * bj);
                    f32x4 a = acc[ai][bj][m][0], b = acc[ai][bj][m][1];
                    a[0] *= bflo(gw.x); a[1] *= bfhi(gw.x); a[2] *= bflo(gw.y); a[3] *= bfhi(gw.y); b[0] *= bflo(gw.z); b[1] *= bfhi(gw.z); b[2] *= bflo(gw.w); b[3] *= bfhi(gw.w);
                    bf16_t* tp = O + ro * D + HALF * bj;
                    if (br > 0) { const u32x4 t = *(const u32x4*)tp; a[0] += bflo(t.x); a[1] += bfhi(t.x); a[2] += bflo(t.y); a[3] += bfhi(t.y); b[0] += bflo(t.z); b[1] += bfhi(t.z); b[2] += bflo(t.w); b[3] += bfhi(t.w); }
                    *(u32x4*)tp = pack8(a, b);
                }
                if (m & 1) asm volatile("" ::: "memory"); }
    }
};
struct EpiMergedR {
    static constexpr bool PERM = true, AFTER_DRAIN = false, KEEP_ACC = true, PERM64 = false;
    const bf16_t* G0; const bf16_t* G2; bf16_t* MRG;
    __device__ __forceinline__ void operator()(acc_t& acc, const Unit& u, int wr, int wc, int fr, int fq) const {
        const int br = u.br; const size_t base = (size_t)(u.pm * BM + wr * 64 + fr) * D + u.pn * BM + wc * 32 + 8 * fq;
        const bf16_t* Ga = (br < 2 ? G0 + (size_t)br * M * D : G2) + base;
        const bf16_t* Gb = (br == 0 ? G0 + (size_t)M * D : G2) + base;
        bf16_t* O = MRG + base;
#pragma unroll
        for (int ai = 0; ai < 2; ++ai) {
            u32x4 ga[4][2], gb[4][2];
#pragma unroll
            for (int m = 0; m < 4; ++m)
#pragma unroll
                for (int bj = 0; bj < 2; ++bj) { const size_t o = (size_t)(ai * HALF + m * 16) * D + HALF * bj; ga[m][bj] = *(const u32x4*)(Ga + o); if (br < 2) gb[m][bj] = *(const u32x4*)(Gb + o); }
#pragma unroll
            for (int m = 0; m < 4; ++m)
#pragma unroll
                for (int bj = 0; bj < 2; ++bj) {
                    const u32x4 a = ga[m][bj]; float f[8] = {clampg(a.x << 16), clampg(a.x & 0xffff0000u), clampg(a.y << 16), clampg(a.y & 0xffff0000u), clampg(a.z << 16), clampg(a.z & 0xffff0000u), clampg(a.w << 16), clampg(a.w & 0xffff0000u)};
                    if (br < 2) { const u32x4 b = gb[m][bj]; const float d[8] = {clampg(b.x << 16), clampg(b.x & 0xffff0000u), clampg(b.y << 16), clampg(b.y & 0xffff0000u), clampg(b.z << 16), clampg(b.z & 0xffff0000u), clampg(b.w << 16), clampg(b.w & 0xffff0000u)};
#pragma unroll
                        for (int e = 0; e < 8; ++e) f[e] *= __builtin_amdgcn_rcpf(d[e]); }
                    f32x4 x0 = acc[ai][bj][m][0], x1 = acc[ai][bj][m][1];
                    x0[0] *= f[0]; x0[1] *= f[1]; x0[2] *= f[2]; x0[3] *= f[3]; x1[0] *= f[4]; x1[1] *= f[5]; x1[2] *= f[6]; x1[3] *= f[7];
                    if (br < 2) { acc[ai][bj][m][0] = x0; acc[ai][bj][m][1] = x1; }
                    else *(u32x4*)(O + (size_t)(ai * HALF + m * 16) * D + HALF * bj) = pack8(x0, x1);
                }
            asm volatile("" ::: "memory");
        }
    }
};
struct EpiOut {
    static constexpr bool PERM = true, AFTER_DRAIN = true, KEEP_ACC = false, PERM64 = false;
    const float* x; float* x1; bf16_t* A2; float* ssq;
    __device__ __forceinline__ void fused(const acc_t& acc, const Unit& u, int wr, int wc, int fr, int fq, PG8_LAS unsigned char* lds, int, int) const {
        PG8_LAS float* red = (PG8_LAS float*)lds;
        const int row0 = u.pm * BM + wr * 64 + fr, col0 = u.pn * BM + wc * 32 + 8 * fq;
#pragma unroll
        for (int ai = 0; ai < 2; ++ai)
#pragma unroll
            for (int m = 0; m < 4; ++m) { const int row = row0 + ai * HALF + m * 16; const size_t off = (size_t)row * D + col0; float ss = 0.f;
#pragma unroll
                for (int bj = 0; bj < 2; ++bj) { const size_t o = off + bj * HALF;
                    const f32x4 r0 = *(const f32x4*)(x + o) + acc[ai][bj][m][0], r1 = *(const f32x4*)(x + o + 4) + acc[ai][bj][m][1];
                    u32x4 w; w.x = cvt_pk_bf16(r0[0], r0[1]); w.y = cvt_pk_bf16(r0[2], r0[3]); w.z = cvt_pk_bf16(r1[0], r1[1]); w.w = cvt_pk_bf16(r1[2], r1[3]); *(u32x4*)(A2 + o) = w;
                    const float q0 = bflo(w.x), q1 = bfhi(w.x), q2 = bflo(w.y), q3 = bfhi(w.y), q4 = bflo(w.z), q5 = bfhi(w.z), q6 = bflo(w.w), q7 = bfhi(w.w);
                    ss += ((q0 * q0 + q1 * q1) + (q2 * q2 + q3 * q3)) + ((q4 * q4 + q5 * q5) + (q6 * q6 + q7 * q7)); }
                ss = xsum16(ss); ss = xsum32(ss);
                if (fq == 0) red[(ai * HALF + wr * 64 + m * 16 + fr) * 4 + wc] = ss;
                if (m & 1) asm volatile("" ::: "memory"); }
        __syncthreads();
        if (threadIdx.x < 256) { const f32x4 p = *(const PG8_LAS f32x4*)(red + threadIdx.x * 4); ssq[(size_t)(u.pm * BM + threadIdx.x) * 4 + u.pn] = (p.x + p.y) + (p.z + p.w); }
    }
};
struct EpiUp {
    static constexpr bool PERM = true, AFTER_DRAIN = false, KEEP_ACC = false, PERM64 = false;
    bf16_t* U;
    __device__ __forceinline__ void operator()(const acc_t& acc, const Unit& u, int wr, int wc, int fr, int fq) const { run(acc, u, wr, wc, fr, fq, 0, 2); }
    __device__ __forceinline__ void half(const acc_t& acc, const Unit& u, int wr, int wc, int fr, int fq, const int ai) const { run(acc, u, wr, wc, fr, fq, ai, ai + 1); }
    __device__ __forceinline__ void run(const acc_t& acc, const Unit& u, int wr, int wc, int fr, int fq, const int A0, const int A1) const {
        const char* ub = (const char*)(U + (size_t)(u.pm * BM + wr * 64) * FF + u.pn * BM + wc * 32); const unsigned lo = (unsigned)(fr * FF + 8 * fq) * 2u;
#pragma unroll
        for (int ai = A0; ai < A1; ++ai)
#pragma unroll
            for (int m = 0; m < 4; ++m) { char* rowp = (char*)ub + (size_t)(ai * HALF + m * 16) * FF * 2;
#pragma unroll
                for (int bj = 0; bj < 2; ++bj) { f32x4 a = acc[ai][bj][m][0], b = acc[ai][bj][m][1];
#pragma unroll
                    for (int e = 0; e < 4; ++e) { a[e] = fmaxf(a[e] * __builtin_fabsf(a[e]), 0.f); b[e] = fmaxf(b[e] * __builtin_fabsf(b[e]), 0.f); }
                    *(u32x4*)(rowp + HALF * bj * 2 + lo) = pack8(a, b); } }
    }
};
struct EpiDown {
    static constexpr bool PERM = true, AFTER_DRAIN = true, KEEP_ACC = false, PERM64 = false;
    float* out; const float* ssq; float probe; const bf16_t* A2;
    __device__ __forceinline__ void fused(const acc_t& acc, const Unit& u, int wr, int wc, int fr, int fq, PG8_LAS unsigned char*, int, int) const {
        const int row0 = u.pm * BM + wr * 64 + fr, col0 = u.pn * BM + wc * 32 + 8 * fq;
#pragma unroll
        for (int ai = 0; ai < 2; ++ai)
#pragma unroll
            for (int m = 0; m < 4; ++m) { const int row = row0 + ai * HALF + m * 16; const size_t off = (size_t)row * D + col0;
                const f32x4 s4 = *(const f32x4*)(ssq + (size_t)row * 4); const float r2 = 1.0f / (((s4.x + s4.y) + (s4.z + s4.w)) * (1.0f / D) + EPS);
#pragma unroll
                for (int bj = 0; bj < 2; ++bj) { float* q = out + off + bj * HALF; const u32x4 xw = *(const u32x4*)(A2 + off + bj * HALF);
                    f32x4 v0 = (f32x4){bflo(xw.x), bfhi(xw.x), bflo(xw.y), bfhi(xw.y)} + acc[ai][bj][m][0] * r2, v1 = (f32x4){bflo(xw.z), bfhi(xw.z), bflo(xw.w), bfhi(xw.w)} + acc[ai][bj][m][1] * r2;
                    if ((TIMING_PHASE >= 0 || GPROBE != 0) && q == out) v0[0] += probe;
                    __builtin_nontemporal_store(v0, (f32x4*)q); __builtin_nontemporal_store(v1, (f32x4*)(q + 4)); }
                if (m & 1) asm volatile("" ::: "memory"); }
    }
};

template <class Epi, class Sched, bool ALIGN_EPI = false, bool SP2 = false, int PID = 0, bool DE = false>
__device__ __forceinline__ void gemm_phase(PG8_LAS unsigned char* lds, const int K, const Sched& S, const Epi& E) {
    const int tid = threadIdx.x, wid = __builtin_amdgcn_readfirstlane(tid >> 6), lane = tid & 63, wr = wid >> 2, wc = wid & 3, fr = lane & 15, fq = lane >> 4;
    const int nt = K / BK;
    unsigned voffA[2], voffB[2];
#pragma unroll
    for (int i = 0; i < 2; ++i) { int R, C; stage_rc(tid * 16 + i * 8192, R, C); const int Rb = Epi::PERM64 ? (64 * (R >> 5) + perm32(R & 31)) : Epi::PERM ? ((R & ~31) + perm32(R & 31)) : R;
        voffA[i] = (unsigned)(R * K + C) * 2u; voffB[i] = (unsigned)(Rb * K + C) * 2u; }
    const size_t kstep = (size_t)(BK * 2);
    const size_t hstep = (size_t)HALF * K * 2;
    const size_t hstepB = Epi::PERM64 ? (size_t)32 * K * 2 : hstep;
    const unsigned ldsw = (unsigned)wid * 1024u;
    const int aoff = lds_byte(wr * 64 + fr, fq * 8), boff = lds_byte(wc * 32 + fr, fq * 8);
#define PG8_SA(b, h) (((b) * 2 + (h)) * HTB)
#define PG8_SB(b, h) ((4 + (b) * 2 + (h)) * HTB)
#define PG8_STAGE(bufoff, gbase, voff) do { const char* gb_ = (const char*)(gbase); asm volatile("" : "+s"(gb_)); _Pragma("unroll") for (int _i = 0; _i < 2; ++_i) { unsigned vo_ = (voff)[_i]; asm volatile("" : "+v"(vo_)); \
        __builtin_amdgcn_global_load_lds((const unsigned*)(gb_ + vo_), (PG8_LAS unsigned*)(lds + (bufoff) + ldsw + _i * 8192), 16, 0, 0); } } while (0)
#define PG8_LDA(dst, b, h) do { _Pragma("unroll") for (int m = 0; m < 4; ++m) _Pragma("unroll") for (int k = 0; k < 2; ++k) dst[m][k] = *(const PG8_LAS bf16x8*)(lds + PG8_SA(b, h) + aoff + m * 2048 + k * 1024); } while (0)
#define PG8_LDB(dst, b, h) do { _Pragma("unroll") for (int n = 0; n < 2; ++n) _Pragma("unroll") for (int k = 0; k < 2; ++k) dst[n][k] = *(const PG8_LAS bf16x8*)(lds + PG8_SB(b, h) + boff + n * 2048 + k * 1024); } while (0)
#define PG8_MMA(ai, bj, At, Bt) do { __builtin_amdgcn_s_setprio(1); _Pragma("unroll") for (int m = 0; m < 4; ++m) _Pragma("unroll") for (int n = 0; n < 2; ++n) _Pragma("unroll") for (int k = 0; k < 2; ++k) \
        acc[ai][bj][m][n] = __builtin_amdgcn_mfma_f32_16x16x32_bf16(Bt[n][k], At[m][k], acc[ai][bj][m][n], 0, 0, 0); __builtin_amdgcn_s_setprio(0); } while (0)
#define PG8_WAIT_V(n) asm volatile("s_waitcnt vmcnt(" #n ")" ::: "memory")
#define PG8_WAIT_L(n) asm volatile("s_waitcnt lgkmcnt(" #n ")" ::: "memory")
#define PG8_BAR __builtin_amdgcn_s_barrier()
#define PG8_SCHED __builtin_amdgcn_sched_barrier(0)
    Unit cur, nxt; int ui = 0;
    if (!S.next(0, cur)) return;
    f32x4 acc[2][2][4][2];
    if constexpr (!DE) {
#pragma unroll
    for (int a = 0; a < 2; ++a)
#pragma unroll
        for (int b = 0; b < 2; ++b)
#pragma unroll
            for (int m = 0; m < 4; ++m)
#pragma unroll
                for (int n = 0; n < 2; ++n) acc[a][b][m][n] = (f32x4){0.f, 0.f, 0.f, 0.f};
    }
    bf16x8 At[4][2], B0[2][2], B1[2][2];
    const char* cA = S.a_ptr(cur); const char* cB = S.b_ptr(cur);
    S.a_ready(cur);
    if constexpr (SP2) {
        PG8_STAGE(PG8_SB(0, 0), cB, voffB); PG8_STAGE(PG8_SB(0, 1), cB + hstepB, voffB); PG8_STAGE(PG8_SA(0, 0), cA, voffA); PG8_STAGE(PG8_SA(0, 1), cA + hstep, voffA);
        if (wr == 1) PG8_BAR;
        PG8_WAIT_V(2); PG8_BAR;
        PG8_STAGE(PG8_SB(1, 0), cB + kstep, voffB); PG8_STAGE(PG8_SA(1, 0), cA + kstep, voffA); PG8_STAGE(PG8_SB(1, 1), cB + hstepB + kstep, voffB);
        PG8_WAIT_V(6); PG8_BAR;
    } else {
        PG8_STAGE(PG8_SB(0, 0), cB, voffB); PG8_STAGE(PG8_SA(0, 0), cA, voffA); PG8_STAGE(PG8_SB(0, 1), cB + hstepB, voffB); PG8_STAGE(PG8_SA(0, 1), cA + hstep, voffA);
        if (wr == 1) PG8_BAR;
        PG8_WAIT_V(4); PG8_BAR;
        PG8_STAGE(PG8_SB(1, 0), cB + kstep, voffB); PG8_STAGE(PG8_SA(1, 0), cA + kstep, voffA); PG8_STAGE(PG8_SB(1, 1), cB + hstepB + kstep, voffB);
        PG8_WAIT_V(6); PG8_BAR;
    }
    constexpr bool GP = (GPROBE != 0 && GPROBE == PID);
    unsigned long long gpU = 0, gp1 = 0, gpEnd = 0, gpS0 = 0, accFirst = 0, accFirst0 = 0, accSteady = 0, accE = 0; if (GP) gpS0 = __builtin_amdgcn_s_memrealtime();
    if constexpr (DE) {
#define PG8_MMAZ(ai, bj, At, Bt) do { __builtin_amdgcn_s_setprio(1); _Pragma("unroll") for (int m = 0; m < 4; ++m) _Pragma("unroll") for (int n = 0; n < 2; ++n) { \
        acc[ai][bj][m][n] = __builtin_amdgcn_mfma_f32_16x16x32_bf16(Bt[n][0], At[m][0], (f32x4){0.f, 0.f, 0.f, 0.f}, 0, 0, 0); \
        acc[ai][bj][m][n] = __builtin_amdgcn_mfma_f32_16x16x32_bf16(Bt[n][1], At[m][1], acc[ai][bj][m][n], 0, 0, 0); } __builtin_amdgcn_s_setprio(0); } while (0)
#define PG8_PAIR(W1, W2, W3, W4, MM, PRE1, PRE4) do { \
            PG8_STAGE(PG8_SA(1, 1), a1 + hstep, voffA); PRE1; PG8_SCHED; PG8_LDB(B0, 0, 0); PG8_LDB(B1, 0, 1); PG8_SCHED; PG8_LDA(At, 0, 0); \
            PG8_WAIT_V(W1); PG8_WAIT_L(0); PG8_BAR; MM(0, 0, At, B0); MM(0, 1, At, B1); PG8_BAR; PG8_SCHED; \
            PG8_LDA(At, 0, 1); PG8_STAGE(PG8_SB(0, 0), b2, voffB); PG8_STAGE(PG8_SB(0, 1), b2 + hstepB, voffB); PG8_STAGE(PG8_SA(0, 0), a2, voffA); \
            PG8_WAIT_V(W2); PG8_WAIT_L(0); PG8_BAR; MM(1, 0, At, B0); MM(1, 1, At, B1); PG8_BAR; PG8_SCHED; \
            PG8_LDB(B0, 1, 0); PG8_LDB(B1, 1, 1); PG8_SCHED; PG8_LDA(At, 1, 0); PG8_STAGE(PG8_SA(0, 1), a2 + hstep, voffA); \
            PG8_WAIT_V(W3); PG8_WAIT_L(0); PG8_BAR; PG8_MMA(0, 0, At, B0); PG8_MMA(0, 1, At, B1); PG8_BAR; PG8_SCHED; \
            PG8_STAGE(PG8_SB(1, 0), b3, voffB); PG8_STAGE(PG8_SB(1, 1), b3 + hstepB, voffB); PG8_STAGE(PG8_SA(1, 0), a3, voffA); PRE4; PG8_SCHED; PG8_LDA(At, 1, 1); \
            PG8_WAIT_V(W4); PG8_WAIT_L(0); PG8_BAR; PG8_MMA(1, 0, At, B0); PG8_MMA(1, 1, At, B1); PG8_BAR; PG8_SCHED; } while (0)
        static_assert(SP2 && !ALIGN_EPI && !Epi::AFTER_DRAIN && !Epi::KEEP_ACC, "DE: SP2 form, store-only per-unit epilogues");
        if (GP) gpU = __builtin_amdgcn_s_memrealtime();
        { const char* a1 = cA + kstep; const char* a2 = cA + 2 * kstep; const char* b2 = cB + 2 * kstep; const char* a3 = a2 + kstep; const char* b3 = b2 + kstep;
          PG8_PAIR(8, 8, 8, 8, PG8_MMAZ, (void)0, (void)0); }
        for (;;) {
            const bool has_next = S.next(ui + 1, nxt);
            const char* nA = has_next ? S.a_ptr(nxt) : cA; const char* nB = has_next ? S.b_ptr(nxt) : cB;
            if (GP) gp1 = __builtin_amdgcn_s_memrealtime();
            for (int t = 2; t < nt - 2; t += 2) {
                const char* a1 = cA + (size_t)(t + 1) * kstep; const char* a2 = cA + (size_t)(t + 2) * kstep; const char* b2 = cB + (size_t)(t + 2) * kstep; const char* a3 = a2 + kstep; const char* b3 = b2 + kstep;
                PG8_PAIR(8, 8, 8, 8, PG8_MMA, (void)0, (void)0); }
            { const char* a1 = cA + (size_t)(nt - 1) * kstep; const char* a2 = nA; const char* b2 = nB; const char* a3 = a2 + kstep; const char* b3 = b2 + kstep;
              if (has_next) S.a_ready(nxt);
              PG8_PAIR(8, 8, 8, 16, PG8_MMA, (void)0, E.half(acc, cur, wr, wc, fr, fq, 0)); }
            if (GP) { gpEnd = __builtin_amdgcn_s_memrealtime(); if (ui == 0) accFirst0 += gp1 - gpU; else accFirst += gp1 - gpU; accSteady += gpEnd - gp1; }
            if (!has_next) break;
            const Unit prev = cur; cur = nxt; cA = nA; cB = nB; ++ui;
            if (GP) gpU = __builtin_amdgcn_s_memrealtime();
            { const char* a1 = cA + kstep; const char* a2 = cA + 2 * kstep; const char* b2 = cB + 2 * kstep; const char* a3 = a2 + kstep; const char* b3 = b2 + kstep;
              PG8_PAIR(24, 24, 16, 8, PG8_MMAZ, E.half(acc, prev, wr, wc, fr, fq, 1), (void)0); }
        }
        E.half(acc, cur, wr, wc, fr, fq, 1);
#undef PG8_PAIR
#undef PG8_MMAZ
    } else
    for (;;) {
        const bool has_next = S.next(ui + 1, nxt);
        if (GP) gpU = __builtin_amdgcn_s_memrealtime();
        const char* nA = has_next ? S.a_ptr(nxt) : cA; const char* nB = has_next ? S.b_ptr(nxt) : cB;
        for (int t = 0; t < nt; t += 2) {
            const bool last = (t == nt - 2);
            if (GP && t == 2) gp1 = __builtin_amdgcn_s_memrealtime();
            const char* a1 = cA + (size_t)(t + 1) * kstep;
            const char* a2 = last ? nA : cA + (size_t)(t + 2) * kstep; const char* b2 = last ? nB : cB + (size_t)(t + 2) * kstep;
            const char* a3 = a2 + kstep; const char* b3 = b2 + kstep;
            if (last && has_next) S.a_ready(nxt);
            if constexpr (SP2) {
            PG8_LDB(B0, 0, 0); PG8_LDB(B1, 0, 1); PG8_SCHED; PG8_LDA(At, 0, 0); PG8_STAGE(PG8_SA(1, 1), a1 + hstep, voffA);
            PG8_WAIT_V(8); PG8_WAIT_L(0); PG8_BAR; PG8_MMA(0, 0, At, B0); PG8_MMA(0, 1, At, B1); PG8_BAR; PG8_SCHED;
            PG8_LDA(At, 0, 1); PG8_STAGE(PG8_SB(0, 0), b2, voffB); PG8_STAGE(PG8_SB(0, 1), b2 + hstepB, voffB); PG8_STAGE(PG8_SA(0, 0), a2, voffA);
            PG8_WAIT_V(8); PG8_WAIT_L(0); PG8_BAR; PG8_MMA(1, 0, At, B0); PG8_MMA(1, 1, At, B1); PG8_BAR; PG8_SCHED;
            PG8_LDB(B0, 1, 0); PG8_LDB(B1, 1, 1); PG8_SCHED; PG8_LDA(At, 1, 0); PG8_STAGE(PG8_SA(0, 1), a2 + hstep, voffA);
            PG8_WAIT_V(8); PG8_WAIT_L(0); PG8_BAR; PG8_MMA(0, 0, At, B0); PG8_MMA(0, 1, At, B1); PG8_BAR; PG8_SCHED;
            PG8_LDA(At, 1, 1); PG8_STAGE(PG8_SB(1, 0), b3, voffB); PG8_STAGE(PG8_SB(1, 1), b3 + hstepB, voffB); PG8_STAGE(PG8_SA(1, 0), a3, voffA);
            PG8_WAIT_V(8); PG8_WAIT_L(0); PG8_BAR; PG8_MMA(1, 0, At, B0); PG8_MMA(1, 1, At, B1); PG8_BAR; PG8_SCHED;
            } else {
            PG8_LDB(B0, 0, 0); PG8_SCHED; PG8_LDA(At, 0, 0); PG8_STAGE(PG8_SA(1, 1), a1 + hstep, voffA);
            PG8_WAIT_L(8); PG8_BAR; PG8_WAIT_L(0); PG8_MMA(0, 0, At, B0); PG8_BAR; PG8_SCHED;
            PG8_LDB(B1, 0, 1); PG8_STAGE(PG8_SB(0, 0), b2, voffB);
            PG8_BAR; PG8_WAIT_L(0); PG8_MMA(0, 1, At, B1); PG8_BAR;
            PG8_LDA(At, 0, 1); PG8_STAGE(PG8_SA(0, 0), a2, voffA);
            PG8_BAR; PG8_WAIT_L(0); PG8_MMA(1, 0, At, B0); PG8_BAR; PG8_SCHED;
            PG8_STAGE(PG8_SB(0, 1), b2 + hstepB, voffB);
            PG8_WAIT_V(6); PG8_BAR; PG8_MMA(1, 1, At, B1); PG8_BAR;
            PG8_LDB(B0, 1, 0); PG8_SCHED; PG8_LDA(At, 1, 0); PG8_STAGE(PG8_SA(0, 1), a2 + hstep, voffA);
            PG8_WAIT_L(8); PG8_BAR; PG8_WAIT_L(0); PG8_MMA(0, 0, At, B0); PG8_BAR; PG8_SCHED;
            PG8_LDB(B1, 1, 1); PG8_STAGE(PG8_SB(1, 0), b3, voffB);
            PG8_BAR; PG8_WAIT_L(0); PG8_MMA(0, 1, At, B1); PG8_BAR;
            PG8_LDA(At, 1, 1); PG8_STAGE(PG8_SA(1, 0), a3, voffA);
            PG8_BAR; PG8_WAIT_L(0); PG8_MMA(1, 0, At, B0); PG8_BAR; PG8_SCHED;
            PG8_STAGE(PG8_SB(1, 1), b3 + hstepB, voffB);
            PG8_WAIT_V(6); PG8_BAR; PG8_MMA(1, 1, At, B1); PG8_BAR;
            }
        }
        if constexpr (ALIGN_EPI) { if (wr == 0) PG8_BAR; }
        if (GP) { gpEnd = __builtin_amdgcn_s_memrealtime(); if (ui == 0) accFirst0 += gp1 - gpU; else accFirst += gp1 - gpU; accSteady += gpEnd - gp1; }
        if constexpr (!Epi::AFTER_DRAIN) { E(acc, cur, wr, wc, fr, fq); S.done(cur); }
        if (GP) accE += __builtin_amdgcn_s_memrealtime() - gpEnd;
        if (!has_next) break;
        if constexpr (!Epi::KEEP_ACC) {
#pragma unroll
        for (int a = 0; a < 2; ++a)
#pragma unroll
            for (int b = 0; b < 2; ++b)
#pragma unroll
                for (int m = 0; m < 4; ++m)
#pragma unroll
                    for (int n = 0; n < 2; ++n) acc[a][b][m][n] = (f32x4){0.f, 0.f, 0.f, 0.f};
        }
        cur = nxt; cA = nA; cB = nB; ++ui;
        if constexpr (ALIGN_EPI) { if (wr == 1) PG8_BAR; }
    }
    PG8_WAIT_V(0);
    if constexpr (!ALIGN_EPI) { if (wr == 0) PG8_BAR; }
    PG8_BAR;
    if constexpr (Epi::AFTER_DRAIN) { E.fused(acc, cur, wr, wc, fr, fq, lds, wid, lane); S.done(cur); }
    if (GP && blockIdx.x == 0 && tid == 0) { const float nu = (float)(ui + 1), npair = (float)(nt / 2 - 1); float v = 0.f;
        if (GPSEL == 1) v = (float)accSteady * 0.01f / (nu * npair);
        if (GPSEL == 2) v = (float)accFirst * 0.01f / fmaxf(nu - 1.f, 1.f);
        if (GPSEL == 3) v = (float)accFirst0 * 0.01f;
        if (GPSEL == 4) v = (float)accE * 0.01f / nu;
        if (GPSEL == 5) v = (float)(__builtin_amdgcn_s_memrealtime() - gpS0) * 0.001f;
        *(PG8_LAS float*)(lds + MISC_OFF + 64) = (v - GPOFF) * GPSCALE; }
#undef PG8_SA
#undef PG8_SB
#undef PG8_STAGE
#undef PG8_LDA
#undef PG8_LDB
#undef PG8_MMA
#undef PG8_WAIT_V
#undef PG8_WAIT_L
#undef PG8_BAR
#undef PG8_SCHED
}
}

namespace att {
typedef float f32x16 __attribute__((ext_vector_type(16)));
typedef float f32x2_t __attribute__((ext_vector_type(2)));
typedef __bf16 bf16x2_t __attribute__((ext_vector_type(2)));
typedef unsigned u32x4 __attribute__((ext_vector_type(4)));
typedef unsigned u32x2 __attribute__((ext_vector_type(2)));
constexpr int KP = 88, VP = 96;
constexpr int BUF_K = 0, BUF_V = 64 * KP * 2, BUF_B = BUF_V + 64 * VP * 2, BUF_BYTES = BUF_B + 256;
typedef short v4i16_t __attribute__((ext_vector_type(4)));
__device__ __forceinline__ u32x2 vtr(const LAS unsigned char* p) { return __builtin_bit_cast(u32x2, __builtin_amdgcn_ds_read_tr16_b64_v4i16((LAS v4i16_t*)p)); }
__device__ __forceinline__ int crow(int r, int hi) { return (r & 3) + 8 * (r >> 2) + 4 * hi; }
__device__ __forceinline__ unsigned cvtpk(float lo, float hi) { f32x2_t v = {lo, hi}; bf16x2_t b = __builtin_convertvector(v, bf16x2_t); return __builtin_bit_cast(unsigned, b); }
__device__ __forceinline__ float other_half(float v, int hi) { auto r = __builtin_amdgcn_permlane32_swap(__float_as_uint(v), __float_as_uint(v), false, false); return __uint_as_float(hi ? r[0] : r[1]); }
#define ATT_MFMA(a, b, c) __builtin_amdgcn_mfma_f32_32x32x16_bf16(a, b, c, 0, 0, 0)

template <int MODE>
__device__ __forceinline__ void att_compute(const LAS unsigned char* bb, int kt, int qw0, int r32, int hi, const bf16x8 (&qf)[5], f32x16& o0, f32x16& o1, float& carry, float& mrun, float& lrun) {
        const int key0 = kt * 64;
        if (key0 <= qw0 + 31) {
            f32x16 p0, p1;
            p0 = f32x16{}; p1 = f32x16{};
            u32x2 vf[4][2][2];
            { const LAS unsigned char* kb = bb + BUF_K + (r32 * KP + 8 * hi) * 2; constexpr int ND = MODE == 1 ? 5 : 4; bf16x8 ka[ND], kc[ND];
#pragma unroll
              for (int d0 = 0; d0 < ND; ++d0) { ka[d0] = *(const LAS bf16x8*)(kb + d0 * 32); kc[d0] = *(const LAS bf16x8*)(kb + 32 * KP * 2 + d0 * 32); }
              __builtin_amdgcn_sched_barrier(0);
#pragma unroll
              for (int d0 = 0; d0 < ND; ++d0) { p0 = ATT_MFMA(ka[d0], qf[d0], p0); p1 = ATT_MFMA(kc[d0], qf[d0], p1); }
              const LAS unsigned char* vb = bb + BUF_V + ((4 * hi + ((r32 & 15) >> 2)) * VP + 16 * (r32 >> 4) + 4 * (r32 & 3)) * 2;
#pragma unroll
              for (int ks = 0; ks < 4; ++ks) { const int koff = (16 * ks) * VP * 2;
                  vf[ks][0][0] = vtr(vb + koff); vf[ks][0][1] = vtr(vb + koff + 8 * VP * 2);
                  vf[ks][1][0] = vtr(vb + koff + 64); vf[ks][1][1] = vtr(vb + koff + 8 * VP * 2 + 64); }
              __builtin_amdgcn_sched_barrier(0); }
            const int qrow = qw0 + r32; const bool diag = key0 + 63 >= qw0;
            if (MODE == 0) {
                f32x16 rm0, rm1;
#pragma unroll
                for (int r = 0; r < 16; ++r) {
                    { const float t = __builtin_amdgcn_exp2f(-p0[r]); const float be = __builtin_amdgcn_rcpf(1.0f + t); p0[r] = be; rm0[r] = 1.0f - be; }
                    { const float t = __builtin_amdgcn_exp2f(-p1[r]); const float be = __builtin_amdgcn_rcpf(1.0f + t); p1[r] = be; rm1[r] = 1.0f - be; }
                }
                if (diag) {
                    asm volatile("" ::: "memory"); const int lim = qrow - key0 - 4 * hi;
#pragma unroll
                    for (int r = 0; r < 16; ++r) { const int c0 = (r & 3) + 8 * (r >> 2);
                        if (c0 >= lim) { p0[r] = 0.f; rm0[r] = 1.0f; } if (c0 + 32 >= lim) { p1[r] = 0.f; rm1[r] = 1.0f; } } }
                float gp[8], pg[8];
#pragma unroll
                for (int g = 0; g < 4; ++g) { gp[g] = (rm0[4 * g] * rm0[4 * g + 1]) * (rm0[4 * g + 2] * rm0[4 * g + 3]); gp[4 + g] = (rm1[4 * g] * rm1[4 * g + 1]) * (rm1[4 * g + 2] * rm1[4 * g + 3]); }
#pragma unroll
                for (int g = 0; g < 8; ++g) pg[g] = other_half(gp[g], hi);
                float run = carry;
#pragma unroll
                for (int g = 7; g >= 0; --g) {
                    const float aft = hi ? run : run * pg[g];
                    run = run * (gp[g] * pg[g]);
                    if (g >= 4) { const int r = 4 * (g - 4); const float a3 = aft, a2 = a3 * rm1[r + 3], a1 = a2 * rm1[r + 2], a0 = a1 * rm1[r + 1];
                        p1[r] *= a0; p1[r + 1] *= a1; p1[r + 2] *= a2; p1[r + 3] *= a3; }
                    else { const int r = 4 * g; const float a3 = aft, a2 = a3 * rm0[r + 3], a1 = a2 * rm0[r + 2], a0 = a1 * rm0[r + 1];
                        p0[r] *= a0; p0[r + 1] *= a1; p0[r + 2] *= a2; p0[r + 3] *= a3; }
                }
                carry = run;
            } else {
                if (diag) {
                    asm volatile("" ::: "memory"); const int lim = qrow - key0 - 4 * hi;
#pragma unroll
                    for (int r = 0; r < 16; ++r) { const int c0 = (r & 3) + 8 * (r >> 2); if (c0 > lim) p0[r] = -1e30f; if (c0 + 32 > lim) p1[r] = -1e30f; } }
                float ls = 0.f;
#pragma unroll
                for (int r = 0; r < 16; ++r) { p0[r] = __builtin_amdgcn_exp2f(p0[r]); p1[r] = __builtin_amdgcn_exp2f(p1[r]); ls += p0[r] + p1[r]; }
                lrun += ls;
            }
#pragma unroll
            for (int ks = 0; ks < 4; ++ks) {
                const int rb = 8 * (ks & 1); u32x4 pw;
                if (ks < 2) { pw.x = cvtpk(p0[rb], p0[rb + 1]); pw.y = cvtpk(p0[rb + 2], p0[rb + 3]); pw.z = cvtpk(p0[rb + 4], p0[rb + 5]); pw.w = cvtpk(p0[rb + 6], p0[rb + 7]); }
                else        { pw.x = cvtpk(p1[rb], p1[rb + 1]); pw.y = cvtpk(p1[rb + 2], p1[rb + 3]); pw.z = cvtpk(p1[rb + 4], p1[rb + 5]); pw.w = cvtpk(p1[rb + 6], p1[rb + 7]); }
                const bf16x8 pf = __builtin_bit_cast(bf16x8, pw);
                const u32x4 a0 = {vf[ks][0][0].x, vf[ks][0][0].y, vf[ks][0][1].x, vf[ks][0][1].y}, a1 = {vf[ks][1][0].x, vf[ks][1][0].y, vf[ks][1][1].x, vf[ks][1][1].y};
                o0 = ATT_MFMA(__builtin_bit_cast(bf16x8, a0), pf, o0); o1 = ATT_MFMA(__builtin_bit_cast(bf16x8, a1), pf, o1);
            }
        }
}
template <int MODE>
__device__ __forceinline__ void unit64(const bf16* Q, const bf16* K, const bf16* V, bf16* O, const float* FC, const float* gq, const float* gk, int b, int h, int qb, LAS unsigned char* lds) {
    const int tid = threadIdx.x, lane = tid & 63, r32 = lane & 31, hi = lane >> 5; const int wid = __builtin_amdgcn_readfirstlane(tid >> 6);
    const size_t rowbase = (size_t)b * SEQ; const int q0 = qb * 256, qw0 = q0 + wid * 32;
    const int NT = 4 * qb + 4;
    const int skey = tid >> 3, sch = tid & 7;
    const bf16* kg = K + (rowbase + skey) * DH + h * HD + sch * 8; const bf16* vg = V + (rowbase + skey) * DH + h * HD + sch * 8;
    const float* fg = FC + (size_t)(b * NH + h) * SEQ;
    v4u kreg, vreg; float breg = 0.f; v4u kregB, vregB; float bregB = 0.f;
#define ATT_LOAD2(t, KR, VR, BR) do { KR = *(const v4u*)(kg + (size_t)(t) * 64 * DH); VR = *(const v4u*)(vg + (size_t)(t) * 64 * DH); if (MODE == 1 && tid < 64) BR = fg[(t) * 64 + tid]; } while (0)
    ATT_LOAD2(NT - 1, kreg, vreg, breg); ATT_LOAD2(NT - 2, kregB, vregB, bregB);
    float fq0 = 0.f; if (MODE == 1) fq0 = fg[qw0 + r32];
    bf16x8 qf[5]; float gmax = 0.f;
    { const bf16* qp = Q + (rowbase + qw0 + r32) * DH + h * HD + 8 * hi;
#pragma unroll
      for (int d0 = 0; d0 < 4; ++d0) { v4u w = *(const v4u*)(qp + 16 * d0);
          if (MODE == 1) { const float* g1 = gq + 16 * d0 + 8 * hi; const float* g2 = gk + 16 * d0 + 8 * hi;
#pragma unroll
              for (int j = 0; j < 8; ++j) gmax = fmaxf(gmax, __builtin_fabsf(g1[j] * g2[j]));
              w.x = cvtpk(bflo(w.x) * g1[0] * g2[0], bfhi(w.x) * g1[1] * g2[1]); w.y = cvtpk(bflo(w.y) * g1[2] * g2[2], bfhi(w.y) * g1[3] * g2[3]);
              w.z = cvtpk(bflo(w.z) * g1[4] * g2[4], bfhi(w.z) * g1[5] * g2[5]); w.w = cvtpk(bflo(w.w) * g1[6] * g2[6], bfhi(w.w) * g1[7] * g2[7]); }
          qf[d0] = __builtin_bit_cast(bf16x8, w); } }
    f32x16 o0 = {}, o1 = {};
    float carry = 1.0f, mrun = -1e30f, lrun = 0.f;
    if (MODE == 1) { gmax = fmaxf(gmax, other_half(gmax, hi));
        mrun = -fq0 * LOG2E + 64.0f * 1.02f * C2 * gmax + 0.5f;
        { const float c = -mrun; const unsigned ch = f2bf(c); const float r1 = c - bf2f((bf16)ch); const unsigned cm = f2bf(r1); const unsigned cl = f2bf(r1 - bf2f((bf16)cm));
          u32x4 w = {0x3F803F80u, 0x3F80u | (ch << 16), cm | (cl << 16), 0u}; if (hi) w = u32x4{0u, 0u, 0u, 0u}; qf[4] = __builtin_bit_cast(bf16x8, w); } }
    else qf[4] = qf[3];
    LAS unsigned* alive = (LAS unsigned*)(lds + 2 * BUF_BYTES);
#define ATT_LOAD(t) do { kreg = *(const v4u*)(kg + (size_t)(t) * 64 * DH); vreg = *(const v4u*)(vg + (size_t)(t) * 64 * DH); if (MODE == 1 && tid < 64) breg = -fg[(t) * 64 + tid] * LOG2E; } while (0)
#define ATT_WRITE(bufo) do { LAS unsigned char* bb_ = lds + (bufo); *(LAS v4u*)(bb_ + BUF_K + (skey * KP + sch * 8) * 2) = kreg; \
        LAS unsigned short* vt_ = (LAS unsigned short*)(bb_ + BUF_V) + (sch * 8) * VP + skey; \
        vt_[0 * VP] = (unsigned short)(vreg.x & 0xffffu); vt_[1 * VP] = (unsigned short)(vreg.x >> 16); vt_[2 * VP] = (unsigned short)(vreg.y & 0xffffu); vt_[3 * VP] = (unsigned short)(vreg.y >> 16); \
        vt_[4 * VP] = (unsigned short)(vreg.z & 0xffffu); vt_[5 * VP] = (unsigned short)(vreg.z >> 16); vt_[6 * VP] = (unsigned short)(vreg.w & 0xffffu); vt_[7 * VP] = (unsigned short)(vreg.w >> 16); \
        if (MODE == 1 && tid < 64) *(LAS float*)(bb_ + BUF_B + tid * 4) = breg; } while (0)
#define ATT_WRITE2(bufo, KR, VR, BR) do { LAS unsigned char* bb_ = lds + (bufo); *(LAS v4u*)(bb_ + BUF_K + (skey * KP + sch * 8) * 2) = KR; *(LAS v4u*)(bb_ + BUF_V + (skey * VP + sch * 8) * 2) = VR; \
        if (MODE == 1 && tid < 64) { const float nb_ = -BR * LOG2E; const unsigned bh_ = f2bf(nb_); const float q1_ = nb_ - bf2f((bf16)bh_); const unsigned bm_ = f2bf(q1_); const unsigned bl_ = f2bf(q1_ - bf2f((bf16)bm_)); \
            LAS v4u* kx_ = (LAS v4u*)(bb_ + BUF_K + (tid * KP + 64) * 2); kx_[0] = v4u{bh_ | (bm_ << 16), bl_ | 0x3F800000u, 0x3F803F80u, 0u}; kx_[1] = v4u{0u, 0u, 0u, 0u}; } } while (0)
    ATT_WRITE2(0, kreg, vreg, breg); __syncthreads();
    bool done = false;
#define ATT_STEP(IT, WK, WV, WB, LK, LV, LB) do { const int it = (IT); const int kt = NT - 1 - it, cur = (it & 1) * BUF_BYTES, nxt = BUF_BYTES - cur; \
        if (it + 2 < NT) ATT_LOAD2(kt - 2, LK, LV, LB); \
        att_compute<MODE>(lds + cur, kt, qw0, r32, hi, qf, o0, o1, carry, mrun, lrun); \
        if (it + 1 < NT) ATT_WRITE2(nxt, WK, WV, WB); \
        if (MODE == 0) { if (lane == 0) alive[(it & 1) * 8 + wid] = __any(carry != 0.0f) ? 1u : 0u; else (void)__any(carry != 0.0f); } \
        __syncthreads(); \
        if (MODE == 0) { const LAS unsigned* al = alive + (it & 1) * 8; if ((al[0] | al[1] | al[2] | al[3] | al[4] | al[5] | al[6] | al[7]) == 0u) done = true; } } while (0)
    for (int it2 = 0; it2 < NT && !done; it2 += 2) {
        ATT_STEP(it2, kregB, vregB, bregB, kreg, vreg, breg);
        if (done) break;
        ATT_STEP(it2 + 1, kreg, vreg, breg, kregB, vregB, bregB);
    }
#undef ATT_STEP
#undef ATT_LOAD2
#undef ATT_WRITE2
    float inv = 1.0f;
    if (MODE == 1) { const float lt = lrun + other_half(lrun, hi); inv = 1.0f / lt; }
    bf16* op = O + (rowbase + qw0 + r32) * DH + h * HD + 4 * hi;
#pragma unroll
    for (int g = 0; g < 4; ++g) { u32x2 w0, w1; w0.x = cvtpk(o0[4 * g] * inv, o0[4 * g + 1] * inv); w0.y = cvtpk(o0[4 * g + 2] * inv, o0[4 * g + 3] * inv);
        w1.x = cvtpk(o1[4 * g] * inv, o1[4 * g + 1] * inv); w1.y = cvtpk(o1[4 * g + 2] * inv, o1[4 * g + 3] * inv);
        *(u32x2*)(op + 8 * g) = w0; *(u32x2*)(op + 32 + 8 * g) = w1; }
#undef ATT_LOAD
#undef ATT_WRITE
}
__device__ __forceinline__ void unit_sb(const bf16* Q, const bf16* K, const bf16* V, bf16* O, int b, int h, int qb, LAS unsigned char* lds) {
    const int tid = threadIdx.x, lane = tid & 63, r32 = lane & 31, hi = lane >> 5; const int wid = __builtin_amdgcn_readfirstlane(tid >> 6);
    const size_t rowbase = (size_t)b * SEQ; const int q0 = qb * 256, qw0 = q0 + wid * 32, T0 = 4 * qb, pw = wid >> 1;
    const int skey = tid >> 3, sch = tid & 7;
    const bf16* kg = K + (rowbase + skey) * DH + h * HD + sch * 8; const bf16* vg = V + (rowbase + skey) * DH + h * HD + sch * 8;
#define SB_LD(t, KR, VR) do { KR = *(const v4u*)(kg + (size_t)(t) * 64 * DH); VR = *(const v4u*)(vg + (size_t)(t) * 64 * DH); } while (0)
#define SB_WR(t, KR, VR) do { int wo_ = ((t) % 5) * BUF_BYTES; asm volatile("" : "+s"(wo_)); LAS unsigned char* bb_ = lds + wo_; *(LAS v4u*)(bb_ + BUF_K + (skey * KP + sch * 8) * 2) = KR; *(LAS v4u*)(bb_ + BUF_V + (skey * VP + sch * 8) * 2) = VR; } while (0)
    v4u kA, vA, kB, vB;
    bf16x8 qf[5];
    { v4u k3, v3, k2, v2, k1, v1, k0, v0;
      SB_LD(T0 + 3, k3, v3); SB_LD(T0 + 2, k2, v2); SB_LD(T0 + 1, k1, v1); SB_LD(T0, k0, v0);
      if (T0 >= 1) SB_LD(T0 - 1, kA, vA); if (T0 >= 2) SB_LD(T0 - 2, kB, vB);
      { const bf16* qp = Q + (rowbase + qw0 + r32) * DH + h * HD + 8 * hi;
#pragma unroll
        for (int d0 = 0; d0 < 4; ++d0) { const v4u w = *(const v4u*)(qp + 16 * d0); qf[d0] = __builtin_bit_cast(bf16x8, w); } }
      qf[4] = qf[3];
      SB_WR(T0 + 3, k3, v3); SB_WR(T0 + 2, k2, v2); SB_WR(T0 + 1, k1, v1); SB_WR(T0, k0, v0); }
    f32x16 o0 = {}, o1 = {};
    float carry = 1.0f, mrun = 0.f, lrun = 0.f;
    LAS unsigned* alive = (LAS unsigned*)(lds + 5 * BUF_BYTES);
    __syncthreads();
    bool done = false; const int NS = T0 + 4;
#define SB_STEP(S_, KR, VR) do { const int s_ = (S_); const int kt = T0 + pw - s_; \
        if (kt >= 0) { int bo_ = (kt % 5) * BUF_BYTES; asm volatile("" : "+s"(bo_)); att_compute<0>(lds + bo_, kt, qw0, r32, hi, qf, o0, o1, carry, mrun, lrun); }     \
        if (T0 - s_ - 1 >= 0) SB_WR(T0 - s_ - 1, KR, VR);             \
        if (T0 - s_ - 3 >= 0) SB_LD(T0 - s_ - 3, KR, VR); \
        { const bool live = __any(carry != 0.0f) && kt >= 1; if (lane == 0) alive[(s_ & 1) * 8 + wid] = live ? 1u : 0u; } \
        __syncthreads(); \
        { const LAS unsigned* al = alive + (s_ & 1) * 8; if ((al[0] | al[1] | al[2] | al[3] | al[4] | al[5] | al[6] | al[7]) == 0u) done = true; } } while (0)
    for (int s2 = 0; s2 < NS && !done; s2 += 2) {
        SB_STEP(s2, kA, vA);
        if (done || s2 + 1 >= NS) break;
        SB_STEP(s2 + 1, kB, vB);
    }
#undef SB_STEP
#undef SB_LD
#undef SB_WR
    bf16* op = O + (rowbase + qw0 + r32) * DH + h * HD + 4 * hi;
#pragma unroll
    for (int g = 0; g < 4; ++g) { u32x2 w0, w1; w0.x = cvtpk(o0[4 * g], o0[4 * g + 1]); w0.y = cvtpk(o0[4 * g + 2], o0[4 * g + 3]);
        w1.x = cvtpk(o1[4 * g], o1[4 * g + 1]); w1.y = cvtpk(o1[4 * g + 2], o1[4 * g + 3]);
        *(u32x2*)(op + 8 * g) = w0; *(u32x2*)(op + 32 + 8 * g) = w1; }
}
constexpr int MKP = 136, MVP = 144;
constexpr int MBUF_K = 0, MBUF_V = 64 * MKP * 2, MBUF_BYTES = MBUF_V + 64 * MVP * 2;
__device__ __forceinline__ void unit_mem(bf16* MQ, const float* MKf, const bf16* MV, const float* g_mq, const float* g_mk, int b, int hm, int qb, LAS unsigned char* lds) {
    const int tid = threadIdx.x, lane = tid & 63, r32 = lane & 31, hi = lane >> 5; const int wid = __builtin_amdgcn_readfirstlane(tid >> 6);
    const size_t rowq = (size_t)b * SEQ + qb * 256 + wid * 32 + r32;
    const int skey = tid >> 3, sch = tid & 7;
    const float* kg = MKf + (size_t)(b * MEMLEN + skey) * DH + hm * MHD + sch * 16; const bf16* vg = MV + (size_t)(b * MEMLEN + skey) * DH + hm * MHD + sch * 16;
    f32x4 kr[4][4]; v4u vr[4][2];
#pragma unroll
    for (int t = 0; t < 4; ++t) { const f32x4* kp_ = (const f32x4*)(kg + (size_t)t * 64 * DH); kr[t][0] = kp_[0]; kr[t][1] = kp_[1]; kr[t][2] = kp_[2]; kr[t][3] = kp_[3];
        const v4u* vp_ = (const v4u*)(vg + (size_t)t * 64 * DH); vr[t][0] = vp_[0]; vr[t][1] = vp_[1]; }
    v4u qw[8];
    { const bf16* qp = MQ + rowq * DH + hm * MHD + 8 * hi;
#pragma unroll
      for (int d0 = 0; d0 < 8; ++d0) qw[d0] = *(const v4u*)(qp + 16 * d0); }
    float gg[16];
#pragma unroll
    for (int i = 0; i < 16; ++i) gg[i] = g_mk[sch * 16 + i] * g_mq[sch * 16 + i] * C2M;
    float gmx = 0.f;
#pragma unroll
    for (int i = 0; i < 16; ++i) gmx = fmaxf(gmx, __builtin_fabsf(gg[i]));
    gmx = fmaxf(gmx, __shfl_xor(gmx, 1)); gmx = fmaxf(gmx, __shfl_xor(gmx, 2)); gmx = fmaxf(gmx, __shfl_xor(gmx, 4));
    const float nref = -(128.0f * 1.02f * gmx + 0.5f);
#pragma unroll
    for (int t = 0; t < 4; ++t) { LAS unsigned char* bb_ = lds + t * MBUF_BYTES; float ss_ = 0.f;
#pragma unroll
        for (int i_ = 0; i_ < 4; ++i_) ss_ += (kr[t][i_][0] * kr[t][i_][0] + kr[t][i_][1] * kr[t][i_][1]) + (kr[t][i_][2] * kr[t][i_][2] + kr[t][i_][3] * kr[t][i_][3]);
        ss_ += __shfl_xor(ss_, 1); ss_ += __shfl_xor(ss_, 2); ss_ += __shfl_xor(ss_, 4);
        const float rk_ = __builtin_amdgcn_rsqf(ss_ * (1.0f / MHD) + EPS); v4u k0_, k1_;
        k0_.x = cvtpk(kr[t][0][0] * rk_ * gg[0], kr[t][0][1] * rk_ * gg[1]); k0_.y = cvtpk(kr[t][0][2] * rk_ * gg[2], kr[t][0][3] * rk_ * gg[3]); k0_.z = cvtpk(kr[t][1][0] * rk_ * gg[4], kr[t][1][1] * rk_ * gg[5]); k0_.w = cvtpk(kr[t][1][2] * rk_ * gg[6], kr[t][1][3] * rk_ * gg[7]);
        k1_.x = cvtpk(kr[t][2][0] * rk_ * gg[8], kr[t][2][1] * rk_ * gg[9]); k1_.y = cvtpk(kr[t][2][2] * rk_ * gg[10], kr[t][2][3] * rk_ * gg[11]); k1_.z = cvtpk(kr[t][3][0] * rk_ * gg[12], kr[t][3][1] * rk_ * gg[13]); k1_.w = cvtpk(kr[t][3][2] * rk_ * gg[14], kr[t][3][3] * rk_ * gg[15]);
        LAS v4u* kd_ = (LAS v4u*)(bb_ + MBUF_K + (skey * MKP + sch * 16) * 2); kd_[0] = k0_; kd_[1] = k1_;
        LAS v4u* vd_ = (LAS v4u*)(bb_ + MBUF_V + (skey * MVP + sch * 16) * 2); vd_[0] = vr[t][0]; vd_[1] = vr[t][1]; }
    bf16x8 qf[8];
    { float ss = 0.f;
#pragma unroll
      for (int d0 = 0; d0 < 8; ++d0) { const float a0 = bflo(qw[d0].x), a1 = bfhi(qw[d0].x), a2 = bflo(qw[d0].y), a3 = bfhi(qw[d0].y), a4 = bflo(qw[d0].z), a5 = bfhi(qw[d0].z), a6 = bflo(qw[d0].w), a7 = bfhi(qw[d0].w);
          ss += (a0 * a0 + a1 * a1) + (a2 * a2 + a3 * a3) + (a4 * a4 + a5 * a5) + (a6 * a6 + a7 * a7); }
      ss += other_half(ss, hi);
      const float rq = __builtin_amdgcn_rsqf(ss * (1.0f / MHD) + EPS);
#pragma unroll
      for (int d0 = 0; d0 < 8; ++d0) { v4u o; o.x = cvtpk(bflo(qw[d0].x) * rq, bfhi(qw[d0].x) * rq); o.y = cvtpk(bflo(qw[d0].y) * rq, bfhi(qw[d0].y) * rq);
          o.z = cvtpk(bflo(qw[d0].z) * rq, bfhi(qw[d0].z) * rq); o.w = cvtpk(bflo(qw[d0].w) * rq, bfhi(qw[d0].w) * rq); qf[d0] = __builtin_bit_cast(bf16x8, o); } }
    f32x16 o0 = {}, o1 = {}, o2 = {}, o3 = {};
    float lrun = 0.f;
    __syncthreads();
#pragma unroll 1
    for (int kt = 0; kt < 4; ++kt) {
        const LAS unsigned char* bb = lds + kt * MBUF_BYTES;
        f32x16 p0, p1;
#pragma unroll
        for (int r = 0; r < 16; ++r) { p0[r] = nref; p1[r] = nref; }
        { const LAS unsigned char* kb = bb + MBUF_K + (r32 * MKP + 8 * hi) * 2;
#pragma unroll
          for (int d0 = 0; d0 < 8; ++d0) { const bf16x8 a0 = *(const LAS bf16x8*)(kb + d0 * 32), a1 = *(const LAS bf16x8*)(kb + 32 * MKP * 2 + d0 * 32);
              p0 = ATT_MFMA(a0, qf[d0], p0); p1 = ATT_MFMA(a1, qf[d0], p1); } }
        float ls = 0.f;
#pragma unroll
        for (int r = 0; r < 16; ++r) { p0[r] = __builtin_amdgcn_exp2f(p0[r]); p1[r] = __builtin_amdgcn_exp2f(p1[r]); ls += p0[r] + p1[r]; }
        lrun += ls;
        const LAS unsigned char* vb = bb + MBUF_V + ((4 * hi + ((r32 & 15) >> 2)) * MVP + 16 * (r32 >> 4) + 4 * (r32 & 3)) * 2;
#pragma unroll
        for (int ks = 0; ks < 4; ++ks) {
            const int rb = 8 * (ks & 1); u32x4 pw;
            if (ks < 2) { pw.x = cvtpk(p0[rb], p0[rb + 1]); pw.y = cvtpk(p0[rb + 2], p0[rb + 3]); pw.z = cvtpk(p0[rb + 4], p0[rb + 5]); pw.w = cvtpk(p0[rb + 6], p0[rb + 7]); }
            else        { pw.x = cvtpk(p1[rb], p1[rb + 1]); pw.y = cvtpk(p1[rb + 2], p1[rb + 3]); pw.z = cvtpk(p1[rb + 4], p1[rb + 5]); pw.w = cvtpk(p1[rb + 6], p1[rb + 7]); }
            const bf16x8 pf = __builtin_bit_cast(bf16x8, pw);
            const int koff = (16 * ks) * MVP * 2;
#define MATT_PV(ob, db) do { const u32x2 l_ = vtr(vb + koff + 64 * (db)), h_ = vtr(vb + koff + 8 * MVP * 2 + 64 * (db)); \
                const u32x4 a_ = {l_.x, l_.y, h_.x, h_.y}; ob = ATT_MFMA(__builtin_bit_cast(bf16x8, a_), pf, ob); } while (0)
            MATT_PV(o0, 0); MATT_PV(o1, 1); MATT_PV(o2, 2); MATT_PV(o3, 3);
#undef MATT_PV
        }
    }
    const float inv = 1.0f / (lrun + other_half(lrun, hi));
    bf16* op = MQ + rowq * DH + hm * MHD + 4 * hi;
#pragma unroll
    for (int g = 0; g < 4; ++g) {
#define MATT_ST(ob, db) do { u32x2 w_; w_.x = cvtpk(ob[4 * g] * inv, ob[4 * g + 1] * inv); w_.y = cvtpk(ob[4 * g + 2] * inv, ob[4 * g + 3] * inv); *(u32x2*)(op + 32 * (db) + 8 * g) = w_; } while (0)
        MATT_ST(o0, 0); MATT_ST(o1, 1); MATT_ST(o2, 2); MATT_ST(o3, 3);
#undef MATT_ST
    }
}
}

constexpr int N_PHASES = 9;
#ifndef OPT_P1
#define OPT_P1 1
#endif
#ifndef OPT_P3
#define OPT_P3 1
#endif
#ifndef OPT_ATT
#define OPT_ATT 1
#endif
#ifndef OPT_P4
#define OPT_P4 1
#endif
#ifndef OPT_P5
#define OPT_P5 1
#endif
#ifndef OPT_P6
#define OPT_P6 1
#endif
#ifndef DE_P1
#define DE_P1 true
#endif
#ifndef DE_P5
#define DE_P5 true
#endif
#ifndef STAGGER_P1
#define STAGGER_P1 0
#endif
#ifndef MK_N_LAUNCHES
#define MK_N_LAUNCHES 1
#endif
constexpr int N_LAUNCHES = MK_N_LAUNCHES;
struct Args { const float* in[18]; float* out; unsigned char* ws; int ph_lo, ph_hi, li, pad; };

__global__ void __launch_bounds__(NTHREADS, 2) skel_fwd(Args args) {
    extern __shared__ __attribute__((aligned(16))) unsigned char lds[];
    Frame F;
    F.lds = (LAS unsigned char*)lds;
    F.MISC = (volatile LAS unsigned*)(F.lds + MISC_OFF);
    F.tid = threadIdx.x; F.lane = F.tid & 63; F.wave = __builtin_amdgcn_readfirstlane(F.tid >> 6);
    F.G = gridDim.x; { const int bx = blockIdx.x; F.vcu = (F.G % 8 == 0) ? (bx % 8) * (F.G / 8) + bx / 8 : bx; }
    unsigned char* ws = args.ws;
    F.ctl = (gu32*)(ws + WS_CTL);
    F.x = args.in[0]; F.mem = args.in[1]; F.g_mix = args.in[2]; F.g_memn = args.in[3]; F.w_in = args.in[4]; F.b_forget = args.in[5]; F.g_fq = args.in[6]; F.g_fk = args.in[7];
    F.g_mq = args.in[8]; F.g_mk = args.in[9]; F.w_mkv = args.in[10]; F.w_bsb = args.in[11]; F.w_bfx = args.in[12]; F.w_bmm = args.in[13]; F.w_out = args.in[14]; F.g_mlp = args.in[15];
    F.w_up = args.in[16]; F.w_dn = args.in[17]; F.out = args.out;
    F.logf = (float*)(ws + WS_LOGF); F.FC = (float*)(ws + WS_FC); F.ssq = (float*)(ws + WS_SSQ); F.MKf = (float*)(ws + WS_MKF);
    F.Win_t = (bf16*)(ws + WS_WIN); F.Wmkv_t = (bf16*)(ws + WS_WMKV); F.Wbr_t = (bf16*)(ws + WS_WBR); F.Wout_t = (bf16*)(ws + WS_WOUT); F.Wup_t = (bf16*)(ws + WS_WUP); F.Wdn_t = (bf16*)(ws + WS_WDN);
    F.MHb = (bf16*)(ws + WS_MH); F.MV = (bf16*)(ws + WS_MV); F.XN = (bf16*)(ws + WS_XN);
    F.SBQ = (bf16*)(ws + WS_SBQ); F.SBK = (bf16*)(ws + WS_SBK); F.SBV = (bf16*)(ws + WS_SBV); F.FXQ = (bf16*)(ws + WS_FXQ); F.FXK = (bf16*)(ws + WS_FXK); F.FXV = (bf16*)(ws + WS_FXV); F.MQ = (bf16*)(ws + WS_MQ);
    F.G0 = (bf16*)args.out; F.G1 = (bf16*)args.out + (size_t)M * D; F.G2 = (bf16*)(ws + WS_G2); F.MRG = (bf16*)(ws + WS_MRG); F.U = (bf16*)(ws + WS_U);
    for (int u = F.tid; u < (LDS_BYTES - LDSCTL_OFF) / 4; u += NTHREADS) ((LAS unsigned*)(F.lds + LDSCTL_OFF))[u] = 0u;
    __syncthreads();
    XcdBarrier bar; bar.bar = (unsigned*)(F.ctl + CW_BAR); bar.x = 0; bar.st = nullptr;
    if (N_LAUNCHES == 1) bar = xcd_barrier_post((unsigned*)(F.ctl + CW_BAR), F.MISC + 8);
#define GRID_BAR() do { if (N_LAUNCHES == 1) xcd_barrier(bar); } while (0)
    const int lo = args.ph_lo, hi = args.ph_hi;
#define IN(k) (lo <= (k) && (k) < hi)
#define BOTH(k) (IN(k) && IN((k) + 1))
    const int wg = (int)blockIdx.x, nwg = F.G;
    unsigned long long ts_prev = 0ull, ts0 = 0ull; float probe = 0.f;
    if (TIMING_PHASE >= 0 && blockIdx.x == 0 && F.tid == 0) { ts0 = __builtin_amdgcn_s_memrealtime(); ts_prev = ts0; }
#define STAMP(k) do { if (TIMING_PHASE >= 0 && blockIdx.x == 0 && F.tid == 0) { const unsigned long long t_ = __builtin_amdgcn_s_memrealtime(); \
        if (TIMING_PHASE == (k)) probe = (float)(t_ - ts_prev) * 1e-5f; if (TIMING_PHASE == 8 && (k) == 7) probe = (float)(t_ - ts0) * 0.25e-5f; ts_prev = t_; } } while (0)

    if (IN(0)) { p0_prologue(F); if (BOTH(0)) GRID_BAR(); STAMP(0); }
    if (IN(1)) {
        fcumsum(F); VM_WAIT();
#if STAGGER_P1
        { if (F.tid == 0) { const unsigned long long t0 = __builtin_amdgcn_s_memrealtime(), dl = (unsigned long long)(((int)blockIdx.x >> 3) & 3) * STAGGER_P1; while (__builtin_amdgcn_s_memrealtime() - t0 < dl) __builtin_amdgcn_s_sleep(8); }
          __syncthreads(); }
#endif
#if OPT_P1
        { pg8::EpiProj E{F.SBQ, F.G0, F.G2, F.MKf, F.MV};
          pg8::SchedP1 S{F.G, (int)blockIdx.x, (const char*)F.XN, (const char*)F.Win_t};
          pg8::gemm_phase<pg8::EpiProj, pg8::SchedP1, false, true, 1, DE_P1>(F.lds, D, S, E);
          if (F.G == 256) { unsigned* qctr = (unsigned*)(F.ctl + CW_LWQ); volatile LAS unsigned* slot = F.MISC + 24;
              VM_WAIT(); __syncthreads();
              unsigned nx = 0; if (F.tid == 0) nx = __hip_atomic_fetch_add(qctr, 1u, __ATOMIC_RELAXED, __HIP_MEMORY_SCOPE_AGENT);
              for (;;) {
                  if (F.tid == 0) *slot = nx;
                  __syncthreads();
                  const unsigned idx = *slot;
                  if (idx * NWAVES >= (unsigned)LATE_ITEMS) break;
                  if (F.tid == 0) nx = __hip_atomic_fetch_add(qctr, 1u, __ATOMIC_RELAXED, __HIP_MEMORY_SCOPE_AGENT);
                  convert_late_weights(F, F.wave, LATE_ITEMS, (int)idx * NWAVES, (int)idx * NWAVES + NWAVES);
                  __syncthreads(); } } }
#else
        { EpiProjN E{F.SBQ, F.G0, F.G2}; ngemm(F.XN, D, F.Win_t, D, M, NPROJ, D, E, wg, nwg); }
        { EpiMkvN E{F.MKf, F.MV}; ngemm(F.MHb, D, F.Wmkv_t, D, MROWS, 1024, D, E, wg, nwg); }
#endif
        if (BOTH(1)) GRID_BAR();
        STAMP(1);
    }
    if (IN(2)) {
#if !OPT_P1
        headnorm_naive(F);
#endif
        if (BOTH(2)) { if (!OPT_P1) GRID_BAR(); } STAMP(2); }
    if (IN(3)) {
#if OPT_ATT
        for (int v = F.vcu; v < 256; v += F.G) { const int bh = v >> 2, s4 = v & 3;
            att::unit_sb(F.SBQ, F.SBK, F.SBV, F.SBQ, bh >> 3, bh & 7, 7 - s4, F.lds); __syncthreads();
            att::unit_sb(F.SBQ, F.SBK, F.SBV, F.SBQ, bh >> 3, bh & 7, s4, F.lds); __syncthreads();
            att::unit64<1>(F.FXQ, F.FXK, F.FXV, F.FXQ, F.FC, F.g_fq, F.g_fk, bh >> 3, bh & 7, 7 - s4, F.lds); __syncthreads();
            att::unit64<1>(F.FXQ, F.FXK, F.FXV, F.FXQ, F.FC, F.g_fq, F.g_fk, bh >> 3, bh & 7, s4, F.lds); __syncthreads(); }
#else
        nattn64<0>(F.SBQ, F.SBK, F.SBV, F.SBQ, F.FC, F.g_fq, F.g_fk, wg, nwg);
        nattn64<1>(F.FXQ, F.FXK, F.FXV, F.FXQ, F.FC, F.g_fq, F.g_fk, wg, nwg);
#endif
#if OPT_ATT
        for (int v = F.vcu; v < 256; v += F.G) { att::unit_mem(F.MQ, F.MKf, F.MV, F.g_mq, F.g_mk, v >> 5, (v >> 3) & 3, v & 7, F.lds); __syncthreads(); }
#else
        nattn_mem(F, wg, nwg);
#endif
        if (BOTH(3)) GRID_BAR();
        STAMP(3);
    }
    if (IN(4)) {
#if OPT_P3
        { pg8::SchedP3m S{F.G, (int)blockIdx.x, (const char*)F.SBQ, (const char*)F.Wbr_t};
          pg8::EpiMergedR E{F.G0, F.G2, F.MRG};
          pg8::gemm_phase<pg8::EpiMergedR, pg8::SchedP3m, true, true, 3>(F.lds, DH, S, E); }
#else
        nmerged(F, wg, nwg);
#endif
        if (BOTH(4)) GRID_BAR(); STAMP(4); }
    if (IN(5)) {
#if OPT_P4
        { pg8::SchedPlain S{64, 4, F.G, (int)blockIdx.x, (const char*)F.MRG, (const char*)F.Wout_t, (size_t)256 * D * 2};
          pg8::EpiOut E{F.x, F.out, F.XN, F.ssq};
          pg8::gemm_phase<pg8::EpiOut, pg8::SchedPlain, false, true, 4>(F.lds, D, S, E); }
#else
        { EpiOutN E{F.x, F.out, F.XN}; ngemm(F.MRG, D, F.Wout_t, D, M, D, D, E, wg, nwg); }
#endif
        if (BOTH(5)) GRID_BAR(); STAMP(5); }
    if (IN(6)) {
#if !OPT_P4
        ssq_naive(F);
        if (BOTH(6)) GRID_BAR();
#endif
    }
    if (IN(7)) {
#if OPT_P5
        {
          pg8::SchedPlain S{64, 16, F.G, (int)blockIdx.x, (const char*)F.XN, (const char*)F.Wup_t, (size_t)256 * D * 2};
          pg8::EpiUp E{F.U};
          pg8::gemm_phase<pg8::EpiUp, pg8::SchedPlain, true, true, 5, false>(F.lds, D, S, E); }
#else
        { EpiUpN E{F.ssq, F.U}; ngemm(F.XN, D, F.Wup_t, D, M, FF, D, E, wg, nwg); }
#endif
        if (BOTH(7)) GRID_BAR(); STAMP(7); }
    if (GPROBE != 0) { __syncthreads(); if (blockIdx.x == 0) probe = *(LAS float*)(F.lds + MISC_OFF + 64); }
    if (IN(8)) {
#if OPT_P6
        { pg8::SchedPlain S{64, 4, F.G, (int)blockIdx.x, (const char*)F.U, (const char*)F.Wdn_t, (size_t)256 * FF * 2};
          pg8::EpiDown E{F.out, F.ssq, probe, F.XN};
          pg8::gemm_phase<pg8::EpiDown, pg8::SchedPlain, false, true>(F.lds, FF, S, E); }
#else
        { EpiDnN E{F.out, F.ssq, F.XN}; ngemm(F.U, FF, F.Wdn_t, FF, M, D, FF, E, wg, nwg); }
#endif
    }
#undef IN
#undef BOTH
}

extern "C" void kernel_launch(void* const* d_in, const int* in_sizes, int n_in, void* d_out, int out_size, void* d_ws, size_t ws_size, hipStream_t stream) {
    static int grid = 0;
    if (grid == 0) {
        if (n_in != 18 || in_sizes[0] != M * D || out_size != M * D || ws_size < WS_END) { fprintf(stderr, "kernel_launch: unexpected shapes (n_in %d, in0 %d, out %d, ws %zu); nothing launched\n", n_in, n_in > 0 ? in_sizes[0] : -1, out_size, ws_size); grid = -1; return; }
        int dev = 0, cus = 0, per_cu = 0;
        if (hipGetDevice(&dev) != hipSuccess || hipDeviceGetAttribute(&cus, hipDeviceAttributeMultiprocessorCount, dev) != hipSuccess) { grid = -1; return; }
        if (hipFuncSetAttribute((const void*)skel_fwd, hipFuncAttributeMaxDynamicSharedMemorySize, LDS_BYTES) != hipSuccess) { fprintf(stderr, "kernel_launch: hipFuncSetAttribute failed\n"); grid = -1; return; }
        if (hipOccupancyMaxActiveBlocksPerMultiprocessor(&per_cu, (const void*)skel_fwd, NTHREADS, LDS_BYTES) != hipSuccess || per_cu < 1) fprintf(stderr, "kernel_launch: occupancy query reports %d\n", per_cu);
        (void)hipGetLastError();
        grid = cus;
    }
    if (grid < 0) return;
    if (hipMemsetAsync((char*)d_ws + WS_CTL, 0, CTL_ZERO_BYTES, stream) != hipSuccess) return;
    Args a{};
    for (int i = 0; i < 18; ++i) a.in[i] = (const float*)d_in[i];
    a.out = (float*)d_out; a.ws = (unsigned char*)d_ws;
    for (int li = 0; li < N_LAUNCHES; ++li) {
        a.ph_lo = (N_LAUNCHES == 1) ? 0 : li; a.ph_hi = (N_LAUNCHES == 1) ? N_PHASES : li + 1; a.li = li;
        hipLaunchKernelGGL(skel_fwd, dim3(grid), dim3(NTHREADS), LDS_BYTES, stream, a);
        if (hipPeekAtLastError() != hipSuccess) break;
    }
}
```

```cpp
#include <hip/hip_runtime.h>
#include <cstdio>
#include <cstdint>
#ifndef TIMING_PHASE
#ifndef GPROBE
#define GPROBE 0
#endif
#ifndef GPSEL
#define GPSEL 0
#endif
#ifndef GPOFF
#define GPOFF 0.f
#endif
#ifndef GPSCALE
#define GPSCALE 1.f
#endif
#define TIMING_PHASE -1
#endif

#define GAS __attribute__((address_space(1)))
#define LAS __attribute__((address_space(3)))
typedef unsigned short bf16;
typedef short bf16x8 __attribute__((ext_vector_type(8)));
typedef float f32x4 __attribute__((ext_vector_type(4)));
typedef unsigned v4u __attribute__((ext_vector_type(4)));
typedef GAS unsigned gu32;
#define RLX_AGENT __ATOMIC_RELAXED, __HIP_MEMORY_SCOPE_AGENT
#define LDS_WAIT() asm volatile("s_waitcnt lgkmcnt(0)" ::: "memory")
#define VM_WAIT() asm volatile("s_waitcnt vmcnt(0)" ::: "memory")

constexpr int NWAVES = 8, NTHREADS = 512;
constexpr int BATCH = 8, SEQ = 2048, M = BATCH * SEQ, D = 1024, MEMLEN = 256, MROWS = BATCH * MEMLEN;
constexpr int HD = 64, NH = 8, MNH = 4, MHD = 128, DH = 512, FF = 4096;
constexpr int DIN = 6664, NPROJ = 6656;
constexpr float EPS = 1e-6f, LOG2E = 1.4426950408889634f, LN2 = 0.6931471805599453f;
constexpr float C2 = 0.125f * LOG2E;
constexpr float C2M = 0.08838834764831845f * LOG2E;

constexpr size_t MiB = 1u << 20;
constexpr size_t WS_CTL = 0, CTL_ZERO_BYTES = 65536;
constexpr size_t WS_LOGF = 1 * MiB, WS_FC = 1 * MiB + 512 * 1024, WS_SSQ = 2 * MiB;
constexpr size_t WS_WIN = 3 * MiB, WS_WMKV = 16 * MiB, WS_WBR = 18 * MiB, WS_WOUT = 21 * MiB, WS_WUP = 23 * MiB, WS_WDN = 31 * MiB;
constexpr size_t WS_MV = 39 * MiB, WS_XN = 44 * MiB, WS_MH = 76 * MiB;
constexpr size_t WS_T1 = 96 * MiB, WS_T2 = 144 * MiB;
constexpr size_t WS_SBQ = 80 * MiB, WS_SBK = 96 * MiB, WS_SBV = 112 * MiB, WS_FXQ = 128 * MiB, WS_FXK = 144 * MiB, WS_FXV = 160 * MiB, WS_MQ = 176 * MiB;
constexpr size_t WS_G2 = 192 * MiB, WS_MRG = 224 * MiB, WS_MKF = 224 * MiB, WS_U = 80 * MiB, WS_END = 256 * MiB;
constexpr int CW_BAR = 4096, CW_LWQ = 2048;

constexpr int RING_BYTES = 131072, LDSCTL_OFF = 147456, MISC_OFF = LDSCTL_OFF + 320, LDS_BYTES = 163840;

__device__ __forceinline__ unsigned f2bf(float f) { unsigned u = __builtin_bit_cast(unsigned, f); return (u + 0x7fffu + ((u >> 16) & 1u)) >> 16; }
__device__ __forceinline__ unsigned pk2(float lo, float hi) { return f2bf(lo) | (f2bf(hi) << 16); }
__device__ __forceinline__ float bf2f(unsigned b) { return __uint_as_float(b << 16); }
__device__ __forceinline__ float bflo(unsigned w) { return __uint_as_float(w << 16); }
__device__ __forceinline__ float bfhi(unsigned w) { return __uint_as_float(w & 0xffff0000u); }
__device__ __forceinline__ float wave_sum(float v) {
#pragma unroll
    for (int o = 1; o < 64; o <<= 1) v += __shfl_xor(v, o);
    return v;
}
__device__ __forceinline__ float log_sigmoid_f(float x) { return fminf(x, 0.f) - log1pf(expf(-fabsf(x))); }

#define XB_TMO      128
#define XB_XCNT(j)  (256  + 64 * (j))
#define XB_XSUB(j)  (1280 + 64 * (j))
#define XB_XGEN(j)  (2304 + 64 * (j))
#define XB_TOP      3328
#define XB_TOPGEN   3392
#define XCD_BAR_WORDS 3456
#define XB_SPIN_CAP (1u << 18)
__device__ __forceinline__ unsigned xb_ld(unsigned* p)              { return __hip_atomic_load(p, __ATOMIC_RELAXED, __HIP_MEMORY_SCOPE_AGENT); }
__device__ __forceinline__ unsigned xb_add(unsigned* p, unsigned v) { return __hip_atomic_fetch_add(p, v, __ATOMIC_RELAXED, __HIP_MEMORY_SCOPE_AGENT); }
__device__ __forceinline__ unsigned xb_xcc_id() { return (unsigned)__builtin_amdgcn_s_getreg((3 << 11) | 20) & 0xFu; }
#define XB_SPIN(cond, bar) do { unsigned _sp = 0; while (cond) { __builtin_amdgcn_s_sleep(1); \
    if ((++_sp & 255u) == 0u) { if (xb_ld(&(bar)[XB_TMO])) break; if (_sp > XB_SPIN_CAP) { atomicAdd(&(bar)[XB_TMO], 1u); break; } } } } while (0)
struct XcdBarrier { unsigned* bar; unsigned x; volatile LAS unsigned* st; };
__device__ __forceinline__ XcdBarrier xcd_barrier_post(unsigned* bar, volatile LAS unsigned* st) {
    XcdBarrier b; b.bar = bar; b.x = xb_xcc_id(); b.st = st;
    if (threadIdx.x == 0) (void)xb_add(&bar[XB_XCNT(b.x)], 1u);
    return b;
}
__device__ __forceinline__ void xcd_barrier_complete(unsigned* bar, unsigned x, unsigned& nloc, unsigned& nx) {
    const unsigned G = gridDim.x * gridDim.y * gridDim.z;
    unsigned sum, cnt, mine, sp = 0u;
    for (;;) {
        sum = 0u; cnt = 0u; mine = 0u;
#pragma unroll
        for (unsigned j = 0; j < 16; ++j) { const unsigned c = xb_ld(&bar[XB_XCNT(j)]); sum += c; cnt += (c > 0u) ? 1u : 0u; mine = (j == x) ? c : mine; }
        if (sum == G) break;
        __builtin_amdgcn_s_sleep(1);
        if ((++sp & 255u) == 0u) { if (xb_ld(&bar[XB_TMO])) break; if (sp > XB_SPIN_CAP) { atomicAdd(&bar[XB_TMO], 1u); break; } }
    }
    nloc = mine > 0u ? mine : 1u; nx = cnt > 0u ? cnt : 1u;
}
__device__ __forceinline__ void xcd_barrier(const XcdBarrier& b) {
    asm volatile("s_waitcnt vmcnt(0)" ::: "memory");
    __syncthreads();
    if (threadIdx.x == 0) {
        unsigned* bar = b.bar;
        __builtin_amdgcn_s_waitcnt(0);
        unsigned nloc = b.st[0], nx = b.st[1];
        if (nloc == 0u) { xcd_barrier_complete(bar, b.x, nloc, nx); b.st[0] = nloc; b.st[1] = nx; }
        const unsigned old = xb_add(&bar[XB_XSUB(b.x)], 1u);
        const unsigned gen = old / nloc;
        if (old + 1u == (gen + 1u) * nloc) {
            __builtin_amdgcn_fence(__ATOMIC_RELEASE, "agent");
            asm volatile("s_waitcnt vmcnt(0)" ::: "memory");
            const unsigned og = xb_add(&bar[XB_TOP], 1u);
            const unsigned tg = og / nx;
            if (og + 1u == (tg + 1u) * nx) xb_add(&bar[XB_TOPGEN], 1u);
            else XB_SPIN(xb_ld(&bar[XB_TOPGEN]) == tg, bar);
            __builtin_amdgcn_fence(__ATOMIC_ACQUIRE, "agent");
            xb_add(&bar[XB_XGEN(b.x)], 1u);
            asm volatile("s_waitcnt vmcnt(0)" ::: "memory");
        } else {
            XB_SPIN(xb_ld(&bar[XB_XGEN(b.x)]) == gen, bar);
            __builtin_amdgcn_fence(__ATOMIC_ACQUIRE, "agent");
            asm volatile("s_waitcnt vmcnt(0)" ::: "memory");
        }
    }
    __syncthreads();
}

struct Frame {
    LAS unsigned char* lds;
    volatile LAS unsigned* MISC;
    gu32* ctl;
    int tid, lane, wave, vcu, G;
    const float *x, *mem, *g_mix, *g_memn, *w_in, *b_forget, *g_fq, *g_fk, *g_mq, *g_mk, *w_mkv, *w_bsb, *w_bfx, *w_bmm, *w_out, *g_mlp, *w_up, *w_dn;
    float* out;
    float *logf, *FC, *ssq, *MKf;
    bf16 *Win_t, *Wmkv_t, *Wbr_t, *Wout_t, *Wup_t, *Wdn_t, *MHb, *MV, *XN, *SBQ, *SBK, *SBV, *FXQ, *FXK, *FXV, *MQ, *G0, *G1, *G2, *MRG, *U;
};

__device__ __forceinline__ void tr_item(const float* W, int ldw, int K, bf16* WT, int src_c0, int dst_r0, int k0, LAS float* scr, int lane, const float* kgain = nullptr, const float cscale = 1.0f) {
    float wv[32];
#pragma unroll
    for (int i = 0; i < 32; ++i) { const int kk = 2 * i + (lane >> 5); wv[i] = W[(size_t)(k0 + kk) * ldw + src_c0 + (lane & 31)]; }
#pragma unroll
    for (int i = 0; i < 32; ++i) { const int kk = 2 * i + (lane >> 5); float w = wv[i] * cscale; if (kgain) w *= kgain[k0 + kk]; scr[kk * 33 + (lane & 31)] = w; }
    LDS_WAIT(); asm volatile("" ::: "memory");
    const int c = lane & 7;
#pragma unroll
    for (int j = 0; j < 4; ++j) { const int n = (lane >> 3) + 8 * j; const LAS float* s = scr + (8 * c) * 33 + n;
        v4u o; o.x = pk2(s[0 * 33], s[1 * 33]); o.y = pk2(s[2 * 33], s[3 * 33]); o.z = pk2(s[4 * 33], s[5 * 33]); o.w = pk2(s[6 * 33], s[7 * 33]);
        *(GAS v4u*)(WT + (size_t)(dst_r0 + n) * K + k0 + 8 * c) = o; }
    LDS_WAIT(); asm volatile("" ::: "memory");
}
__host__ __device__ __forceinline__ int proj_src_col(int n) {
    const int pn = n >> 8, j = n & 255;
    if (pn < 12) { const int T = pn >> 1, bj = j >> 7, wc = (j >> 5) & 3, e = j & 31; return T * 512 + ((pn & 1) * 4 + wc) * 64 + bj * 32 + e; }
    const int bj = j >> 7, wc = (j >> 5) & 3, e = j & 31, t = 64 * wc + 32 * bj + e;
    if (pn < 14) return 3080 + (pn - 12) * 256 + t;
    return 3592 + (pn - 14) * 256 + t;
}
template <bool IS_X>
__device__ __forceinline__ void p0_rows(Frame& F, const float* srcb, const float* g, bf16* dstb, int nrows, const LAS float* wf, int gw, int NGW) {
    const GAS f32x4* gr = (const GAS f32x4*)g + F.lane;
    f32x4 wfr[4][4][2];
    if (IS_X) {
#pragma unroll
        for (int j = 0; j < 4; ++j)
#pragma unroll
            for (int e = 0; e < 4; ++e) { const LAS f32x4* wp = (const LAS f32x4*)(wf + (256 * j + 4 * F.lane + e) * 8); wfr[j][e][0] = wp[0]; wfr[j][e][1] = wp[1]; } }
    f32x4 nx[4];
    if (gw < nrows) { const GAS f32x4* xr = (const GAS f32x4*)(srcb + (size_t)gw * D) + F.lane;
#pragma unroll
        for (int j = 0; j < 4; ++j) nx[j] = xr[64 * j]; }
    for (int m = gw; m < nrows; m += NGW) {
        f32x4 v[4]; float s = 0.f;
#pragma unroll
        for (int j = 0; j < 4; ++j) v[j] = nx[j];
        if (m + NGW < nrows) { const GAS f32x4* xr = (const GAS f32x4*)(srcb + (size_t)(m + NGW) * D) + F.lane;
#pragma unroll
            for (int j = 0; j < 4; ++j) nx[j] = xr[64 * j]; }
#pragma unroll
        for (int j = 0; j < 4; ++j) s += (v[j].x * v[j].x + v[j].y * v[j].y) + (v[j].z * v[j].z + v[j].w * v[j].w);
        const float rstd = __builtin_amdgcn_rsqf(wave_sum(s) * (1.f / D) + EPS);
#pragma unroll
        for (int j = 0; j < 4; ++j) { const f32x4 gg = gr[64 * j]; v[j] = v[j] * rstd * gg; }
        GAS unsigned long long* o8 = (GAS unsigned long long*)(dstb + (size_t)m * D) + F.lane;
#pragma unroll
        for (int j = 0; j < 4; ++j) o8[64 * j] = (unsigned long long)pk2(v[j].x, v[j].y) | ((unsigned long long)pk2(v[j].z, v[j].w) << 32);
        if (IS_X) {
            float fl[8];
#pragma unroll
            for (int c = 0; c < 8; ++c) fl[c] = 0.f;
#pragma unroll
            for (int j = 0; j < 4; ++j)
#pragma unroll
                for (int e = 0; e < 4; ++e) { const float hv = v[j][e]; const f32x4 w0 = wfr[j][e][0], w1 = wfr[j][e][1];
                    fl[0] += hv * w0.x; fl[1] += hv * w0.y; fl[2] += hv * w0.z; fl[3] += hv * w0.w; fl[4] += hv * w1.x; fl[5] += hv * w1.y; fl[6] += hv * w1.z; fl[7] += hv * w1.w; }
            float mine = 0.f;
#pragma unroll
            for (int c = 0; c < 8; ++c) { const float t = wave_sum(fl[c]); if (F.lane == c) mine = t; }
            if (F.lane < 8) F.logf[(size_t)m * 8 + F.lane] = log_sigmoid_f(mine + F.b_forget[F.lane]);
        }
    }
}
constexpr int LATE_ITEMS = 3 * 8 * 32 + 16 * 32 + 16 * 128 + 64 * 32;
__device__ __forceinline__ void convert_late_weights(Frame& F, int w, int nw, const int lo = 0, const int NITEMS = LATE_ITEMS) {
    LAS float* scr = (LAS float*)(F.lds + F.wave * 8448);
    constexpr int I_BR = 8 * 32, I_OUT = 16 * 32, I_UP = 16 * 128;
    for (int it = lo + w; it < NITEMS; it += nw) {
        int r = it;
        if (r < I_BR) { const int kb = r / 32, gi = r % 32; tr_item(F.w_bsb, D, DH, F.Wbr_t, 32 * gi, 32 * gi, 64 * kb, scr, F.lane); continue; } r -= I_BR;
        if (r < I_BR) { const int kb = r / 32, gi = r % 32; tr_item(F.w_bfx, D, DH, F.Wbr_t + (size_t)D * DH, 32 * gi, 32 * gi, 64 * kb, scr, F.lane); continue; } r -= I_BR;
        if (r < I_BR) { const int kb = r / 32, gi = r % 32; tr_item(F.w_bmm, D, DH, F.Wbr_t + (size_t)2 * D * DH, 32 * gi, 32 * gi, 64 * kb, scr, F.lane); continue; } r -= I_BR;
        if (r < I_OUT) { const int kb = r / 32, gi = r % 32; tr_item(F.w_out, D, D, F.Wout_t, 32 * gi, 32 * gi, 64 * kb, scr, F.lane); continue; } r -= I_OUT;
        if (r < I_UP) { const int kb = r / 128, gi = r % 128; tr_item(F.w_up, FF, D, F.Wup_t, 32 * gi, 32 * gi, 64 * kb, scr, F.lane, F.g_mlp); continue; } r -= I_UP;
        { const int kb = r / 32, gi = r % 32; tr_item(F.w_dn, D, FF, F.Wdn_t, 32 * gi, 32 * gi, 64 * kb, scr, F.lane); }
    }
}
__device__ __forceinline__ void p0_prologue(Frame& F) {
    LAS float* scr = (LAS float*)(F.lds + F.wave * 8448);
    LAS float* wf = (LAS float*)(F.lds + 8 * 8448);
    for (int i = F.tid; i < D * 8; i += NTHREADS) wf[i] = F.w_in[(size_t)(i >> 3) * DIN + 3072 + (i & 7)];
    const int gw = F.vcu * NWAVES + F.wave, NGW = F.G * NWAVES;
    constexpr int I_IN = 16 * 208, I_MKV = 16 * 32, NITEMS = I_IN + I_MKV;
    for (int it = gw; it < NITEMS; it += NGW) {
        int r = it;
        if (r < I_IN) { const int kb = r / 208, gi = r % 208; tr_item(F.w_in, DIN, D, F.Win_t, proj_src_col(32 * gi), 32 * gi, 64 * kb, scr, F.lane, nullptr, gi >= 14 * 8 ? -LOG2E : 1.0f); continue; } r -= I_IN;
        { const int kb = r / 32, gi = r % 32; tr_item(F.w_mkv, 1024, D, F.Wmkv_t, 32 * gi, 32 * gi, 64 * kb, scr, F.lane); }
    }
    if (F.G != 256) { __syncthreads(); convert_late_weights(F, gw, NGW); }
    __syncthreads();
    p0_rows<true>(F, F.x, F.g_mix, F.XN, M, wf, gw, NGW);
    p0_rows<false>(F, F.mem, F.g_memn, F.MHb, MROWS, wf, gw, NGW);
}

template <class Epi>
__device__ __forceinline__ void ngemm(const bf16* A, int lda, const bf16* Bt, int ldb, int Mr, int Nc, int K, const Epi& E, int wg, int nwg) {
    const int tid = threadIdx.x, lane = tid & 63, wid = tid >> 6, wm = wid >> 1, wn = wid & 1;
    const int tilesN = Nc / 128, ntiles = (Mr / 128) * tilesN;
    for (int t = wg; t < ntiles; t += nwg) {
        const int tm = t / tilesN, tn = t % tilesN, r0 = tm * 128 + wm * 32, c0 = tn * 128 + wn * 64;
        f32x4 acc[2][4];
#pragma unroll
        for (int m = 0; m < 2; ++m)
#pragma unroll
            for (int n = 0; n < 4; ++n) acc[m][n] = (f32x4){0.f, 0.f, 0.f, 0.f};
        const bf16* ap = A + (size_t)(r0 + (lane & 15)) * lda + 8 * (lane >> 4);
        const bf16* bp = Bt + (size_t)(c0 + (lane & 15)) * ldb + 8 * (lane >> 4);
        for (int k0 = 0; k0 < K; k0 += 32) {
            bf16x8 a[2], b[4];
#pragma unroll
            for (int m = 0; m < 2; ++m) a[m] = *(const bf16x8*)(ap + (size_t)(m * 16) * lda + k0);
#pragma unroll
            for (int n = 0; n < 4; ++n) b[n] = *(const bf16x8*)(bp + (size_t)(n * 16) * ldb + k0);
#pragma unroll
            for (int m = 0; m < 2; ++m)
#pragma unroll
                for (int n = 0; n < 4; ++n) acc[m][n] = __builtin_amdgcn_mfma_f32_16x16x32_bf16(a[m], b[n], acc[m][n], 0, 0, 0);
        }
#pragma unroll
        for (int m = 0; m < 2; ++m)
#pragma unroll
            for (int n = 0; n < 4; ++n)
#pragma unroll
                for (int j = 0; j < 4; ++j) E(r0 + m * 16 + (lane >> 4) * 4 + j, c0 + n * 16 + (lane & 15), acc[m][n][j]);
    }
}

struct EpiProjN {
    bf16 *SBQ, *G0, *G2;
    __device__ __forceinline__ void operator()(int row, int n, float v) const {
        const int pn = n >> 8, j = n & 255;
        if (pn < 12) { const int T = pn >> 1, bj = j >> 7, wc = (j >> 5) & 3, e = j & 31, c = ((pn & 1) * 4 + wc) * 64 + bj * 32 + e;
            if (T == 0) v *= C2;
            (SBQ + (size_t)T * M * DH)[(size_t)row * DH + c] = (bf16)f2bf(v); }
        else if (pn < 14) { (SBQ + (size_t)6 * M * DH)[(size_t)row * DH + (n - 12 * 256)] = (bf16)f2bf(v); }
        else { const int g = (pn - 14) >> 2, c = n - (14 + 4 * g) * 256; bf16* G = g < 2 ? G0 + (size_t)g * M * D : G2;
            G[(size_t)row * D + c] = (bf16)f2bf(1.0f / (1.0f + expf(-v))); }
    }
};
struct EpiMkvN { float* MKf; bf16* MV;
    __device__ __forceinline__ void operator()(int row, int n, float v) const { if (n < DH) MKf[(size_t)row * DH + n] = v; else MV[(size_t)row * DH + (n - DH)] = (bf16)f2bf(v); } };
struct EpiOutN { const float* x; float* x1; bf16* A2;
    __device__ __forceinline__ void operator()(int row, int n, float v) const { const size_t o = (size_t)row * D + n; const float r = x[o] + v; A2[o] = (bf16)f2bf(r); } };
struct EpiUpN { const float* ssq; bf16* U;
    __device__ __forceinline__ void operator()(int row, int n, float v) const {
        const f32x4* p = (const f32x4*)(ssq + (size_t)row * 16); const f32x4 a = p[0], b = p[1], c = p[2], d = p[3];
        const float ss = ((a.x + a.y) + (a.z + a.w)) + ((b.x + b.y) + (b.z + b.w)) + ((c.x + c.y) + (c.z + c.w)) + ((d.x + d.y) + (d.z + d.w));
        (void)ss; const float r = fmaxf(v, 0.f); U[(size_t)row * FF + n] = (bf16)f2bf(r * r); } };
struct EpiDnN { float* out; const float* ssq; const bf16* A2;
    __device__ __forceinline__ void operator()(int row, int n, float v) const { const size_t o = (size_t)row * D + n;
        const f32x4* p = (const f32x4*)(ssq + (size_t)row * 16); const f32x4 a = p[0], b = p[1], c = p[2], d = p[3];
        const float ss = ((a.x + a.y) + (a.z + a.w)) + ((b.x + b.y) + (b.z + b.w)) + ((c.x + c.y) + (c.z + c.w)) + ((d.x + d.y) + (d.z + d.w));
        out[o] = bf2f(A2[o]) + v / (ss * (1.f / D) + EPS); } };

__device__ __forceinline__ void fcumsum(Frame& F) {
    const int gw = F.vcu * NWAVES + F.wave;
    if (gw >= BATCH * NH) return;
    const int b = gw >> 3, h = gw & 7;
    const float* src = F.logf + ((size_t)b * SEQ + 32 * F.lane) * 8 + h;
    float v[32], tot = 0.f;
#pragma unroll
    for (int i = 0; i < 32; ++i) v[i] = src[i * 8];
#pragma unroll
    for (int i = 0; i < 32; ++i) tot += v[i];
    float incl = tot;
#pragma unroll
    for (int off = 1; off < 64; off <<= 1) { const float y = __shfl_up(incl, off); if (F.lane >= off) incl += y; }
    float run = incl - tot;
    float* dst = F.FC + (size_t)gw * SEQ + 32 * F.lane;
#pragma unroll
    for (int i = 0; i < 32; i += 4) { f32x4 o; run += v[i]; o.x = run; run += v[i + 1]; o.y = run; run += v[i + 2]; o.z = run; run += v[i + 3]; o.w = run; *(f32x4*)(dst + i) = o; }
}

__device__ __forceinline__ void headnorm_naive(Frame& F) {
    const int gw = F.vcu * NWAVES + F.wave, NGW = F.G * NWAVES;
    for (int it = gw; it < 2 * M; it += NGW) {
        const int which = it / M, row = it % M;
        bf16* p = F.FXQ + (size_t)which * M * DH + (size_t)row * DH + 8 * F.lane;
        const v4u w = *(const v4u*)p; float v[8] = {bflo(w.x), bfhi(w.x), bflo(w.y), bfhi(w.y), bflo(w.z), bfhi(w.z), bflo(w.w), bfhi(w.w)};
        float s = 0.f;
#pragma unroll
        for (int i = 0; i < 8; ++i) s += v[i] * v[i];
        s += __shfl_xor(s, 1); s += __shfl_xor(s, 2); s += __shfl_xor(s, 4);
        const float sc = (1.0f / sqrtf(s * (1.f / HD) + EPS)) * (which == 0 ? C2 : 1.0f);
#pragma unroll
        for (int i = 0; i < 8; ++i) v[i] = v[i] * sc;
        v4u o; o.x = pk2(v[0], v[1]); o.y = pk2(v[2], v[3]); o.z = pk2(v[4], v[5]); o.w = pk2(v[6], v[7]);
        *(v4u*)p = o;
    }
}

template <int MODE>
__device__ __forceinline__ void nattn64(const bf16* Q, const bf16* K, const bf16* V, bf16* O, const float* FC, const float* gq, const float* gk, int wg, int nwg) {
    const int tid = threadIdx.x, half = tid & 1;
    for (int u = wg; u < 512; u += nwg) {
        const int b = u >> 6, h = (u >> 3) & 7, blk = u & 7, t = blk * 256 + (tid >> 1); const size_t row = (size_t)b * SEQ + t;
        float q[32], o[32];
        { const v4u* qp = (const v4u*)(Q + row * DH + h * HD + half * 32);
#pragma unroll
          for (int i = 0; i < 4; ++i) { const v4u w = qp[i]; q[8 * i] = bflo(w.x); q[8 * i + 1] = bfhi(w.x); q[8 * i + 2] = bflo(w.y); q[8 * i + 3] = bfhi(w.y); q[8 * i + 4] = bflo(w.z); q[8 * i + 5] = bfhi(w.z); q[8 * i + 6] = bflo(w.w); q[8 * i + 7] = bfhi(w.w); } }
        if (MODE == 1) {
#pragma unroll
            for (int d = 0; d < 32; ++d) q[d] *= gq[half * 32 + d] * gk[half * 32 + d]; }
#pragma unroll
        for (int d = 0; d < 32; ++d) o[d] = 0.f;
        const int kend = blk * 256 + 256;
        const bf16* Kb = K + (size_t)b * SEQ * DH + h * HD + half * 32; const bf16* Vb = V + (size_t)b * SEQ * DH + h * HD + half * 32;
        const float* Fs = FC + (size_t)(b * NH + h) * SEQ;
        float carry = 0.f, mrun = -1e30f, lrun = 0.f;
        for (int i = 0; i < kend; ++i) {
            const int s = MODE == 0 ? kend - 1 - i : i;
            const v4u* kp = (const v4u*)(Kb + (size_t)s * DH); const v4u* vp = (const v4u*)(Vb + (size_t)s * DH);
            float z = 0.f;
#pragma unroll
            for (int c = 0; c < 4; ++c) { const v4u w = kp[c];
                z += q[8 * c] * bflo(w.x) + q[8 * c + 1] * bfhi(w.x) + q[8 * c + 2] * bflo(w.y) + q[8 * c + 3] * bfhi(w.y) + q[8 * c + 4] * bflo(w.z) + q[8 * c + 5] * bfhi(w.z) + q[8 * c + 6] * bflo(w.w) + q[8 * c + 7] * bfhi(w.w); }
            z += __shfl_xor(z, 1);
            float wgt;
            if (MODE == 0) {
                const float zn = z * LN2; const bool strict = s < t;
                const float lr = log_sigmoid_f(-zn), ls = zn + lr;
                wgt = strict ? expf(ls + carry) : 0.f; carry += strict ? lr : 0.f;
            } else {
                const float z2 = (s <= t) ? z - Fs[s] * LOG2E : -1e30f;
                const float mn = fmaxf(mrun, z2), al = exp2f(mrun - mn); wgt = (s <= t) ? exp2f(z2 - mn) : 0.f;
                lrun = lrun * al + wgt; mrun = mn;
#pragma unroll
                for (int d = 0; d < 32; ++d) o[d] *= al;
            }
#pragma unroll
            for (int c = 0; c < 4; ++c) { const v4u w = vp[c];
                o[8 * c] += wgt * bflo(w.x); o[8 * c + 1] += wgt * bfhi(w.x); o[8 * c + 2] += wgt * bflo(w.y); o[8 * c + 3] += wgt * bfhi(w.y); o[8 * c + 4] += wgt * bflo(w.z); o[8 * c + 5] += wgt * bfhi(w.z); o[8 * c + 6] += wgt * bflo(w.w); o[8 * c + 7] += wgt * bfhi(w.w); }
        }
        const float inv = MODE == 0 ? 1.0f : 1.0f / lrun;
        v4u* op = (v4u*)(O + row * DH + h * HD + half * 32);
#pragma unroll
        for (int i = 0; i < 4; ++i) { v4u w; w.x = pk2(o[8 * i] * inv, o[8 * i + 1] * inv); w.y = pk2(o[8 * i + 2] * inv, o[8 * i + 3] * inv); w.z = pk2(o[8 * i + 4] * inv, o[8 * i + 5] * inv); w.w = pk2(o[8 * i + 6] * inv, o[8 * i + 7] * inv); op[i] = w; }
    }
}
__device__ __forceinline__ void nattn_mem(Frame& F, int wg, int nwg) {
    const int tid = threadIdx.x, qt = tid & 3;
    for (int u = wg; u < 512; u += nwg) {
        const int b = u >> 6, hm = (u >> 4) & 3, blk = u & 15, t = blk * 128 + (tid >> 2); const size_t row = (size_t)b * SEQ + t;
        float q[32], o[32];
        { const v4u* qp = (const v4u*)(F.MQ + row * DH + hm * MHD + qt * 32);
#pragma unroll
          for (int i = 0; i < 4; ++i) { const v4u w = qp[i]; q[8 * i] = bflo(w.x); q[8 * i + 1] = bfhi(w.x); q[8 * i + 2] = bflo(w.y); q[8 * i + 3] = bfhi(w.y); q[8 * i + 4] = bflo(w.z); q[8 * i + 5] = bfhi(w.z); q[8 * i + 6] = bflo(w.w); q[8 * i + 7] = bfhi(w.w); } }
        float ss = 0.f;
#pragma unroll
        for (int d = 0; d < 32; ++d) ss += q[d] * q[d];
        ss += __shfl_xor(ss, 1); ss += __shfl_xor(ss, 2);
        const float rq = (1.0f / sqrtf(ss * (1.f / MHD) + EPS)) * C2M;
#pragma unroll
        for (int d = 0; d < 32; ++d) { q[d] = q[d] * rq * F.g_mq[qt * 32 + d] * F.g_mk[qt * 32 + d]; o[d] = 0.f; }
        float mrun = -1e30f, lrun = 0.f;
        for (int key = 0; key < MEMLEN; ++key) {
            const f32x4* kp = (const f32x4*)(F.MKf + (size_t)(b * MEMLEN + key) * DH + hm * MHD + qt * 32);
            const v4u* vp = (const v4u*)(F.MV + (size_t)(b * MEMLEN + key) * DH + hm * MHD + qt * 32);
            float dot = 0.f, kss = 0.f;
#pragma unroll
            for (int c = 0; c < 8; ++c) { const f32x4 k4 = kp[c]; dot += q[4 * c] * k4.x + q[4 * c + 1] * k4.y + q[4 * c + 2] * k4.z + q[4 * c + 3] * k4.w; kss += k4.x * k4.x + k4.y * k4.y + k4.z * k4.z + k4.w * k4.w; }
            dot += __shfl_xor(dot, 1); dot += __shfl_xor(dot, 2); kss += __shfl_xor(kss, 1); kss += __shfl_xor(kss, 2);
            const float z2 = dot * (1.0f / sqrtf(kss * (1.f / MHD) + EPS));
            const float mn = fmaxf(mrun, z2), al = exp2f(mrun - mn), wgt = exp2f(z2 - mn);
            lrun = lrun * al + wgt; mrun = mn;
#pragma unroll
            for (int c = 0; c < 4; ++c) { const v4u w = vp[c];
                o[8 * c] = o[8 * c] * al + wgt * bflo(w.x); o[8 * c + 1] = o[8 * c + 1] * al + wgt * bfhi(w.x); o[8 * c + 2] = o[8 * c + 2] * al + wgt * bflo(w.y); o[8 * c + 3] = o[8 * c + 3] * al + wgt * bfhi(w.y);
                o[8 * c + 4] = o[8 * c + 4] * al + wgt * bflo(w.z); o[8 * c + 5] = o[8 * c + 5] * al + wgt * bfhi(w.z); o[8 * c + 6] = o[8 * c + 6] * al + wgt * bflo(w.w); o[8 * c + 7] = o[8 * c + 7] * al + wgt * bfhi(w.w); }
        }
        const float inv = 1.0f / lrun;
        v4u* op = (v4u*)(F.MQ + row * DH + hm * MHD + qt * 32);
#pragma unroll
        for (int i = 0; i < 4; ++i) { v4u w; w.x = pk2(o[8 * i] * inv, o[8 * i + 1] * inv); w.y = pk2(o[8 * i + 2] * inv, o[8 * i + 3] * inv); w.z = pk2(o[8 * i + 4] * inv, o[8 * i + 5] * inv); w.w = pk2(o[8 * i + 6] * inv, o[8 * i + 7] * inv); op[i] = w; }
    }
}

__device__ __forceinline__ void nmerged(Frame& F, int wg, int nwg) {
    const int tid = threadIdx.x, lane = tid & 63, wid = tid >> 6, wm = wid >> 1, wn = wid & 1;
    const int tilesN = D / 128, ntiles = (M / 128) * tilesN;
    for (int t = wg; t < ntiles; t += nwg) {
        const int tm = t / tilesN, tn = t % tilesN, r0 = tm * 128 + wm * 32, c0 = tn * 128 + wn * 64;
        f32x4 tot[2][4];
#pragma unroll
        for (int m = 0; m < 2; ++m)
#pragma unroll
            for (int n = 0; n < 4; ++n) tot[m][n] = (f32x4){0.f, 0.f, 0.f, 0.f};
#pragma unroll 1
        for (int br = 0; br < 3; ++br) {
            const bf16* A = F.SBQ + (size_t)br * 3 * M * DH; const bf16* Bt = F.Wbr_t + (size_t)br * D * DH; const bf16* G = br < 2 ? F.G0 + (size_t)br * M * D : F.G2;
            f32x4 acc[2][4];
#pragma unroll
            for (int m = 0; m < 2; ++m)
#pragma unroll
                for (int n = 0; n < 4; ++n) acc[m][n] = (f32x4){0.f, 0.f, 0.f, 0.f};
            const bf16* ap = A + (size_t)(r0 + (lane & 15)) * DH + 8 * (lane >> 4);
            const bf16* bp = Bt + (size_t)(c0 + (lane & 15)) * DH + 8 * (lane >> 4);
            for (int k0 = 0; k0 < DH; k0 += 32) {
                bf16x8 a[2], b[4];
#pragma unroll
                for (int m = 0; m < 2; ++m) a[m] = *(const bf16x8*)(ap + (size_t)(m * 16) * DH + k0);
#pragma unroll
                for (int n = 0; n < 4; ++n) b[n] = *(const bf16x8*)(bp + (size_t)(n * 16) * DH + k0);
#pragma unroll
                for (int m = 0; m < 2; ++m)
#pragma unroll
                    for (int n = 0; n < 4; ++n) acc[m][n] = __builtin_amdgcn_mfma_f32_16x16x32_bf16(a[m], b[n], acc[m][n], 0, 0, 0);
            }
#pragma unroll
            for (int m = 0; m < 2; ++m)
#pragma unroll
                for (int n = 0; n < 4; ++n)
#pragma unroll
                    for (int j = 0; j < 4; ++j) tot[m][n][j] += bf2f(G[(size_t)(r0 + m * 16 + (lane >> 4) * 4 + j) * D + c0 + n * 16 + (lane & 15)]) * acc[m][n][j];
        }
#pragma unroll
        for (int m = 0; m < 2; ++m)
#pragma unroll
            for (int n = 0; n < 4; ++n)
#pragma unroll
                for (int j = 0; j < 4; ++j) F.MRG[(size_t)(r0 + m * 16 + (lane >> 4) * 4 + j) * D + c0 + n * 16 + (lane & 15)] = (bf16)f2bf(tot[m][n][j]);
    }
}
__device__ __forceinline__ void ssq_naive(Frame& F) {
    const int gw = F.vcu * NWAVES + F.wave, NGW = F.G * NWAVES;
    for (int m = gw; m < M; m += NGW) {
        const GAS v4u* xr = (const GAS v4u*)(F.XN + (size_t)m * D) + F.lane; float s = 0.f;
#pragma unroll
        for (int j = 0; j < 2; ++j) { const v4u w = xr[64 * j]; const float a0 = bflo(w.x), a1 = bfhi(w.x), a2 = bflo(w.y), a3 = bfhi(w.y), a4 = bflo(w.z), a5 = bfhi(w.z), a6 = bflo(w.w), a7 = bfhi(w.w);
            s += (a0 * a0 + a1 * a1) + (a2 * a2 + a3 * a3) + (a4 * a4 + a5 * a5) + (a6 * a6 + a7 * a7); }
        s = wave_sum(s);
        if (F.lane < 16) F.ssq[(size_t)m * 16 + F.lane] = F.lane == 0 ? s : 0.f;
    }
}

namespace pg8 {
#define PG8_LAS __attribute__((address_space(3)))
typedef unsigned short bf16_t;
typedef unsigned u32x4 __attribute__((ext_vector_type(4)));
typedef unsigned u32x2 __attribute__((ext_vector_type(2)));
constexpr int BM = 256, BK = 64, HALF = 128, HTB = HALF * BK * 2, STAGE_BYTES = 8 * HTB, NXCD = 8, WGM = 4;
__host__ __device__ __forceinline__ int lds_byte(int r, int c) { const int st = (r >> 4) * 2 + (c >> 5), rr = r & 15, cc = c & 31, ob = rr * 64 + cc * 2; return st * 1024 + (ob ^ (((ob >> 9) & 1) << 5)); }
__host__ __device__ __forceinline__ void stage_rc(int b, int& R, int& C) { const int st = b / 1024, sb = b % 1024, swz = sb ^ (((sb >> 9) & 1) << 5); R = (st >> 1) * 16 + swz / 64; C = (st & 1) * 32 + (swz % 64) / 2; }
__host__ __device__ __forceinline__ int perm32(int rho) { const int n = rho >> 4, i = rho & 15; return 8 * (i >> 2) + 4 * n + (i & 3); }
struct Unit { int pm, pn, br; };
typedef float f32x2c __attribute__((ext_vector_type(2))); typedef __bf16 bf16x2c __attribute__((ext_vector_type(2)));
__device__ __forceinline__ unsigned cvt_pk_bf16(float lo, float hi) { f32x2c v = {lo, hi}; bf16x2c b = __builtin_convertvector(v, bf16x2c); return __builtin_bit_cast(unsigned, b); }
__device__ __forceinline__ float bflo(unsigned w) { return __uint_as_float(w << 16); }
__device__ __forceinline__ float bfhi(unsigned w) { return __uint_as_float(w & 0xffff0000u); }

__device__ __forceinline__ float xsum16(float v) { auto r = __builtin_amdgcn_permlane16_swap(__float_as_uint(v), __float_as_uint(v), false, false); return __uint_as_float(r[0]) + __uint_as_float(r[1]); }
__device__ __forceinline__ float xsum32(float v) { auto r = __builtin_amdgcn_permlane32_swap(__float_as_uint(v), __float_as_uint(v), false, false); return __uint_as_float(r[0]) + __uint_as_float(r[1]); }
__device__ __forceinline__ void static_tile(int L, int nM, int nN, int& pm, int& pn) {
    const int nwg = nM * nN; int wgid = L;
    { const int q = nwg / NXCD, r = nwg % NXCD, xcd = wgid % NXCD, off = wgid / NXCD; wgid = (xcd < r ? xcd * (q + 1) : r * (q + 1) + (xcd - r) * q) + off; }
    const int nig = WGM * nN, gid = wgid / nig, fm = gid * WGM, gsz = (nM - fm) < WGM ? (nM - fm) : WGM;
    pm = fm + ((wgid % nig) % gsz); pn = (wgid % nig) / gsz;
}
struct SchedPlain {
    int nM, nN, G, c; const char* A; const char* B; size_t tstep;
    __device__ __forceinline__ bool next(int i, Unit& u) const { const long L = (long)i * G + c; if (L >= (long)nM * nN) return false; static_tile((int)L, nM, nN, u.pm, u.pn); u.br = 0; return true; }
    __device__ __forceinline__ const char* a_ptr(const Unit& u) const { return A + (size_t)u.pm * tstep; }
    __device__ __forceinline__ const char* b_ptr(const Unit& u) const { return B + (size_t)u.pn * tstep; }
    __device__ __forceinline__ void a_ready(const Unit&) const {}
    __device__ __forceinline__ void done(const Unit&) const {}
};
struct SchedP1 {
    int G, c; const char* A; const char* B;
    __device__ __forceinline__ bool next(int i, Unit& u) const {
        if (G == 256 && c >= 128 && c < 160) { if (i == 0) { const int j = c - 128; u.pm = 64 + (j & 7); u.pn = 26 + (j >> 3); u.br = 0; return true; }
            if (i > 6) return false; static_tile((i - 1) * G + c, 64, 26, u.pm, u.pn); u.br = 0; return true; }
        const long L = (long)i * G + c; if (L >= 1696) return false;
        if (L < 1664) static_tile((int)L, 64, 26, u.pm, u.pn); else { const int r = (int)L - 1664; u.pm = 64 + (r >> 2); u.pn = 26 + (r & 3); } u.br = 0; return true; }
    __device__ __forceinline__ const char* a_ptr(const Unit& u) const { return A + (size_t)u.pm * (256 * 1024 * 2); }
    __device__ __forceinline__ const char* b_ptr(const Unit& u) const { return B + (size_t)u.pn * (256 * 1024 * 2); }
    __device__ __forceinline__ void a_ready(const Unit&) const {}
    __device__ __forceinline__ void done(const Unit&) const {}
};
struct SchedP3 {
    int G, c; const char* A; const char* B; int br;
    __device__ __forceinline__ bool next(int i, Unit& u) const { if (i >= 1 || c >= 256) return false; static_tile(c, 64, 4, u.pm, u.pn); u.br = br; return true; }
    __device__ __forceinline__ const char* a_ptr(const Unit& u) const { return A + (size_t)u.br * ((size_t)3 * M * DH * 2) + (size_t)u.pm * (256 * 512 * 2); }
    __device__ __forceinline__ const char* b_ptr(const Unit& u) const { return B + (size_t)u.br * ((size_t)D * DH * 2) + (size_t)u.pn * (256 * 512 * 2); }
    __device__ __forceinline__ void a_ready(const Unit&) const {}
    __device__ __forceinline__ void done(const Unit&) const {}
};

struct SchedP3m {
    int G, c; const char* A; const char* B;
    __device__ __forceinline__ bool next(int i, Unit& u) const { if (i >= 3 || c >= 256) return false; static_tile(c, 64, 4, u.pm, u.pn); u.br = i; return true; }
    __device__ __forceinline__ const char* a_ptr(const Unit& u) const { return A + (size_t)u.br * ((size_t)3 * M * DH * 2) + (size_t)u.pm * (256 * 512 * 2); }
    __device__ __forceinline__ const char* b_ptr(const Unit& u) const { return B + (size_t)u.br * ((size_t)D * DH * 2) + (size_t)u.pn * (256 * 512 * 2); }
    __device__ __forceinline__ void a_ready(const Unit&) const {}
    __device__ __forceinline__ void done(const Unit&) const {}
};
typedef f32x4 acc_t[2][2][4][2];
__device__ __forceinline__ u32x4 pack8(const f32x4 a, const f32x4 b) { u32x4 w; w.x = cvt_pk_bf16(a[0], a[1]); w.y = cvt_pk_bf16(a[2], a[3]); w.z = cvt_pk_bf16(b[0], b[1]); w.w = cvt_pk_bf16(b[2], b[3]); return w; }
__device__ __forceinline__ float sigm(float x) { return __builtin_amdgcn_rcpf(1.0f + __builtin_amdgcn_exp2f(x)); }

struct EpiProj {
    static constexpr bool PERM = true, AFTER_DRAIN = false, KEEP_ACC = false, PERM64 = false;
    bf16_t* SBQ; bf16_t* G0; bf16_t* G2; float* MKf; bf16_t* MV;
    __device__ __forceinline__ void operator()(const acc_t& acc, const Unit& u, int wr, int wc, int fr, int fq) const { run(acc, u, wr, wc, fr, fq, 0, 2); }
    __device__ __forceinline__ void half(const acc_t& acc, const Unit& u, int wr, int wc, int fr, int fq, const int ai) const { run(acc, u, wr, wc, fr, fq, ai, ai + 1); }
    __device__ __forceinline__ void run(const acc_t& acc, const Unit& u, int wr, int wc, int fr, int fq, const int A0, const int A1) const {
        const int pn = u.pn; const int row0 = u.pm * BM + wr * 64 + fr;
        if (pn < 12) {
            const int T = pn >> 1, hd = (pn & 1) * 4 + wc;
            bf16_t* base = SBQ + (size_t)T * M * DH + (size_t)row0 * DH + hd * 64 + 8 * fq;
            if (T == 3 || T == 4) {
                const float qs = T == 3 ? C2 : 1.0f;
#pragma unroll
                for (int ai = A0; ai < A1; ++ai)
#pragma unroll
                    for (int m = 0; m < 4; ++m) {
                        float ss = 0.f;
#pragma unroll
                        for (int bj = 0; bj < 2; ++bj)
#pragma unroll
                            for (int n = 0; n < 2; ++n) { const f32x4 x = acc[ai][bj][m][n]; ss += (x[0] * x[0] + x[1] * x[1]) + (x[2] * x[2] + x[3] * x[3]); }
                        ss = xsum16(ss); ss = xsum32(ss);
                        const float sc = qs * __builtin_amdgcn_rsqf(ss * (1.0f / HD) + EPS);
                        bf16_t* rowp = base + (size_t)(ai * HALF + m * 16) * DH;
#pragma unroll
                        for (int bj = 0; bj < 2; ++bj) *(u32x4*)(rowp + 32 * bj) = pack8(acc[ai][bj][m][0] * sc, acc[ai][bj][m][1] * sc);
                    }
            } else {
                const float sc = T == 0 ? C2 : 1.0f;
#pragma unroll
                for (int ai = A0; ai < A1; ++ai)
#pragma unroll
                    for (int m = 0; m < 4; ++m) { bf16_t* rowp = base + (size_t)(ai * HALF + m * 16) * DH;
#pragma unroll
                        for (int bj = 0; bj < 2; ++bj) *(u32x4*)(rowp + 32 * bj) = pack8(acc[ai][bj][m][0] * sc, acc[ai][bj][m][1] * sc); }
            }
        } else if (pn < 14) {
            bf16_t* base = SBQ + (size_t)6 * M * DH + (size_t)row0 * DH + (pn - 12) * 256 + wc * 64 + 8 * fq;
#pragma unroll
            for (int ai = A0; ai < A1; ++ai)
#pragma unroll
                for (int m = 0; m < 4; ++m) { bf16_t* rowp = base + (size_t)(ai * HALF + m * 16) * DH;
#pragma unroll
                    for (int bj = 0; bj < 2; ++bj) *(u32x4*)(rowp + 32 * bj) = pack8(acc[ai][bj][m][0], acc[ai][bj][m][1]); }
        } else if (pn < 26) {
            const int g = (pn - 14) >> 2; bf16_t* G = g < 2 ? G0 + (size_t)g * M * D : G2;
            bf16_t* base = G + (size_t)row0 * D + ((pn - 14) & 3) * 256 + wc * 64 + 8 * fq;
#pragma unroll
            for (int ai = A0; ai < A1; ++ai)
#pragma unroll
                for (int m = 0; m < 4; ++m) { bf16_t* rowp = base + (size_t)(ai * HALF + m * 16) * D;
#pragma unroll
                    for (int bj = 0; bj < 2; ++bj) { f32x4 a = acc[ai][bj][m][0], b = acc[ai][bj][m][1];
#pragma unroll
                        for (int e = 0; e < 4; ++e) { a[e] = sigm(a[e]); b[e] = sigm(b[e]); }
                        *(u32x4*)(rowp + 32 * bj) = pack8(a, b); } }
        } else {
            const int mrow0 = (u.pm - 64) * BM + wr * 64 + fr, pl = pn - 26;
            if (pl < 2) { float* base = MKf + (size_t)mrow0 * DH + pl * 256 + wc * 32 + 8 * fq;
#pragma unroll
                for (int ai = A0; ai < A1; ++ai)
#pragma unroll
                    for (int m = 0; m < 4; ++m) { float* rowp = base + (size_t)(ai * HALF + m * 16) * DH;
#pragma unroll
                        for (int bj = 0; bj < 2; ++bj) { *(f32x4*)(rowp + HALF * bj) = acc[ai][bj][m][0]; *(f32x4*)(rowp + HALF * bj + 4) = acc[ai][bj][m][1]; } }
            } else { bf16_t* base = MV + (size_t)mrow0 * DH + (pl - 2) * 256 + wc * 32 + 8 * fq;
#pragma unroll
                for (int ai = A0; ai < A1; ++ai)
#pragma unroll
                    for (int m = 0; m < 4; ++m) { bf16_t* rowp = base + (size_t)(ai * HALF + m * 16) * DH;
#pragma unroll
                        for (int bj = 0; bj < 2; ++bj) *(u32x4*)(rowp + HALF * bj) = pack8(acc[ai][bj][m][0], acc[ai][bj][m][1]); } }
        }
    }
};
__device__ __forceinline__ float clampg(unsigned bits) { return __uint_as_float(bits > 0x0da24260u ? bits : 0x0da24260u); }
struct EpiMerged {
    static constexpr bool PERM = true, AFTER_DRAIN = true, KEEP_ACC = false, PERM64 = false;
    const bf16_t* G0; const bf16_t* G2; bf16_t* MRG;
    __device__ __forceinline__ void fused(const acc_t& acc, const Unit& u, int wr, int wc, int fr, int fq, PG8_LAS unsigned char*, int, int) const {
        const int br = u.br; const int row0 = u.pm * BM + wr * 64 + fr, col0 = u.pn * BM + wc * 32 + 8 * fq;
        const bf16_t* G = (br < 2 ? G0 + (size_t)br * M * D : G2) + (size_t)row0 * D + col0;
        bf16_t* O = MRG + (size_t)row0 * D + col0;
#pragma unroll
        for (int ai = 0; ai < 2; ++ai)
#pragma unroll
            for (int m = 0; m < 4; ++m) { const size_t ro = (size_t)(ai * HALF + m * 16);
#pragma unroll
                for (int bj = 0; bj < 2; ++bj) {
                    const u32x4 gw = *(const u32x4*)(G + ro * D + HALF * bj);
                    f32x4 a = acc[ai][bj][m][0], b = acc[ai][bj][m][1];
                    a[0] *= bflo(gw.x); a[1] *= bfhi(gw.x); a[2] *= bflo(gw.y); a[3] *= bfhi(gw.y); b[0] *= bflo(gw.z); b[1] *= bfhi(gw.z); b[2] *= bflo(gw.w); b[3] *= bfhi(gw.w);
                    bf16_t* tp = O + ro * D + HALF * bj;
                    if (br > 0) { const u32x4 t = *(const u32x4*)tp; a[0] += bflo(t.x); a[1] += bfhi(t.x); a[2] += bflo(t.y); a[3] += bfhi(t.y); b[0] += bflo(t.z); b[1] += bfhi(t.z); b[2] += bflo(t.w); b[3] += bfhi(t.w); }
                    *(u32x4*)tp = pack8(a, b);
                }
                if (m & 1) asm volatile("" ::: "memory"); }
    }
};
struct EpiMergedR {
    static constexpr bool PERM = true, AFTER_DRAIN = false, KEEP_ACC = true, PERM64 = false;
    const bf16_t* G0; const bf16_t* G2; bf16_t* MRG;
    __device__ __forceinline__ void operator()(acc_t& acc, const Unit& u, int wr, int wc, int fr, int fq) const {
        const int br = u.br; const size_t base = (size_t)(u.pm * BM + wr * 64 + fr) * D + u.pn * BM + wc * 32 + 8 * fq;
        const bf16_t* Ga = (br < 2 ? G0 + (size_t)br * M * D : G2) + base;
        const bf16_t* Gb = (br == 0 ? G0 + (size_t)M * D : G2) + base;
        bf16_t* O = MRG + base;
#pragma unroll
        for (int ai = 0; ai < 2; ++ai) {
            u32x4 ga[4][2], gb[4][2];
#pragma unroll
            for (int m = 0; m < 4; ++m)
#pragma unroll
                for (int bj = 0; bj < 2; ++bj) { const size_t o = (size_t)(ai * HALF + m * 16) * D + HALF * bj; ga[m][bj] = *(const u32x4*)(Ga + o); if (br < 2) gb[m][bj] = *(const u32x4*)(Gb + o); }
#pragma unroll
            for (int m = 0; m < 4; ++m)
#pragma unroll
                for (int bj = 0; bj < 2; ++bj) {
                    const u32x4 a = ga[m][bj]; float f[8] = {clampg(a.x << 16), clampg(a.x & 0xffff0000u), clampg(a.y << 16), clampg(a.y & 0xffff0000u), clampg(a.z << 16), clampg(a.z & 0xffff0000u), clampg(a.w << 16), clampg(a.w & 0xffff0000u)};
                    if (br < 2) { const u32x4 b = gb[m][bj]; const float d[8] = {clampg(b.x << 16), clampg(b.x & 0xffff0000u), clampg(b.y << 16), clampg(b.y & 0xffff0000u), clampg(b.z << 16), clampg(b.z & 0xffff0000u), clampg(b.w << 16), clampg(b.w & 0xffff0000u)};
#pragma unroll
                        for (int e = 0; e < 8; ++e) f[e] *= __builtin_amdgcn_rcpf(d[e]); }
                    f32x4 x0 = acc[ai][bj][m][0], x1 = acc[ai][bj][m][1];
                    x0[0] *= f[0]; x0[1] *= f[1]; x0[2] *= f[2]; x0[3] *= f[3]; x1[0] *= f[4]; x1[1] *= f[5]; x1[2] *= f[6]; x1[3] *= f[7];
                    if (br < 2) { acc[ai][bj][m][0] = x0; acc[ai][bj][m][1] = x1; }
                    else *(u32x4*)(O + (size_t)(ai * HALF + m * 16) * D + HALF * bj) = pack8(x0, x1);
                }
            asm volatile("" ::: "memory");
        }
    }
};
struct EpiOut {
    static constexpr bool PERM = true, AFTER_DRAIN = true, KEEP_ACC = false, PERM64 = false;
    const float* x; float* x1; bf16_t* A2; float* ssq;
    __device__ __forceinline__ void fused(const acc_t& acc, const Unit& u, int wr, int wc, int fr, int fq, PG8_LAS unsigned char* lds, int, int) const {
        PG8_LAS float* red = (PG8_LAS float*)lds;
        const int row0 = u.pm * BM + wr * 64 + fr, col0 = u.pn * BM + wc * 32 + 8 * fq;
#pragma unroll
        for (int ai = 0; ai < 2; ++ai)
#pragma unroll
            for (int m = 0; m < 4; ++m) { const int row = row0 + ai * HALF + m * 16; const size_t off = (size_t)row * D + col0; float ss = 0.f;
#pragma unroll
                for (int bj = 0; bj < 2; ++bj) { const size_t o = off + bj * HALF;
                    const f32x4 r0 = __builtin_nontemporal_load((const f32x4*)(x + o)) + acc[ai][bj][m][0], r1 = __builtin_nontemporal_load((const f32x4*)(x + o + 4)) + acc[ai][bj][m][1];
                    u32x4 w; w.x = cvt_pk_bf16(r0[0], r0[1]); w.y = cvt_pk_bf16(r0[2], r0[3]); w.z = cvt_pk_bf16(r1[0], r1[1]); w.w = cvt_pk_bf16(r1[2], r1[3]); *(u32x4*)(A2 + o) = w;
                    const float q0 = bflo(w.x), q1 = bfhi(w.x), q2 = bflo(w.y), q3 = bfhi(w.y), q4 = bflo(w.z), q5 = bfhi(w.z), q6 = bflo(w.w), q7 = bfhi(w.w);
                    ss += ((q0 * q0 + q1 * q1) + (q2 * q2 + q3 * q3)) + ((q4 * q4 + q5 * q5) + (q6 * q6 + q7 * q7)); }
                ss = xsum16(ss); ss = xsum32(ss);
                if (fq == 0) red[(ai * HALF + wr * 64 + m * 16 + fr) * 4 + wc] = ss;
                if (m & 1) asm volatile("" ::: "memory"); }
        __syncthreads();
        if (threadIdx.x < 256) { const f32x4 p = *(const PG8_LAS f32x4*)(red + threadIdx.x * 4); ssq[(size_t)(u.pm * BM + threadIdx.x) * 4 + u.pn] = (p.x + p.y) + (p.z + p.w); }
    }
};
struct EpiUp {
    static constexpr bool PERM = true, AFTER_DRAIN = false, KEEP_ACC = false, PERM64 = true;
    bf16_t* U;
    __device__ __forceinline__ void operator()(const acc_t& acc, const Unit& u, int wr, int wc, int fr, int fq) const { run(acc, u, wr, wc, fr, fq, 0, 2); }
    __device__ __forceinline__ void half(const acc_t& acc, const Unit& u, int wr, int wc, int fr, int fq, const int ai) const { run(acc, u, wr, wc, fr, fq, ai, ai + 1); }
    __device__ __forceinline__ void run(const acc_t& acc, const Unit& u, int wr, int wc, int fr, int fq, const int A0, const int A1) const {
        const char* ub = (const char*)(U + (size_t)(u.pm * BM + wr * 64) * FF + u.pn * BM + wc * 64); const unsigned lo = (unsigned)(fr * FF + 8 * fq) * 2u;
#pragma unroll
        for (int ai = A0; ai < A1; ++ai)
#pragma unroll
            for (int m = 0; m < 4; ++m) { char* rowp = (char*)ub + (size_t)(ai * HALF + m * 16) * FF * 2;
#pragma unroll
                for (int bj = 0; bj < 2; ++bj) { f32x4 a = acc[ai][bj][m][0], b = acc[ai][bj][m][1];
#pragma unroll
                    for (int e = 0; e < 4; ++e) { a[e] = fmaxf(a[e] * __builtin_fabsf(a[e]), 0.f); b[e] = fmaxf(b[e] * __builtin_fabsf(b[e]), 0.f); }
                    *(u32x4*)(rowp + 32 * bj * 2 + lo) = pack8(a, b); } }
    }
};
struct EpiDown {
    static constexpr bool PERM = true, AFTER_DRAIN = true, KEEP_ACC = false, PERM64 = false;
    float* out; const float* ssq; float probe; const bf16_t* A2;
    __device__ __forceinline__ void fused(const acc_t& acc, const Unit& u, int wr, int wc, int fr, int fq, PG8_LAS unsigned char*, int, int) const {
        const int row0 = u.pm * BM + wr * 64 + fr, col0 = u.pn * BM + wc * 32 + 8 * fq;
#pragma unroll
        for (int ai = 0; ai < 2; ++ai)
#pragma unroll
            for (int m = 0; m < 4; ++m) { const int row = row0 + ai * HALF + m * 16; const size_t off = (size_t)row * D + col0;
                const f32x4 s4 = *(const f32x4*)(ssq + (size_t)row * 4); const float r2 = 1.0f / (((s4.x + s4.y) + (s4.z + s4.w)) * (1.0f / D) + EPS);
#pragma unroll
                for (int bj = 0; bj < 2; ++bj) { float* q = out + off + bj * HALF; const u32x4 xw = *(const u32x4*)(A2 + off + bj * HALF);
                    f32x4 v0 = (f32x4){bflo(xw.x), bfhi(xw.x), bflo(xw.y), bfhi(xw.y)} + acc[ai][bj][m][0] * r2, v1 = (f32x4){bflo(xw.z), bfhi(xw.z), bflo(xw.w), bfhi(xw.w)} + acc[ai][bj][m][1] * r2;
                    if ((TIMING_PHASE >= 0 || GPROBE != 0) && q == out) v0[0] += probe;
                    __builtin_nontemporal_store(v0, (f32x4*)q); __builtin_nontemporal_store(v1, (f32x4*)(q + 4)); }
                if (m & 1) asm volatile("" ::: "memory"); }
    }
};

template <class Epi, class Sched, bool ALIGN_EPI = false, bool SP2 = false, int PID = 0, bool DE = false>
__device__ __forceinline__ void gemm_phase(PG8_LAS unsigned char* lds, const int K, const Sched& S, const Epi& E) {
    const int tid = threadIdx.x, wid = __builtin_amdgcn_readfirstlane(tid >> 6), lane = tid & 63, wr = wid >> 2, wc = wid & 3, fr = lane & 15, fq = lane >> 4;
    const int nt = K / BK;
    unsigned voffA[2], voffB[2];
#pragma unroll
    for (int i = 0; i < 2; ++i) { int R, C; stage_rc(tid * 16 + i * 8192, R, C); const int Rb = Epi::PERM64 ? (64 * (R >> 5) + perm32(R & 31)) : Epi::PERM ? ((R & ~31) + perm32(R & 31)) : R;
        voffA[i] = (unsigned)(R * K + C) * 2u; voffB[i] = (unsigned)(Rb * K + C) * 2u; }
    const size_t kstep = (size_t)(BK * 2);
    const size_t hstep = (size_t)HALF * K * 2;
    const size_t hstepB = Epi::PERM64 ? (size_t)32 * K * 2 : hstep;
    const unsigned ldsw = (unsigned)wid * 1024u;
    const int aoff = lds_byte(wr * 64 + fr, fq * 8), boff = lds_byte(wc * 32 + fr, fq * 8);
#define PG8_SA(b, h) (((b) * 2 + (h)) * HTB)
#define PG8_SB(b, h) ((4 + (b) * 2 + (h)) * HTB)
#define PG8_STAGE(bufoff, gbase, voff) do { const char* gb_ = (const char*)(gbase); asm volatile("" : "+s"(gb_)); _Pragma("unroll") for (int _i = 0; _i < 2; ++_i) { unsigned vo_ = (voff)[_i]; asm volatile("" : "+v"(vo_)); \
        __builtin_amdgcn_global_load_lds((const unsigned*)(gb_ + vo_), (PG8_LAS unsigned*)(lds + (bufoff) + ldsw + _i * 8192), 16, 0, 0); } } while (0)
#define PG8_LDA(dst, b, h) do { _Pragma("unroll") for (int m = 0; m < 4; ++m) _Pragma("unroll") for (int k = 0; k < 2; ++k) dst[m][k] = *(const PG8_LAS bf16x8*)(lds + PG8_SA(b, h) + aoff + m * 2048 + k * 1024); } while (0)
#define PG8_LDB(dst, b, h) do { _Pragma("unroll") for (int n = 0; n < 2; ++n) _Pragma("unroll") for (int k = 0; k < 2; ++k) dst[n][k] = *(const PG8_LAS bf16x8*)(lds + PG8_SB(b, h) + boff + n * 2048 + k * 1024); } while (0)
#define PG8_MMA(ai, bj, At, Bt) do { __builtin_amdgcn_s_setprio(1); _Pragma("unroll") for (int m = 0; m < 4; ++m) _Pragma("unroll") for (int n = 0; n < 2; ++n) _Pragma("unroll") for (int k = 0; k < 2; ++k) \
        acc[ai][bj][m][n] = __builtin_amdgcn_mfma_f32_16x16x32_bf16(Bt[n][k], At[m][k], acc[ai][bj][m][n], 0, 0, 0); __builtin_amdgcn_s_setprio(0); } while (0)
#define PG8_WAIT_V(n) asm volatile("s_waitcnt vmcnt(" #n ")" ::: "memory")
#define PG8_WAIT_L(n) asm volatile("s_waitcnt lgkmcnt(" #n ")" ::: "memory")
#define PG8_BAR __builtin_amdgcn_s_barrier()
#define PG8_SCHED __builtin_amdgcn_sched_barrier(0)
    Unit cur, nxt; int ui = 0;
    if (!S.next(0, cur)) return;
    f32x4 acc[2][2][4][2];
    if constexpr (!DE) {
#pragma unroll
    for (int a = 0; a < 2; ++a)
#pragma unroll
        for (int b = 0; b < 2; ++b)
#pragma unroll
            for (int m = 0; m < 4; ++m)
#pragma unroll
                for (int n = 0; n < 2; ++n) acc[a][b][m][n] = (f32x4){0.f, 0.f, 0.f, 0.f};
    }
    bf16x8 At[4][2], B0[2][2], B1[2][2];
    const char* cA = S.a_ptr(cur); const char* cB = S.b_ptr(cur);
    S.a_ready(cur);
    if constexpr (SP2) {
        PG8_STAGE(PG8_SB(0, 0), cB, voffB); PG8_STAGE(PG8_SB(0, 1), cB + hstepB, voffB); PG8_STAGE(PG8_SA(0, 0), cA, voffA); PG8_STAGE(PG8_SA(0, 1), cA + hstep, voffA);
        if (wr == 1) PG8_BAR;
        PG8_WAIT_V(2); PG8_BAR;
        PG8_STAGE(PG8_SB(1, 0), cB + kstep, voffB); PG8_STAGE(PG8_SA(1, 0), cA + kstep, voffA); PG8_STAGE(PG8_SB(1, 1), cB + hstepB + kstep, voffB);
        PG8_WAIT_V(6); PG8_BAR;
    } else {
        PG8_STAGE(PG8_SB(0, 0), cB, voffB); PG8_STAGE(PG8_SA(0, 0), cA, voffA); PG8_STAGE(PG8_SB(0, 1), cB + hstepB, voffB); PG8_STAGE(PG8_SA(0, 1), cA + hstep, voffA);
        if (wr == 1) PG8_BAR;
        PG8_WAIT_V(4); PG8_BAR;
        PG8_STAGE(PG8_SB(1, 0), cB + kstep, voffB); PG8_STAGE(PG8_SA(1, 0), cA + kstep, voffA); PG8_STAGE(PG8_SB(1, 1), cB + hstepB + kstep, voffB);
        PG8_WAIT_V(6); PG8_BAR;
    }
    constexpr bool GP = (GPROBE != 0 && GPROBE == PID);
    unsigned long long gpU = 0, gp1 = 0, gpEnd = 0, gpS0 = 0, accFirst = 0, accFirst0 = 0, accSteady = 0, accE = 0; if (GP) gpS0 = __builtin_amdgcn_s_memrealtime();
    if constexpr (DE) {
#define PG8_MMAZ(ai, bj, At, Bt) do { __builtin_amdgcn_s_setprio(1); _Pragma("unroll") for (int m = 0; m < 4; ++m) _Pragma("unroll") for (int n = 0; n < 2; ++n) { \
        acc[ai][bj][m][n] = __builtin_amdgcn_mfma_f32_16x16x32_bf16(Bt[n][0], At[m][0], (f32x4){0.f, 0.f, 0.f, 0.f}, 0, 0, 0); \
        acc[ai][bj][m][n] = __builtin_amdgcn_mfma_f32_16x16x32_bf16(Bt[n][1], At[m][1], acc[ai][bj][m][n], 0, 0, 0); } __builtin_amdgcn_s_setprio(0); } while (0)
#define PG8_PAIR(W1, W2, W3, W4, MM, PRE1, PRE4) do { \
            PG8_STAGE(PG8_SA(1, 1), a1 + hstep, voffA); PRE1; PG8_SCHED; PG8_LDB(B0, 0, 0); PG8_LDB(B1, 0, 1); PG8_SCHED; PG8_LDA(At, 0, 0); \
            PG8_WAIT_V(W1); PG8_WAIT_L(0); PG8_BAR; MM(0, 0, At, B0); MM(0, 1, At, B1); PG8_BAR; PG8_SCHED; \
            PG8_LDA(At, 0, 1); PG8_STAGE(PG8_SB(0, 0), b2, voffB); PG8_STAGE(PG8_SB(0, 1), b2 + hstepB, voffB); PG8_STAGE(PG8_SA(0, 0), a2, voffA); \
            PG8_WAIT_V(W2); PG8_WAIT_L(0); PG8_BAR; MM(1, 0, At, B0); MM(1, 1, At, B1); PG8_BAR; PG8_SCHED; \
            PG8_LDB(B0, 1, 0); PG8_LDB(B1, 1, 1); PG8_SCHED; PG8_LDA(At, 1, 0); PG8_STAGE(PG8_SA(0, 1), a2 + hstep, voffA); \
            PG8_WAIT_V(W3); PG8_WAIT_L(0); PG8_BAR; PG8_MMA(0, 0, At, B0); PG8_MMA(0, 1, At, B1); PG8_BAR; PG8_SCHED; \
            PG8_STAGE(PG8_SB(1, 0), b3, voffB); PG8_STAGE(PG8_SB(1, 1), b3 + hstepB, voffB); PG8_STAGE(PG8_SA(1, 0), a3, voffA); PRE4; PG8_SCHED; PG8_LDA(At, 1, 1); \
            PG8_WAIT_V(W4); PG8_WAIT_L(0); PG8_BAR; PG8_MMA(1, 0, At, B0); PG8_MMA(1, 1, At, B1); PG8_BAR; PG8_SCHED; } while (0)
        static_assert(SP2 && !ALIGN_EPI && !Epi::AFTER_DRAIN && !Epi::KEEP_ACC, "DE: SP2 form, store-only per-unit epilogues");
        if (GP) gpU = __builtin_amdgcn_s_memrealtime();
        { const char* a1 = cA + kstep; const char* a2 = cA + 2 * kstep; const char* b2 = cB + 2 * kstep; const char* a3 = a2 + kstep; const char* b3 = b2 + kstep;
          PG8_PAIR(8, 8, 8, 8, PG8_MMAZ, (void)0, (void)0); }
        for (;;) {
            const bool has_next = S.next(ui + 1, nxt);
            const char* nA = has_next ? S.a_ptr(nxt) : cA; const char* nB = has_next ? S.b_ptr(nxt) : cB;
            if (GP) gp1 = __builtin_amdgcn_s_memrealtime();
            for (int t = 2; t < nt - 2; t += 2) {
                const char* a1 = cA + (size_t)(t + 1) * kstep; const char* a2 = cA + (size_t)(t + 2) * kstep; const char* b2 = cB + (size_t)(t + 2) * kstep; const char* a3 = a2 + kstep; const char* b3 = b2 + kstep;
                PG8_PAIR(8, 8, 8, 8, PG8_MMA, (void)0, (void)0); }
            { const char* a1 = cA + (size_t)(nt - 1) * kstep; const char* a2 = nA; const char* b2 = nB; const char* a3 = a2 + kstep; const char* b3 = b2 + kstep;
              if (has_next) S.a_ready(nxt);
              PG8_PAIR(8, 8, 8, 16, PG8_MMA, (void)0, E.half(acc, cur, wr, wc, fr, fq, 0)); }
            if (GP) { gpEnd = __builtin_amdgcn_s_memrealtime(); if (ui == 0) accFirst0 += gp1 - gpU; else accFirst += gp1 - gpU; accSteady += gpEnd - gp1; }
            if (!has_next) break;
            const Unit prev = cur; cur = nxt; cA = nA; cB = nB; ++ui;
            if (GP) gpU = __builtin_amdgcn_s_memrealtime();
            { const char* a1 = cA + kstep; const char* a2 = cA + 2 * kstep; const char* b2 = cB + 2 * kstep; const char* a3 = a2 + kstep; const char* b3 = b2 + kstep;
              PG8_PAIR(24, 24, 16, 8, PG8_MMAZ, E.half(acc, prev, wr, wc, fr, fq, 1), (void)0); }
        }
        E.half(acc, cur, wr, wc, fr, fq, 1);
#undef PG8_PAIR
#undef PG8_MMAZ
    } else
    for (;;) {
        const bool has_next = S.next(ui + 1, nxt);
        if (GP) gpU = __builtin_amdgcn_s_memrealtime();
        const char* nA = has_next ? S.a_ptr(nxt) : cA; const char* nB = has_next ? S.b_ptr(nxt) : cB;
        for (int t = 0; t < nt; t += 2) {
            const bool last = (t == nt - 2);
            if (GP && t == 2) gp1 = __builtin_amdgcn_s_memrealtime();
            const char* a1 = cA + (size_t)(t + 1) * kstep;
            const char* a2 = last ? nA : cA + (size_t)(t + 2) * kstep; const char* b2 = last ? nB : cB + (size_t)(t + 2) * kstep;
            const char* a3 = a2 + kstep; const char* b3 = b2 + kstep;
            if (last && has_next) S.a_ready(nxt);
            if constexpr (SP2) {
            PG8_LDB(B0, 0, 0); PG8_LDB(B1, 0, 1); PG8_SCHED; PG8_LDA(At, 0, 0); PG8_STAGE(PG8_SA(1, 1), a1 + hstep, voffA);
            PG8_WAIT_V(8); PG8_WAIT_L(0); PG8_BAR; PG8_MMA(0, 0, At, B0); PG8_MMA(0, 1, At, B1); PG8_BAR; PG8_SCHED;
            PG8_LDA(At, 0, 1); PG8_STAGE(PG8_SB(0, 0), b2, voffB); PG8_STAGE(PG8_SB(0, 1), b2 + hstepB, voffB); PG8_STAGE(PG8_SA(0, 0), a2, voffA);
            PG8_WAIT_V(8); PG8_WAIT_L(0); PG8_BAR; PG8_MMA(1, 0, At, B0); PG8_MMA(1, 1, At, B1); PG8_BAR; PG8_SCHED;
            PG8_LDB(B0, 1, 0); PG8_LDB(B1, 1, 1); PG8_SCHED; PG8_LDA(At, 1, 0); PG8_STAGE(PG8_SA(0, 1), a2 + hstep, voffA);
            PG8_WAIT_V(8); PG8_WAIT_L(0); PG8_BAR; PG8_MMA(0, 0, At, B0); PG8_MMA(0, 1, At, B1); PG8_BAR; PG8_SCHED;
            PG8_LDA(At, 1, 1); PG8_STAGE(PG8_SB(1, 0), b3, voffB); PG8_STAGE(PG8_SB(1, 1), b3 + hstepB, voffB); PG8_STAGE(PG8_SA(1, 0), a3, voffA);
            PG8_WAIT_V(8); PG8_WAIT_L(0); PG8_BAR; PG8_MMA(1, 0, At, B0); PG8_MMA(1, 1, At, B1); PG8_BAR; PG8_SCHED;
            } else {
            PG8_LDB(B0, 0, 0); PG8_SCHED; PG8_LDA(At, 0, 0); PG8_STAGE(PG8_SA(1, 1), a1 + hstep, voffA);
            PG8_WAIT_L(8); PG8_BAR; PG8_WAIT_L(0); PG8_MMA(0, 0, At, B0); PG8_BAR; PG8_SCHED;
            PG8_LDB(B1, 0, 1); PG8_STAGE(PG8_SB(0, 0), b2, voffB);
            PG8_BAR; PG8_WAIT_L(0); PG8_MMA(0, 1, At, B1); PG8_BAR;
            PG8_LDA(At, 0, 1); PG8_STAGE(PG8_SA(0, 0), a2, voffA);
            PG8_BAR; PG8_WAIT_L(0); PG8_MMA(1, 0, At, B0); PG8_BAR; PG8_SCHED;
            PG8_STAGE(PG8_SB(0, 1), b2 + hstepB, voffB);
            PG8_WAIT_V(6); PG8_BAR; PG8_MMA(1, 1, At, B1); PG8_BAR;
            PG8_LDB(B0, 1, 0); PG8_SCHED; PG8_LDA(At, 1, 0); PG8_STAGE(PG8_SA(0, 1), a2 + hstep, voffA);
            PG8_WAIT_L(8); PG8_BAR; PG8_WAIT_L(0); PG8_MMA(0, 0, At, B0); PG8_BAR; PG8_SCHED;
            PG8_LDB(B1, 1, 1); PG8_STAGE(PG8_SB(1, 0), b3, voffB);
            PG8_BAR; PG8_WAIT_L(0); PG8_MMA(0, 1, At, B1); PG8_BAR;
            PG8_LDA(At, 1, 1); PG8_STAGE(PG8_SA(1, 0), a3, voffA);
            PG8_BAR; PG8_WAIT_L(0); PG8_MMA(1, 0, At, B0); PG8_BAR; PG8_SCHED;
            PG8_STAGE(PG8_SB(1, 1), b3 + hstepB, voffB);
            PG8_WAIT_V(6); PG8_BAR; PG8_MMA(1, 1, At, B1); PG8_BAR;
            }
        }
        if constexpr (ALIGN_EPI) { if (wr == 0) PG8_BAR; }
        if (GP) { gpEnd = __builtin_amdgcn_s_memrealtime(); if (ui == 0) accFirst0 += gp1 - gpU; else accFirst += gp1 - gpU; accSteady += gpEnd - gp1; }
        if constexpr (!Epi::AFTER_DRAIN) { E(acc, cur, wr, wc, fr, fq); S.done(cur); }
        if (GP) accE += __builtin_amdgcn_s_memrealtime() - gpEnd;
        if (!has_next) break;
        if constexpr (!Epi::KEEP_ACC) {
#pragma unroll
        for (int a = 0; a < 2; ++a)
#pragma unroll
            for (int b = 0; b < 2; ++b)
#pragma unroll
                for (int m = 0; m < 4; ++m)
#pragma unroll
                    for (int n = 0; n < 2; ++n) acc[a][b][m][n] = (f32x4){0.f, 0.f, 0.f, 0.f};
        }
        cur = nxt; cA = nA; cB = nB; ++ui;
        if constexpr (ALIGN_EPI) { if (wr == 1) PG8_BAR; }
    }
    PG8_WAIT_V(0);
    if constexpr (!ALIGN_EPI) { if (wr == 0) PG8_BAR; }
    PG8_BAR;
    if constexpr (Epi::AFTER_DRAIN) { E.fused(acc, cur, wr, wc, fr, fq, lds, wid, lane); S.done(cur); }
    if (GP && blockIdx.x == 0 && tid == 0) { const float nu = (float)(ui + 1), npair = (float)(nt / 2 - 1); float v = 0.f;
        if (GPSEL == 1) v = (float)accSteady * 0.01f / (nu * npair);
        if (GPSEL == 2) v = (float)accFirst * 0.01f / fmaxf(nu - 1.f, 1.f);
        if (GPSEL == 3) v = (float)accFirst0 * 0.01f;
        if (GPSEL == 4) v = (float)accE * 0.01f / nu;
        if (GPSEL == 5) v = (float)(__builtin_amdgcn_s_memrealtime() - gpS0) * 0.001f;
        *(PG8_LAS float*)(lds + MISC_OFF + 64) = (v - GPOFF) * GPSCALE; }
#undef PG8_SA
#undef PG8_SB
#undef PG8_STAGE
#undef PG8_LDA
#undef PG8_LDB
#undef PG8_MMA
#undef PG8_WAIT_V
#undef PG8_WAIT_L
#undef PG8_BAR
#undef PG8_SCHED
}
}

namespace att {
typedef float f32x16 __attribute__((ext_vector_type(16)));
typedef float f32x2_t __attribute__((ext_vector_type(2)));
typedef __bf16 bf16x2_t __attribute__((ext_vector_type(2)));
typedef unsigned u32x4 __attribute__((ext_vector_type(4)));
typedef unsigned u32x2 __attribute__((ext_vector_type(2)));
constexpr int KP = 88, VP = 96;
constexpr int BUF_K = 0, BUF_V = 64 * KP * 2, BUF_B = BUF_V + 64 * VP * 2, BUF_BYTES = BUF_B + 256;
typedef short v4i16_t __attribute__((ext_vector_type(4)));
__device__ __forceinline__ u32x2 vtr(const LAS unsigned char* p) { return __builtin_bit_cast(u32x2, __builtin_amdgcn_ds_read_tr16_b64_v4i16((LAS v4i16_t*)p)); }
__device__ __forceinline__ int crow(int r, int hi) { return (r & 3) + 8 * (r >> 2) + 4 * hi; }
__device__ __forceinline__ unsigned cvtpk(float lo, float hi) { f32x2_t v = {lo, hi}; bf16x2_t b = __builtin_convertvector(v, bf16x2_t); return __builtin_bit_cast(unsigned, b); }
__device__ __forceinline__ float other_half(float v, int hi) { auto r = __builtin_amdgcn_permlane32_swap(__float_as_uint(v), __float_as_uint(v), false, false); return __uint_as_float(hi ? r[0] : r[1]); }
#define ATT_MFMA(a, b, c) __builtin_amdgcn_mfma_f32_32x32x16_bf16(a, b, c, 0, 0, 0)

template <int MODE>
__device__ __forceinline__ void att_compute(const LAS unsigned char* bb, int kt, int qw0, int r32, int hi, const bf16x8 (&qf)[5], f32x16& o0, f32x16& o1, float& carry, float& mrun, float& lrun) {
        const int key0 = kt * 64;
        if (key0 <= qw0 + 31) {
            f32x16 p0, p1;
            p0 = f32x16{}; p1 = f32x16{};
            u32x2 vf[4][2][2];
            { const LAS unsigned char* kb = bb + BUF_K + (r32 * KP + 8 * hi) * 2; constexpr int ND = MODE == 1 ? 5 : 4; bf16x8 ka[ND], kc[ND];
#pragma unroll
              for (int d0 = 0; d0 < ND; ++d0) { ka[d0] = *(const LAS bf16x8*)(kb + d0 * 32); kc[d0] = *(const LAS bf16x8*)(kb + 32 * KP * 2 + d0 * 32); }
              __builtin_amdgcn_sched_barrier(0);
#pragma unroll
              for (int d0 = 0; d0 < ND; ++d0) { p0 = ATT_MFMA(ka[d0], qf[d0], p0); p1 = ATT_MFMA(kc[d0], qf[d0], p1); }
              const LAS unsigned char* vb = bb + BUF_V + ((4 * hi + ((r32 & 15) >> 2)) * VP + 16 * (r32 >> 4) + 4 * (r32 & 3)) * 2;
#pragma unroll
              for (int ks = 0; ks < 4; ++ks) { const int koff = (16 * ks) * VP * 2;
                  vf[ks][0][0] = vtr(vb + koff); vf[ks][0][1] = vtr(vb + koff + 8 * VP * 2);
                  vf[ks][1][0] = vtr(vb + koff + 64); vf[ks][1][1] = vtr(vb + koff + 8 * VP * 2 + 64); }
              __builtin_amdgcn_sched_barrier(0); }
            const int qrow = qw0 + r32; const bool diag = key0 + 63 >= qw0;
            if (MODE == 0) {
                f32x16 rm0, rm1;
#pragma unroll
                for (int r = 0; r < 16; ++r) {
                    { const float t = __builtin_amdgcn_exp2f(-p0[r]); const float be = __builtin_amdgcn_rcpf(1.0f + t); p0[r] = be; rm0[r] = 1.0f - be; }
                    { const float t = __builtin_amdgcn_exp2f(-p1[r]); const float be = __builtin_amdgcn_rcpf(1.0f + t); p1[r] = be; rm1[r] = 1.0f - be; }
                }
                if (diag) {
                    asm volatile("" ::: "memory"); const int lim = qrow - key0 - 4 * hi;
#pragma unroll
                    for (int r = 0; r < 16; ++r) { const int c0 = (r & 3) + 8 * (r >> 2);
                        if (c0 >= lim) { p0[r] = 0.f; rm0[r] = 1.0f; } if (c0 + 32 >= lim) { p1[r] = 0.f; rm1[r] = 1.0f; } } }
                float gp[8], pg[8];
#pragma unroll
                for (int g = 0; g < 4; ++g) { gp[g] = (rm0[4 * g] * rm0[4 * g + 1]) * (rm0[4 * g + 2] * rm0[4 * g + 3]); gp[4 + g] = (rm1[4 * g] * rm1[4 * g + 1]) * (rm1[4 * g + 2] * rm1[4 * g + 3]); }
#pragma unroll
                for (int g = 0; g < 8; ++g) pg[g] = other_half(gp[g], hi);
                float run = carry;
#pragma unroll
                for (int g = 7; g >= 0; --g) {
                    const float aft = hi ? run : run * pg[g];
                    run = run * (gp[g] * pg[g]);
                    if (g >= 4) { const int r = 4 * (g - 4); const float a3 = aft, a2 = a3 * rm1[r + 3], a1 = a2 * rm1[r + 2], a0 = a1 * rm1[r + 1];
                        p1[r] *= a0; p1[r + 1] *= a1; p1[r + 2] *= a2; p1[r + 3] *= a3; }
                    else { const int r = 4 * g; const float a3 = aft, a2 = a3 * rm0[r + 3], a1 = a2 * rm0[r + 2], a0 = a1 * rm0[r + 1];
                        p0[r] *= a0; p0[r + 1] *= a1; p0[r + 2] *= a2; p0[r + 3] *= a3; }
                }
                carry = run;
            } else {
                if (diag) {
                    asm volatile("" ::: "memory"); const int lim = qrow - key0 - 4 * hi;
#pragma unroll
                    for (int r = 0; r < 16; ++r) { const int c0 = (r & 3) + 8 * (r >> 2); if (c0 > lim) p0[r] = -1e30f; if (c0 + 32 > lim) p1[r] = -1e30f; } }
                float ls = 0.f;
#pragma unroll
                for (int r = 0; r < 16; ++r) { p0[r] = __builtin_amdgcn_exp2f(p0[r]); p1[r] = __builtin_amdgcn_exp2f(p1[r]); ls += p0[r] + p1[r]; }
                lrun += ls;
            }
#pragma unroll
            for (int ks = 0; ks < 4; ++ks) {
                const int rb = 8 * (ks & 1); u32x4 pw;
                if (ks < 2) { pw.x = cvtpk(p0[rb], p0[rb + 1]); pw.y = cvtpk(p0[rb + 2], p0[rb + 3]); pw.z = cvtpk(p0[rb + 4], p0[rb + 5]); pw.w = cvtpk(p0[rb + 6], p0[rb + 7]); }
                else        { pw.x = cvtpk(p1[rb], p1[rb + 1]); pw.y = cvtpk(p1[rb + 2], p1[rb + 3]); pw.z = cvtpk(p1[rb + 4], p1[rb + 5]); pw.w = cvtpk(p1[rb + 6], p1[rb + 7]); }
                const bf16x8 pf = __builtin_bit_cast(bf16x8, pw);
                const u32x4 a0 = {vf[ks][0][0].x, vf[ks][0][0].y, vf[ks][0][1].x, vf[ks][0][1].y}, a1 = {vf[ks][1][0].x, vf[ks][1][0].y, vf[ks][1][1].x, vf[ks][1][1].y};
                o0 = ATT_MFMA(__builtin_bit_cast(bf16x8, a0), pf, o0); o1 = ATT_MFMA(__builtin_bit_cast(bf16x8, a1), pf, o1);
            }
        }
}
template <int MODE>
__device__ __forceinline__ void unit64(const bf16* Q, const bf16* K, const bf16* V, bf16* O, const float* FC, const float* gq, const float* gk, int b, int h, int qb, LAS unsigned char* lds) {
    const int tid = threadIdx.x, lane = tid & 63, r32 = lane & 31, hi = lane >> 5; const int wid = __builtin_amdgcn_readfirstlane(tid >> 6);
    const size_t rowbase = (size_t)b * SEQ; const int q0 = qb * 256, qw0 = q0 + wid * 32;
    const int NT = 4 * qb + 4;
    const int skey = tid >> 3, sch = tid & 7;
    const bf16* kg = K + (rowbase + skey) * DH + h * HD + sch * 8; const bf16* vg = V + (rowbase + skey) * DH + h * HD + sch * 8;
    const float* fg = FC + (size_t)(b * NH + h) * SEQ;
    v4u kreg, vreg; float breg = 0.f; v4u kregB, vregB; float bregB = 0.f;
#define ATT_LOAD2(t, KR, VR, BR) do { KR = *(const v4u*)(kg + (size_t)(t) * 64 * DH); VR = *(const v4u*)(vg + (size_t)(t) * 64 * DH); if (MODE == 1 && tid < 64) BR = fg[(t) * 64 + tid]; } while (0)
    ATT_LOAD2(NT - 1, kreg, vreg, breg); ATT_LOAD2(NT - 2, kregB, vregB, bregB);
    float fq0 = 0.f; if (MODE == 1) fq0 = fg[qw0 + r32];
    bf16x8 qf[5]; float gmax = 0.f;
    { const bf16* qp = Q + (rowbase + qw0 + r32) * DH + h * HD + 8 * hi;
#pragma unroll
      for (int d0 = 0; d0 < 4; ++d0) { v4u w = *(const v4u*)(qp + 16 * d0);
          if (MODE == 1) { const float* g1 = gq + 16 * d0 + 8 * hi; const float* g2 = gk + 16 * d0 + 8 * hi;
#pragma unroll
              for (int j = 0; j < 8; ++j) gmax = fmaxf(gmax, __builtin_fabsf(g1[j] * g2[j]));
              w.x = cvtpk(bflo(w.x) * g1[0] * g2[0], bfhi(w.x) * g1[1] * g2[1]); w.y = cvtpk(bflo(w.y) * g1[2] * g2[2], bfhi(w.y) * g1[3] * g2[3]);
              w.z = cvtpk(bflo(w.z) * g1[4] * g2[4], bfhi(w.z) * g1[5] * g2[5]); w.w = cvtpk(bflo(w.w) * g1[6] * g2[6], bfhi(w.w) * g1[7] * g2[7]); }
          qf[d0] = __builtin_bit_cast(bf16x8, w); } }
    f32x16 o0 = {}, o1 = {};
    float carry = 1.0f, mrun = -1e30f, lrun = 0.f;
    if (MODE == 1) { gmax = fmaxf(gmax, other_half(gmax, hi));
        mrun = -fq0 * LOG2E + 64.0f * 1.02f * C2 * gmax + 0.5f;
        { const float c = -mrun; const unsigned ch = f2bf(c); const float r1 = c - bf2f((bf16)ch); const unsigned cm = f2bf(r1); const unsigned cl = f2bf(r1 - bf2f((bf16)cm));
          u32x4 w = {0x3F803F80u, 0x3F80u | (ch << 16), cm | (cl << 16), 0u}; if (hi) w = u32x4{0u, 0u, 0u, 0u}; qf[4] = __builtin_bit_cast(bf16x8, w); } }
    else qf[4] = qf[3];
    LAS unsigned* alive = (LAS unsigned*)(lds + 2 * BUF_BYTES);
#define ATT_LOAD(t) do { kreg = *(const v4u*)(kg + (size_t)(t) * 64 * DH); vreg = *(const v4u*)(vg + (size_t)(t) * 64 * DH); if (MODE == 1 && tid < 64) breg = -fg[(t) * 64 + tid] * LOG2E; } while (0)
#define ATT_WRITE(bufo) do { LAS unsigned char* bb_ = lds + (bufo); *(LAS v4u*)(bb_ + BUF_K + (skey * KP + sch * 8) * 2) = kreg; \
        LAS unsigned short* vt_ = (LAS unsigned short*)(bb_ + BUF_V) + (sch * 8) * VP + skey; \
        vt_[0 * VP] = (unsigned short)(vreg.x & 0xffffu); vt_[1 * VP] = (unsigned short)(vreg.x >> 16); vt_[2 * VP] = (unsigned short)(vreg.y & 0xffffu); vt_[3 * VP] = (unsigned short)(vreg.y >> 16); \
        vt_[4 * VP] = (unsigned short)(vreg.z & 0xffffu); vt_[5 * VP] = (unsigned short)(vreg.z >> 16); vt_[6 * VP] = (unsigned short)(vreg.w & 0xffffu); vt_[7 * VP] = (unsigned short)(vreg.w >> 16); \
        if (MODE == 1 && tid < 64) *(LAS float*)(bb_ + BUF_B + tid * 4) = breg; } while (0)
#define ATT_WRITE2(bufo, KR, VR, BR) do { LAS unsigned char* bb_ = lds + (bufo); *(LAS v4u*)(bb_ + BUF_K + (skey * KP + sch * 8) * 2) = KR; *(LAS v4u*)(bb_ + BUF_V + (skey * VP + sch * 8) * 2) = VR; \
        if (MODE == 1 && tid < 64) { const float nb_ = -BR * LOG2E; const unsigned bh_ = f2bf(nb_); const float q1_ = nb_ - bf2f((bf16)bh_); const unsigned bm_ = f2bf(q1_); const unsigned bl_ = f2bf(q1_ - bf2f((bf16)bm_)); \
            LAS v4u* kx_ = (LAS v4u*)(bb_ + BUF_K + (tid * KP + 64) * 2); kx_[0] = v4u{bh_ | (bm_ << 16), bl_ | 0x3F800000u, 0x3F803F80u, 0u}; kx_[1] = v4u{0u, 0u, 0u, 0u}; } } while (0)
    ATT_WRITE2(0, kreg, vreg, breg); __syncthreads();
    bool done = false;
#define ATT_STEP(IT, WK, WV, WB, LK, LV, LB) do { const int it = (IT); const int kt = NT - 1 - it, cur = (it & 1) * BUF_BYTES, nxt = BUF_BYTES - cur; \
        if (it + 2 < NT) ATT_LOAD2(kt - 2, LK, LV, LB); \
        att_compute<MODE>(lds + cur, kt, qw0, r32, hi, qf, o0, o1, carry, mrun, lrun); \
        if (it + 1 < NT) ATT_WRITE2(nxt, WK, WV, WB); \
        if (MODE == 0) { if (lane == 0) alive[(it & 1) * 8 + wid] = __any(carry != 0.0f) ? 1u : 0u; else (void)__any(carry != 0.0f); } \
        __syncthreads(); \
        if (MODE == 0) { const LAS unsigned* al = alive + (it & 1) * 8; if ((al[0] | al[1] | al[2] | al[3] | al[4] | al[5] | al[6] | al[7]) == 0u) done = true; } } while (0)
    for (int it2 = 0; it2 < NT && !done; it2 += 2) {
        ATT_STEP(it2, kregB, vregB, bregB, kreg, vreg, breg);
        if (done) break;
        ATT_STEP(it2 + 1, kreg, vreg, breg, kregB, vregB, bregB);
    }
#undef ATT_STEP
#undef ATT_LOAD2
#undef ATT_WRITE2
    float inv = 1.0f;
    if (MODE == 1) { const float lt = lrun + other_half(lrun, hi); inv = 1.0f / lt; }
    bf16* op = O + (rowbase + qw0 + r32) * DH + h * HD + 4 * hi;
#pragma unroll
    for (int g = 0; g < 4; ++g) { u32x2 w0, w1; w0.x = cvtpk(o0[4 * g] * inv, o0[4 * g + 1] * inv); w0.y = cvtpk(o0[4 * g + 2] * inv, o0[4 * g + 3] * inv);
        w1.x = cvtpk(o1[4 * g] * inv, o1[4 * g + 1] * inv); w1.y = cvtpk(o1[4 * g + 2] * inv, o1[4 * g + 3] * inv);
        *(u32x2*)(op + 8 * g) = w0; *(u32x2*)(op + 32 + 8 * g) = w1; }
#undef ATT_LOAD
#undef ATT_WRITE
}
__device__ __forceinline__ void unit_sb(const bf16* Q, const bf16* K, const bf16* V, bf16* O, int b, int h, int qb, LAS unsigned char* lds) {
    const int tid = threadIdx.x, lane = tid & 63, r32 = lane & 31, hi = lane >> 5; const int wid = __builtin_amdgcn_readfirstlane(tid >> 6);
    const size_t rowbase = (size_t)b * SEQ; const int q0 = qb * 256, qw0 = q0 + wid * 32, T0 = 4 * qb, pw = wid >> 1;
    const int skey = tid >> 3, sch = tid & 7;
    const bf16* kg = K + (rowbase + skey) * DH + h * HD + sch * 8; const bf16* vg = V + (rowbase + skey) * DH + h * HD + sch * 8;
#define SB_LD(t, KR, VR) do { KR = *(const v4u*)(kg + (size_t)(t) * 64 * DH); VR = *(const v4u*)(vg + (size_t)(t) * 64 * DH); } while (0)
#define SB_WR(t, KR, VR) do { int wo_ = ((t) % 5) * BUF_BYTES; asm volatile("" : "+s"(wo_)); LAS unsigned char* bb_ = lds + wo_; *(LAS v4u*)(bb_ + BUF_K + (skey * KP + sch * 8) * 2) = KR; *(LAS v4u*)(bb_ + BUF_V + (skey * VP + sch * 8) * 2) = VR; } while (0)
    v4u kA, vA, kB, vB;
    bf16x8 qf[5];
    { v4u k3, v3, k2, v2, k1, v1, k0, v0;
      SB_LD(T0 + 3, k3, v3); SB_LD(T0 + 2, k2, v2); SB_LD(T0 + 1, k1, v1); SB_LD(T0, k0, v0);
      if (T0 >= 1) SB_LD(T0 - 1, kA, vA); if (T0 >= 2) SB_LD(T0 - 2, kB, vB);
      { const bf16* qp = Q + (rowbase + qw0 + r32) * DH + h * HD + 8 * hi;
#pragma unroll
        for (int d0 = 0; d0 < 4; ++d0) { const v4u w = *(const v4u*)(qp + 16 * d0); qf[d0] = __builtin_bit_cast(bf16x8, w); } }
      qf[4] = qf[3];
      SB_WR(T0 + 3, k3, v3); SB_WR(T0 + 2, k2, v2); SB_WR(T0 + 1, k1, v1); SB_WR(T0, k0, v0); }
    f32x16 o0 = {}, o1 = {};
    float carry = 1.0f, mrun = 0.f, lrun = 0.f;
    LAS unsigned* alive = (LAS unsigned*)(lds + 5 * BUF_BYTES);
    __syncthreads();
    bool done = false; const int NS = T0 + 4;
#define SB_STEP(S_, KR, VR) do { const int s_ = (S_); const int kt = T0 + pw - s_; \
        if (kt >= 0) { int bo_ = (kt % 5) * BUF_BYTES; asm volatile("" : "+s"(bo_)); att_compute<0>(lds + bo_, kt, qw0, r32, hi, qf, o0, o1, carry, mrun, lrun); }     \
        if (T0 - s_ - 1 >= 0) SB_WR(T0 - s_ - 1, KR, VR);             \
        if (T0 - s_ - 3 >= 0) SB_LD(T0 - s_ - 3, KR, VR); \
        { const bool live = __any(carry != 0.0f) && kt >= 1; if (lane == 0) alive[(s_ & 1) * 8 + wid] = live ? 1u : 0u; } \
        __syncthreads(); \
        { const LAS unsigned* al = alive + (s_ & 1) * 8; if ((al[0] | al[1] | al[2] | al[3] | al[4] | al[5] | al[6] | al[7]) == 0u) done = true; } } while (0)
    for (int s2 = 0; s2 < NS && !done; s2 += 2) {
        SB_STEP(s2, kA, vA);
        if (done || s2 + 1 >= NS) break;
        SB_STEP(s2 + 1, kB, vB);
    }
#undef SB_STEP
#undef SB_LD
#undef SB_WR
    bf16* op = O + (rowbase + qw0 + r32) * DH + h * HD + 4 * hi;
#pragma unroll
    for (int g = 0; g < 4; ++g) { u32x2 w0, w1; w0.x = cvtpk(o0[4 * g], o0[4 * g + 1]); w0.y = cvtpk(o0[4 * g + 2], o0[4 * g + 3]);
        w1.x = cvtpk(o1[4 * g], o1[4 * g + 1]); w1.y = cvtpk(o1[4 * g + 2], o1[4 * g + 3]);
        *(u32x2*)(op + 8 * g) = w0; *(u32x2*)(op + 32 + 8 * g) = w1; }
}
constexpr int MKP = 136, MVP = 144;
constexpr int MBUF_K = 0, MBUF_V = 64 * MKP * 2, MBUF_BYTES = MBUF_V + 64 * MVP * 2;
__device__ __forceinline__ void unit_mem(bf16* MQ, const float* MKf, const bf16* MV, const float* g_mq, const float* g_mk, int b, int hm, int qb, LAS unsigned char* lds) {
    const int tid = threadIdx.x, lane = tid & 63, r32 = lane & 31, hi = lane >> 5; const int wid = __builtin_amdgcn_readfirstlane(tid >> 6);
    const size_t rowq = (size_t)b * SEQ + qb * 256 + wid * 32 + r32;
    const int skey = tid >> 3, sch = tid & 7;
    const float* kg = MKf + (size_t)(b * MEMLEN + skey) * DH + hm * MHD + sch * 16; const bf16* vg = MV + (size_t)(b * MEMLEN + skey) * DH + hm * MHD + sch * 16;
    f32x4 kr[4][4]; v4u vr[4][2];
#pragma unroll
    for (int t = 0; t < 4; ++t) { const f32x4* kp_ = (const f32x4*)(kg + (size_t)t * 64 * DH); kr[t][0] = kp_[0]; kr[t][1] = kp_[1]; kr[t][2] = kp_[2]; kr[t][3] = kp_[3];
        const v4u* vp_ = (const v4u*)(vg + (size_t)t * 64 * DH); vr[t][0] = vp_[0]; vr[t][1] = vp_[1]; }
    v4u qw[8];
    { const bf16* qp = MQ + rowq * DH + hm * MHD + 8 * hi;
#pragma unroll
      for (int d0 = 0; d0 < 8; ++d0) qw[d0] = *(const v4u*)(qp + 16 * d0); }
    float gg[16];
#pragma unroll
    for (int i = 0; i < 16; ++i) gg[i] = g_mk[sch * 16 + i] * g_mq[sch * 16 + i] * C2M;
    float gmx = 0.f;
#pragma unroll
    for (int i = 0; i < 16; ++i) gmx = fmaxf(gmx, __builtin_fabsf(gg[i]));
    gmx = fmaxf(gmx, __shfl_xor(gmx, 1)); gmx = fmaxf(gmx, __shfl_xor(gmx, 2)); gmx = fmaxf(gmx, __shfl_xor(gmx, 4));
    const float nref = -(128.0f * 1.02f * gmx + 0.5f);
#pragma unroll
    for (int t = 0; t < 4; ++t) { LAS unsigned char* bb_ = lds + t * MBUF_BYTES; float ss_ = 0.f;
#pragma unroll
        for (int i_ = 0; i_ < 4; ++i_) ss_ += (kr[t][i_][0] * kr[t][i_][0] + kr[t][i_][1] * kr[t][i_][1]) + (kr[t][i_][2] * kr[t][i_][2] + kr[t][i_][3] * kr[t][i_][3]);
        ss_ += __shfl_xor(ss_, 1); ss_ += __shfl_xor(ss_, 2); ss_ += __shfl_xor(ss_, 4);
        const float rk_ = __builtin_amdgcn_rsqf(ss_ * (1.0f / MHD) + EPS); v4u k0_, k1_;
        k0_.x = cvtpk(kr[t][0][0] * rk_ * gg[0], kr[t][0][1] * rk_ * gg[1]); k0_.y = cvtpk(kr[t][0][2] * rk_ * gg[2], kr[t][0][3] * rk_ * gg[3]); k0_.z = cvtpk(kr[t][1][0] * rk_ * gg[4], kr[t][1][1] * rk_ * gg[5]); k0_.w = cvtpk(kr[t][1][2] * rk_ * gg[6], kr[t][1][3] * rk_ * gg[7]);
        k1_.x = cvtpk(kr[t][2][0] * rk_ * gg[8], kr[t][2][1] * rk_ * gg[9]); k1_.y = cvtpk(kr[t][2][2] * rk_ * gg[10], kr[t][2][3] * rk_ * gg[11]); k1_.z = cvtpk(kr[t][3][0] * rk_ * gg[12], kr[t][3][1] * rk_ * gg[13]); k1_.w = cvtpk(kr[t][3][2] * rk_ * gg[14], kr[t][3][3] * rk_ * gg[15]);
        LAS v4u* kd_ = (LAS v4u*)(bb_ + MBUF_K + (skey * MKP + sch * 16) * 2); kd_[0] = k0_; kd_[1] = k1_;
        LAS v4u* vd_ = (LAS v4u*)(bb_ + MBUF_V + (skey * MVP + sch * 16) * 2); vd_[0] = vr[t][0]; vd_[1] = vr[t][1]; }
    bf16x8 qf[8];
    { float ss = 0.f;
#pragma unroll
      for (int d0 = 0; d0 < 8; ++d0) { const float a0 = bflo(qw[d0].x), a1 = bfhi(qw[d0].x), a2 = bflo(qw[d0].y), a3 = bfhi(qw[d0].y), a4 = bflo(qw[d0].z), a5 = bfhi(qw[d0].z), a6 = bflo(qw[d0].w), a7 = bfhi(qw[d0].w);
          ss += (a0 * a0 + a1 * a1) + (a2 * a2 + a3 * a3) + (a4 * a4 + a5 * a5) + (a6 * a6 + a7 * a7); }
      ss += other_half(ss, hi);
      const float rq = __builtin_amdgcn_rsqf(ss * (1.0f / MHD) + EPS);
#pragma unroll
      for (int d0 = 0; d0 < 8; ++d0) { v4u o; o.x = cvtpk(bflo(qw[d0].x) * rq, bfhi(qw[d0].x) * rq); o.y = cvtpk(bflo(qw[d0].y) * rq, bfhi(qw[d0].y) * rq);
          o.z = cvtpk(bflo(qw[d0].z) * rq, bfhi(qw[d0].z) * rq); o.w = cvtpk(bflo(qw[d0].w) * rq, bfhi(qw[d0].w) * rq); qf[d0] = __builtin_bit_cast(bf16x8, o); } }
    f32x16 o0 = {}, o1 = {}, o2 = {}, o3 = {};
    float lrun = 0.f;
    __syncthreads();
#pragma unroll 1
    for (int kt = 0; kt < 4; ++kt) {
        const LAS unsigned char* bb = lds + kt * MBUF_BYTES;
        f32x16 p0, p1;
#pragma unroll
        for (int r = 0; r < 16; ++r) { p0[r] = nref; p1[r] = nref; }
        { const LAS unsigned char* kb = bb + MBUF_K + (r32 * MKP + 8 * hi) * 2;
#pragma unroll
          for (int d0 = 0; d0 < 8; ++d0) { const bf16x8 a0 = *(const LAS bf16x8*)(kb + d0 * 32), a1 = *(const LAS bf16x8*)(kb + 32 * MKP * 2 + d0 * 32);
              p0 = ATT_MFMA(a0, qf[d0], p0); p1 = ATT_MFMA(a1, qf[d0], p1); } }
        float ls = 0.f;
#pragma unroll
        for (int r = 0; r < 16; ++r) { p0[r] = __builtin_amdgcn_exp2f(p0[r]); p1[r] = __builtin_amdgcn_exp2f(p1[r]); ls += p0[r] + p1[r]; }
        lrun += ls;
        const LAS unsigned char* vb = bb + MBUF_V + ((4 * hi + ((r32 & 15) >> 2)) * MVP + 16 * (r32 >> 4) + 4 * (r32 & 3)) * 2;
#pragma unroll
        for (int ks = 0; ks < 4; ++ks) {
            const int rb = 8 * (ks & 1); u32x4 pw;
            if (ks < 2) { pw.x = cvtpk(p0[rb], p0[rb + 1]); pw.y = cvtpk(p0[rb + 2], p0[rb + 3]); pw.z = cvtpk(p0[rb + 4], p0[rb + 5]); pw.w = cvtpk(p0[rb + 6], p0[rb + 7]); }
            else        { pw.x = cvtpk(p1[rb], p1[rb + 1]); pw.y = cvtpk(p1[rb + 2], p1[rb + 3]); pw.z = cvtpk(p1[rb + 4], p1[rb + 5]); pw.w = cvtpk(p1[rb + 6], p1[rb + 7]); }
            const bf16x8 pf = __builtin_bit_cast(bf16x8, pw);
            const int koff = (16 * ks) * MVP * 2;
#define MATT_PV(ob, db) do { const u32x2 l_ = vtr(vb + koff + 64 * (db)), h_ = vtr(vb + koff + 8 * MVP * 2 + 64 * (db)); \
                const u32x4 a_ = {l_.x, l_.y, h_.x, h_.y}; ob = ATT_MFMA(__builtin_bit_cast(bf16x8, a_), pf, ob); } while (0)
            MATT_PV(o0, 0); MATT_PV(o1, 1); MATT_PV(o2, 2); MATT_PV(o3, 3);
#undef MATT_PV
        }
    }
    const float inv = 1.0f / (lrun + other_half(lrun, hi));
    bf16* op = MQ + rowq * DH + hm * MHD + 4 * hi;
#pragma unroll
    for (int g = 0; g < 4; ++g) {
#define MATT_ST(ob, db) do { u32x2 w_; w_.x = cvtpk(ob[4 * g] * inv, ob[4 * g + 1] * inv); w_.y = cvtpk(ob[4 * g + 2] * inv, ob[4 * g + 3] * inv); *(u32x2*)(op + 32 * (db) + 8 * g) = w_; } while (0)
        MATT_ST(o0, 0); MATT_ST(o1, 1); MATT_ST(o2, 2); MATT_ST(o3, 3);
#undef MATT_ST
    }
}
}

constexpr int N_PHASES = 9;
#ifndef OPT_P1
#define OPT_P1 1
#endif
#ifndef OPT_P3
#define OPT_P3 1
#endif
#ifndef OPT_ATT
#define OPT_ATT 1
#endif
#ifndef OPT_P4
#define OPT_P4 1
#endif
#ifndef OPT_P5
#define OPT_P5 1
#endif
#ifndef OPT_P6
#define OPT_P6 1
#endif
#ifndef DE_P1
#define DE_P1 true
#endif
#ifndef DE_P5
#define DE_P5 true
#endif
#ifndef STAGGER_P1
#define STAGGER_P1 0
#endif
#ifndef MK_N_LAUNCHES
#define MK_N_LAUNCHES 1
#endif
constexpr int N_LAUNCHES = MK_N_LAUNCHES;
struct Args { const float* in[18]; float* out; unsigned char* ws; int ph_lo, ph_hi, li, pad; };

__global__ void __launch_bounds__(NTHREADS, 2) skel_fwd(Args args) {
    extern __shared__ __attribute__((aligned(16))) unsigned char lds[];
    Frame F;
    F.lds = (LAS unsigned char*)lds;
    F.MISC = (volatile LAS unsigned*)(F.lds + MISC_OFF);
    F.tid = threadIdx.x; F.lane = F.tid & 63; F.wave = __builtin_amdgcn_readfirstlane(F.tid >> 6);
    F.G = gridDim.x; { const int bx = blockIdx.x; F.vcu = (F.G % 8 == 0) ? (bx % 8) * (F.G / 8) + bx / 8 : bx; }
    unsigned char* ws = args.ws;
    F.ctl = (gu32*)(ws + WS_CTL);
    F.x = args.in[0]; F.mem = args.in[1]; F.g_mix = args.in[2]; F.g_memn = args.in[3]; F.w_in = args.in[4]; F.b_forget = args.in[5]; F.g_fq = args.in[6]; F.g_fk = args.in[7];
    F.g_mq = args.in[8]; F.g_mk = args.in[9]; F.w_mkv = args.in[10]; F.w_bsb = args.in[11]; F.w_bfx = args.in[12]; F.w_bmm = args.in[13]; F.w_out = args.in[14]; F.g_mlp = args.in[15];
    F.w_up = args.in[16]; F.w_dn = args.in[17]; F.out = args.out;
    F.logf = (float*)(ws + WS_LOGF); F.FC = (float*)(ws + WS_FC); F.ssq = (float*)(ws + WS_SSQ); F.MKf = (float*)(ws + WS_MKF);
    F.Win_t = (bf16*)(ws + WS_WIN); F.Wmkv_t = (bf16*)(ws + WS_WMKV); F.Wbr_t = (bf16*)(ws + WS_WBR); F.Wout_t = (bf16*)(ws + WS_WOUT); F.Wup_t = (bf16*)(ws + WS_WUP); F.Wdn_t = (bf16*)(ws + WS_WDN);
    F.MHb = (bf16*)(ws + WS_MH); F.MV = (bf16*)(ws + WS_MV); F.XN = (bf16*)(ws + WS_XN);
    F.SBQ = (bf16*)(ws + WS_SBQ); F.SBK = (bf16*)(ws + WS_SBK); F.SBV = (bf16*)(ws + WS_SBV); F.FXQ = (bf16*)(ws + WS_FXQ); F.FXK = (bf16*)(ws + WS_FXK); F.FXV = (bf16*)(ws + WS_FXV); F.MQ = (bf16*)(ws + WS_MQ);
    F.G0 = (bf16*)args.out; F.G1 = (bf16*)args.out + (size_t)M * D; F.G2 = (bf16*)(ws + WS_G2); F.MRG = (bf16*)(ws + WS_MRG); F.U = (bf16*)(ws + WS_U);
    for (int u = F.tid; u < (LDS_BYTES - LDSCTL_OFF) / 4; u += NTHREADS) ((LAS unsigned*)(F.lds + LDSCTL_OFF))[u] = 0u;
    __syncthreads();
    XcdBarrier bar; bar.bar = (unsigned*)(F.ctl + CW_BAR); bar.x = 0; bar.st = nullptr;
    if (N_LAUNCHES == 1) bar = xcd_barrier_post((unsigned*)(F.ctl + CW_BAR), F.MISC + 8);
#define GRID_BAR() do { if (N_LAUNCHES == 1) xcd_barrier(bar); } while (0)
    const int lo = args.ph_lo, hi = args.ph_hi;
#define IN(k) (lo <= (k) && (k) < hi)
#define BOTH(k) (IN(k) && IN((k) + 1))
    const int wg = (int)blockIdx.x, nwg = F.G;
    unsigned long long ts_prev = 0ull, ts0 = 0ull; float probe = 0.f;
    if (TIMING_PHASE >= 0 && blockIdx.x == 0 && F.tid == 0) { ts0 = __builtin_amdgcn_s_memrealtime(); ts_prev = ts0; }
#define STAMP(k) do { if (TIMING_PHASE >= 0 && blockIdx.x == 0 && F.tid == 0) { const unsigned long long t_ = __builtin_amdgcn_s_memrealtime(); \
        if (TIMING_PHASE == (k)) probe = (float)(t_ - ts_prev) * 1e-5f; if (TIMING_PHASE == 8 && (k) == 7) probe = (float)(t_ - ts0) * 0.25e-5f; ts_prev = t_; } } while (0)

    if (IN(0)) { p0_prologue(F); if (BOTH(0)) GRID_BAR(); STAMP(0); }
    if (IN(1)) {
        fcumsum(F); VM_WAIT();
#if STAGGER_P1
        { if (F.tid == 0) { const unsigned long long t0 = __builtin_amdgcn_s_memrealtime(), dl = (unsigned long long)(((int)blockIdx.x >> 3) & 3) * STAGGER_P1; while (__builtin_amdgcn_s_memrealtime() - t0 < dl) __builtin_amdgcn_s_sleep(8); }
          __syncthreads(); }
#endif
#if OPT_P1
        { pg8::EpiProj E{F.SBQ, F.G0, F.G2, F.MKf, F.MV};
          pg8::SchedP1 S{F.G, (int)blockIdx.x, (const char*)F.XN, (const char*)F.Win_t};
          pg8::gemm_phase<pg8::EpiProj, pg8::SchedP1, false, true, 1, DE_P1>(F.lds, D, S, E);
          if (F.G == 256) { unsigned* qctr = (unsigned*)(F.ctl + CW_LWQ); volatile LAS unsigned* slot = F.MISC + 24;
              VM_WAIT(); __syncthreads();
              unsigned nx = 0; if (F.tid == 0) nx = __hip_atomic_fetch_add(qctr, 1u, __ATOMIC_RELAXED, __HIP_MEMORY_SCOPE_AGENT);
              for (;;) {
                  if (F.tid == 0) *slot = nx;
                  __syncthreads();
                  const unsigned idx = *slot;
                  if (idx * NWAVES >= (unsigned)LATE_ITEMS) break;
                  if (F.tid == 0) nx = __hip_atomic_fetch_add(qctr, 1u, __ATOMIC_RELAXED, __HIP_MEMORY_SCOPE_AGENT);
                  convert_late_weights(F, F.wave, LATE_ITEMS, (int)idx * NWAVES, (int)idx * NWAVES + NWAVES);
                  __syncthreads(); } } }
#else
        { EpiProjN E{F.SBQ, F.G0, F.G2}; ngemm(F.XN, D, F.Win_t, D, M, NPROJ, D, E, wg, nwg); }
        { EpiMkvN E{F.MKf, F.MV}; ngemm(F.MHb, D, F.Wmkv_t, D, MROWS, 1024, D, E, wg, nwg); }
#endif
        if (BOTH(1)) GRID_BAR();
        STAMP(1);
    }
    if (IN(2)) {
#if !OPT_P1
        headnorm_naive(F);
#endif
        if (BOTH(2)) { if (!OPT_P1) GRID_BAR(); } STAMP(2); }
    if (IN(3)) {
#if OPT_ATT
        for (int v = F.vcu; v < 256; v += F.G) { const int bh = v >> 2, s4 = v & 3;
            att::unit_sb(F.SBQ, F.SBK, F.SBV, F.SBQ, bh >> 3, bh & 7, 7 - s4, F.lds); __syncthreads();
            att::unit_sb(F.SBQ, F.SBK, F.SBV, F.SBQ, bh >> 3, bh & 7, s4, F.lds); __syncthreads();
            att::unit64<1>(F.FXQ, F.FXK, F.FXV, F.FXQ, F.FC, F.g_fq, F.g_fk, bh >> 3, bh & 7, 7 - s4, F.lds); __syncthreads();
            att::unit64<1>(F.FXQ, F.FXK, F.FXV, F.FXQ, F.FC, F.g_fq, F.g_fk, bh >> 3, bh & 7, s4, F.lds); __syncthreads(); }
#else
        nattn64<0>(F.SBQ, F.SBK, F.SBV, F.SBQ, F.FC, F.g_fq, F.g_fk, wg, nwg);
        nattn64<1>(F.FXQ, F.FXK, F.FXV, F.FXQ, F.FC, F.g_fq, F.g_fk, wg, nwg);
#endif
#if OPT_ATT
        for (int v = F.vcu; v < 256; v += F.G) { att::unit_mem(F.MQ, F.MKf, F.MV, F.g_mq, F.g_mk, v >> 5, (v >> 3) & 3, v & 7, F.lds); __syncthreads(); }
#else
        nattn_mem(F, wg, nwg);
#endif
        if (BOTH(3)) GRID_BAR();
        STAMP(3);
    }
    if (IN(4)) {
#if OPT_P3
        { pg8::SchedP3m S{F.G, (int)blockIdx.x, (const char*)F.SBQ, (const char*)F.Wbr_t};
          pg8::EpiMergedR E{F.G0, F.G2, F.MRG};
          pg8::gemm_phase<pg8::EpiMergedR, pg8::SchedP3m, true, true, 3>(F.lds, DH, S, E); }
#else
        nmerged(F, wg, nwg);
#endif
        if (BOTH(4)) GRID_BAR(); STAMP(4); }
    if (IN(5)) {
#if OPT_P4
        { pg8::SchedPlain S{64, 4, F.G, (int)blockIdx.x, (const char*)F.MRG, (const char*)F.Wout_t, (size_t)256 * D * 2};
          pg8::EpiOut E{F.x, F.out, F.XN, F.ssq};
          pg8::gemm_phase<pg8::EpiOut, pg8::SchedPlain, false, true, 4>(F.lds, D, S, E); }
#else
        { EpiOutN E{F.x, F.out, F.XN}; ngemm(F.MRG, D, F.Wout_t, D, M, D, D, E, wg, nwg); }
#endif
        if (BOTH(5)) GRID_BAR(); STAMP(5); }
    if (IN(6)) {
#if !OPT_P4
        ssq_naive(F);
        if (BOTH(6)) GRID_BAR();
#endif
    }
    if (IN(7)) {
#if OPT_P5
        {
          pg8::SchedPlain S{64, 16, F.G, (int)blockIdx.x, (const char*)F.XN, (const char*)F.Wup_t, (size_t)256 * D * 2};
          pg8::EpiUp E{F.U};
          pg8::gemm_phase<pg8::EpiUp, pg8::SchedPlain, true, true, 5, false>(F.lds, D, S, E); }
#else
        { EpiUpN E{F.ssq, F.U}; ngemm(F.XN, D, F.Wup_t, D, M, FF, D, E, wg, nwg); }
#endif
        if (BOTH(7)) GRID_BAR(); STAMP(7); }
    if (GPROBE != 0) { __syncthreads(); if (blockIdx.x == 0) probe = *(LAS float*)(F.lds + MISC_OFF + 64); }
    if (IN(8)) {
#if OPT_P6
        { pg8::SchedPlain S{64, 4, F.G, (int)blockIdx.x, (const char*)F.U, (const char*)F.Wdn_t, (size_t)256 * FF * 2};
          pg8::EpiDown E{F.out, F.ssq, probe, F.XN};
          pg8::gemm_phase<pg8::EpiDown, pg8::SchedPlain, false, true>(F.lds, FF, S, E); }
#else
        { EpiDnN E{F.out, F.ssq, F.XN}; ngemm(F.U, FF, F.Wdn_t, FF, M, D, FF, E, wg, nwg); }
#endif
    }
#undef IN
#undef BOTH
}

extern "C" void kernel_launch(void* const* d_in, const int* in_sizes, int n_in, void* d_out, int out_size, void* d_ws, size_t ws_size, hipStream_t stream) {
    static int grid = 0;
    if (grid == 0) {
        if (n_in != 18 || in_sizes[0] != M * D || out_size != M * D || ws_size < WS_END) { fprintf(stderr, "kernel_launch: unexpected shapes (n_in %d, in0 %d, out %d, ws %zu); nothing launched\n", n_in, n_in > 0 ? in_sizes[0] : -1, out_size, ws_size); grid = -1; return; }
        int dev = 0, cus = 0, per_cu = 0;
        if (hipGetDevice(&dev) != hipSuccess || hipDeviceGetAttribute(&cus, hipDeviceAttributeMultiprocessorCount, dev) != hipSuccess) { grid = -1; return; }
        if (hipFuncSetAttribute((const void*)skel_fwd, hipFuncAttributeMaxDynamicSharedMemorySize, LDS_BYTES) != hipSuccess) { fprintf(stderr, "kernel_launch: hipFuncSetAttribute failed\n"); grid = -1; return; }
        if (hipOccupancyMaxActiveBlocksPerMultiprocessor(&per_cu, (const void*)skel_fwd, NTHREADS, LDS_BYTES) != hipSuccess || per_cu < 1) fprintf(stderr, "kernel_launch: occupancy query reports %d\n", per_cu);
        (void)hipGetLastError();
        grid = cus;
    }
    if (grid < 0) return;
    if (hipMemsetAsync((char*)d_ws + WS_CTL, 0, CTL_ZERO_BYTES, stream) != hipSuccess) return;
    Args a{};
    for (int i = 0; i < 18; ++i) a.in[i] = (const float*)d_in[i];
    a.out = (float*)d_out; a.ws = (unsigned char*)d_ws;
    for (int li = 0; li < N_LAUNCHES; ++li) {
        a.ph_lo = (N_LAUNCHES == 1) ? 0 : li; a.ph_hi = (N_LAUNCHES == 1) ? N_PHASES : li + 1; a.li = li;
        hipLaunchKernelGGL(skel_fwd, dim3(grid), dim3(NTHREADS), LDS_BYTES, stream, a);
        if (hipPeekAtLastError() != hipSuccess) break;
    }
}
```

```cpp
#include <hip/hip_runtime.h>
#include <cstdio>
#include <cstdint>
#ifndef TIMING_PHASE
#ifndef GPROBE
#define GPROBE 0
#endif
#ifndef GPSEL
#define GPSEL 0
#endif
#ifndef GPOFF
#define GPOFF 0.f
#endif
#ifndef GPSCALE
#define GPSCALE 1.f
#endif
#define TIMING_PHASE -1
#endif

#define GAS __attribute__((address_space(1)))
#define LAS __attribute__((address_space(3)))
typedef unsigned short bf16;
typedef short bf16x8 __attribute__((ext_vector_type(8)));
typedef float f32x4 __attribute__((ext_vector_type(4)));
typedef unsigned v4u __attribute__((ext_vector_type(4)));
typedef GAS unsigned gu32;
#define RLX_AGENT __ATOMIC_RELAXED, __HIP_MEMORY_SCOPE_AGENT
#define LDS_WAIT() asm volatile("s_waitcnt lgkmcnt(0)" ::: "memory")
#define VM_WAIT() asm volatile("s_waitcnt vmcnt(0)" ::: "memory")

constexpr int NWAVES = 8, NTHREADS = 512;
constexpr int BATCH = 8, SEQ = 2048, M = BATCH * SEQ, D = 1024, MEMLEN = 256, MROWS = BATCH * MEMLEN;
constexpr int HD = 64, NH = 8, MNH = 4, MHD = 128, DH = 512, FF = 4096;
constexpr int DIN = 6664, NPROJ = 6656;
constexpr float EPS = 1e-6f, LOG2E = 1.4426950408889634f, LN2 = 0.6931471805599453f;
constexpr float C2 = 0.125f * LOG2E;
constexpr float C2M = 0.08838834764831845f * LOG2E;

constexpr size_t MiB = 1u << 20;
constexpr size_t WS_CTL = 0, CTL_ZERO_BYTES = 65536;
constexpr size_t WS_LOGF = 1 * MiB, WS_FC = 1 * MiB + 512 * 1024, WS_SSQ = 2 * MiB;
constexpr size_t WS_WIN = 3 * MiB, WS_WMKV = 16 * MiB, WS_WBR = 18 * MiB, WS_WOUT = 21 * MiB, WS_WUP = 23 * MiB, WS_WDN = 31 * MiB;
constexpr size_t WS_MV = 39 * MiB, WS_XN = 44 * MiB, WS_MH = 76 * MiB;
constexpr size_t WS_T1 = 96 * MiB, WS_T2 = 144 * MiB;
constexpr size_t WS_SBQ = 80 * MiB, WS_SBK = 96 * MiB, WS_SBV = 112 * MiB, WS_FXQ = 128 * MiB, WS_FXK = 144 * MiB, WS_FXV = 160 * MiB, WS_MQ = 176 * MiB;
constexpr size_t WS_G2 = 192 * MiB, WS_MRG = 224 * MiB, WS_MKF = 224 * MiB, WS_U = 80 * MiB, WS_END = 256 * MiB;
constexpr int CW_BAR = 4096, CW_LWQ = 2048;

constexpr int RING_BYTES = 131072, LDSCTL_OFF = 147456, MISC_OFF = LDSCTL_OFF + 320, LDS_BYTES = 163840;

__device__ __forceinline__ unsigned f2bf(float f) { unsigned u = __builtin_bit_cast(unsigned, f); return (u + 0x7fffu + ((u >> 16) & 1u)) >> 16; }
__device__ __forceinline__ unsigned pk2(float lo, float hi) { return f2bf(lo) | (f2bf(hi) << 16); }
__device__ __forceinline__ float bf2f(unsigned b) { return __uint_as_float(b << 16); }
__device__ __forceinline__ float bflo(unsigned w) { return __uint_as_float(w << 16); }
__device__ __forceinline__ float bfhi(unsigned w) { return __uint_as_float(w & 0xffff0000u); }
__device__ __forceinline__ float wave_sum(float v) {
#pragma unroll
    for (int o = 1; o < 64; o <<= 1) v += __shfl_xor(v, o);
    return v;
}
__device__ __forceinline__ float log_sigmoid_f(float x) { return fminf(x, 0.f) - log1pf(expf(-fabsf(x))); }

#define XB_TMO      128
#define XB_XCNT(j)  (256  + 64 * (j))
#define XB_XSUB(j)  (1280 + 64 * (j))
#define XB_XGEN(j)  (2304 + 64 * (j))
#define XB_TOP      3328
#define XB_TOPGEN   3392
#define XCD_BAR_WORDS 3456
#define XB_SPIN_CAP (1u << 18)
__device__ __forceinline__ unsigned xb_ld(unsigned* p)              { return __hip_atomic_load(p, __ATOMIC_RELAXED, __HIP_MEMORY_SCOPE_AGENT); }
__device__ __forceinline__ unsigned xb_add(unsigned* p, unsigned v) { return __hip_atomic_fetch_add(p, v, __ATOMIC_RELAXED, __HIP_MEMORY_SCOPE_AGENT); }
__device__ __forceinline__ unsigned xb_xcc_id() { return (unsigned)__builtin_amdgcn_s_getreg((3 << 11) | 20) & 0xFu; }
#define XB_SPIN(cond, bar) do { unsigned _sp = 0; while (cond) { __builtin_amdgcn_s_sleep(1); \
    if ((++_sp & 255u) == 0u) { if (xb_ld(&(bar)[XB_TMO])) break; if (_sp > XB_SPIN_CAP) { atomicAdd(&(bar)[XB_TMO], 1u); break; } } } } while (0)
struct XcdBarrier { unsigned* bar; unsigned x; volatile LAS unsigned* st; };
__device__ __forceinline__ XcdBarrier xcd_barrier_post(unsigned* bar, volatile LAS unsigned* st) {
    XcdBarrier b; b.bar = bar; b.x = xb_xcc_id(); b.st = st;
    if (threadIdx.x == 0) (void)xb_add(&bar[XB_XCNT(b.x)], 1u);
    return b;
}
__device__ __forceinline__ void xcd_barrier_complete(unsigned* bar, unsigned x, unsigned& nloc, unsigned& nx) {
    const unsigned G = gridDim.x * gridDim.y * gridDim.z;
    unsigned sum, cnt, mine, sp = 0u;
    for (;;) {
        sum = 0u; cnt = 0u; mine = 0u;
#pragma unroll
        for (unsigned j = 0; j < 16; ++j) { const unsigned c = xb_ld(&bar[XB_XCNT(j)]); sum += c; cnt += (c > 0u) ? 1u : 0u; mine = (j == x) ? c : mine; }
        if (sum == G) break;
        __builtin_amdgcn_s_sleep(1);
        if ((++sp & 255u) == 0u) { if (xb_ld(&bar[XB_TMO])) break; if (sp > XB_SPIN_CAP) { atomicAdd(&bar[XB_TMO], 1u); break; } }
    }
    nloc = mine > 0u ? mine : 1u; nx = cnt > 0u ? cnt : 1u;
}
__device__ __forceinline__ void xcd_barrier(const XcdBarrier& b) {
    asm volatile("s_waitcnt vmcnt(0)" ::: "memory");
    __syncthreads();
    if (threadIdx.x == 0) {
        unsigned* bar = b.bar;
        __builtin_amdgcn_s_waitcnt(0);
        unsigned nloc = b.st[0], nx = b.st[1];
        if (nloc == 0u) { xcd_barrier_complete(bar, b.x, nloc, nx); b.st[0] = nloc; b.st[1] = nx; }
        const unsigned old = xb_add(&bar[XB_XSUB(b.x)], 1u);
        const unsigned gen = old / nloc;
        if (old + 1u == (gen + 1u) * nloc) {
            __builtin_amdgcn_fence(__ATOMIC_RELEASE, "agent");
            asm volatile("s_waitcnt vmcnt(0)" ::: "memory");
            const unsigned og = xb_add(&bar[XB_TOP], 1u);
            const unsigned tg = og / nx;
            if (og + 1u == (tg + 1u) * nx) xb_add(&bar[XB_TOPGEN], 1u);
            else XB_SPIN(xb_ld(&bar[XB_TOPGEN]) == tg, bar);
            __builtin_amdgcn_fence(__ATOMIC_ACQUIRE, "agent");
            xb_add(&bar[XB_XGEN(b.x)], 1u);
            asm volatile("s_waitcnt vmcnt(0)" ::: "memory");
        } else {
            XB_SPIN(xb_ld(&bar[XB_XGEN(b.x)]) == gen, bar);
            __builtin_amdgcn_fence(__ATOMIC_ACQUIRE, "agent");
            asm volatile("s_waitcnt vmcnt(0)" ::: "memory");
        }
    }
    __syncthreads();
}

struct Frame {
    LAS unsigned char* lds;
    volatile LAS unsigned* MISC;
    gu32* ctl;
    int tid, lane, wave, vcu, G;
    const float *x, *mem, *g_mix, *g_memn, *w_in, *b_forget, *g_fq, *g_fk, *g_mq, *g_mk, *w_mkv, *w_bsb, *w_bfx, *w_bmm, *w_out, *g_mlp, *w_up, *w_dn;
    float* out;
    float *logf, *FC, *ssq, *MKf;
    bf16 *Win_t, *Wmkv_t, *Wbr_t, *Wout_t, *Wup_t, *Wdn_t, *MHb, *MV, *XN, *SBQ, *SBK, *SBV, *FXQ, *FXK, *FXV, *MQ, *G0, *G1, *G2, *MRG, *U;
};

__device__ __forceinline__ void tr_item(const float* W, int ldw, int K, bf16* WT, int src_c0, int dst_r0, int k0, LAS float* scr, int lane, const float* kgain = nullptr, const float cscale = 1.0f) {
    float wv[32];
#pragma unroll
    for (int i = 0; i < 32; ++i) { const int kk = 2 * i + (lane >> 5); wv[i] = __builtin_nontemporal_load(W + (size_t)(k0 + kk) * ldw + src_c0 + (lane & 31)); }
#pragma unroll
    for (int i = 0; i < 32; ++i) { const int kk = 2 * i + (lane >> 5); float w = wv[i] * cscale; if (kgain) w *= kgain[k0 + kk]; scr[kk * 33 + (lane & 31)] = w; }
    LDS_WAIT(); asm volatile("" ::: "memory");
    const int c = lane & 7;
#pragma unroll
    for (int j = 0; j < 4; ++j) { const int n = (lane >> 3) + 8 * j; const LAS float* s = scr + (8 * c) * 33 + n;
        v4u o; o.x = pk2(s[0 * 33], s[1 * 33]); o.y = pk2(s[2 * 33], s[3 * 33]); o.z = pk2(s[4 * 33], s[5 * 33]); o.w = pk2(s[6 * 33], s[7 * 33]);
        *(GAS v4u*)(WT + (size_t)(dst_r0 + n) * K + k0 + 8 * c) = o; }
    LDS_WAIT(); asm volatile("" ::: "memory");
}
__host__ __device__ __forceinline__ int proj_src_col(int n) {
    const int pn = n >> 8, j = n & 255;
    if (pn < 12) { const int T = pn >> 1, bj = j >> 7, wc = (j >> 5) & 3, e = j & 31; return T * 512 + ((pn & 1) * 4 + wc) * 64 + bj * 32 + e; }
    const int bj = j >> 7, wc = (j >> 5) & 3, e = j & 31, t = 64 * wc + 32 * bj + e;
    if (pn < 14) return 3080 + (pn - 12) * 256 + t;
    return 3592 + (pn - 14) * 256 + t;
}
template <bool IS_X>
__device__ __forceinline__ void p0_rows(Frame& F, const float* srcb, const float* g, bf16* dstb, int nrows, const LAS float* wf, int gw, int NGW) {
    const GAS f32x4* gr = (const GAS f32x4*)g + F.lane;
    f32x4 wfr[4][4][2];
    if (IS_X) {
#pragma unroll
        for (int j = 0; j < 4; ++j)
#pragma unroll
            for (int e = 0; e < 4; ++e) { const LAS f32x4* wp = (const LAS f32x4*)(wf + (256 * j + 4 * F.lane + e) * 8); wfr[j][e][0] = wp[0]; wfr[j][e][1] = wp[1]; } }
    f32x4 nx[4];
    if (gw < nrows) { const GAS f32x4* xr = (const GAS f32x4*)(srcb + (size_t)gw * D) + F.lane;
#pragma unroll
        for (int j = 0; j < 4; ++j) nx[j] = IS_X ? xr[64 * j] : __builtin_nontemporal_load(xr + 64 * j);     }
    for (int m = gw; m < nrows; m += NGW) {
        f32x4 v[4]; float s = 0.f;
#pragma unroll
        for (int j = 0; j < 4; ++j) v[j] = nx[j];
        if (m + NGW < nrows) { const GAS f32x4* xr = (const GAS f32x4*)(srcb + (size_t)(m + NGW) * D) + F.lane;
#pragma unroll
            for (int j = 0; j < 4; ++j) nx[j] = IS_X ? xr[64 * j] : __builtin_nontemporal_load(xr + 64 * j);     }
#pragma unroll
        for (int j = 0; j < 4; ++j) s += (v[j].x * v[j].x + v[j].y * v[j].y) + (v[j].z * v[j].z + v[j].w * v[j].w);
        const float rstd = __builtin_amdgcn_rsqf(wave_sum(s) * (1.f / D) + EPS);
#pragma unroll
        for (int j = 0; j < 4; ++j) { const f32x4 gg = gr[64 * j]; v[j] = v[j] * rstd * gg; }
        GAS unsigned long long* o8 = (GAS unsigned long long*)(dstb + (size_t)m * D) + F.lane;
#pragma unroll
        for (int j = 0; j < 4; ++j) o8[64 * j] = (unsigned long long)pk2(v[j].x, v[j].y) | ((unsigned long long)pk2(v[j].z, v[j].w) << 32);
        if (IS_X) {
            float fl[8];
#pragma unroll
            for (int c = 0; c < 8; ++c) fl[c] = 0.f;
#pragma unroll
            for (int j = 0; j < 4; ++j)
#pragma unroll
                for (int e = 0; e < 4; ++e) { const float hv = v[j][e]; const f32x4 w0 = wfr[j][e][0], w1 = wfr[j][e][1];
                    fl[0] += hv * w0.x; fl[1] += hv * w0.y; fl[2] += hv * w0.z; fl[3] += hv * w0.w; fl[4] += hv * w1.x; fl[5] += hv * w1.y; fl[6] += hv * w1.z; fl[7] += hv * w1.w; }
            float mine = 0.f;
#pragma unroll
            for (int c = 0; c < 8; ++c) { const float t = wave_sum(fl[c]); if (F.lane == c) mine = t; }
            if (F.lane < 8) F.logf[(size_t)m * 8 + F.lane] = log_sigmoid_f(mine + F.b_forget[F.lane]);
        }
    }
}
constexpr int LATE_ITEMS = 3 * 8 * 32 + 16 * 32 + 16 * 128 + 64 * 32;
__device__ __forceinline__ void convert_late_weights(Frame& F, int w, int nw, const int lo = 0, const int NITEMS = LATE_ITEMS) {
    LAS float* scr = (LAS float*)(F.lds + F.wave * 8448);
    constexpr int I_BR = 8 * 32, I_OUT = 16 * 32, I_UP = 16 * 128;
    for (int it = lo + w; it < NITEMS; it += nw) {
        int r = it;
        if (r < I_BR) { const int kb = r / 32, gi = r % 32; tr_item(F.w_bsb, D, DH, F.Wbr_t, 32 * gi, 32 * gi, 64 * kb, scr, F.lane); continue; } r -= I_BR;
        if (r < I_BR) { const int kb = r / 32, gi = r % 32; tr_item(F.w_bfx, D, DH, F.Wbr_t + (size_t)D * DH, 32 * gi, 32 * gi, 64 * kb, scr, F.lane); continue; } r -= I_BR;
        if (r < I_BR) { const int kb = r / 32, gi = r % 32; tr_item(F.w_bmm, D, DH, F.Wbr_t + (size_t)2 * D * DH, 32 * gi, 32 * gi, 64 * kb, scr, F.lane); continue; } r -= I_BR;
        if (r < I_OUT) { const int kb = r / 32, gi = r % 32; tr_item(F.w_out, D, D, F.Wout_t, 32 * gi, 32 * gi, 64 * kb, scr, F.lane); continue; } r -= I_OUT;
        if (r < I_UP) { const int kb = r / 128, gi = r % 128; tr_item(F.w_up, FF, D, F.Wup_t, 32 * gi, 32 * gi, 64 * kb, scr, F.lane, F.g_mlp); continue; } r -= I_UP;
        { const int kb = r / 32, gi = r % 32; tr_item(F.w_dn, D, FF, F.Wdn_t, 32 * gi, 32 * gi, 64 * kb, scr, F.lane); }
    }
}
__device__ __forceinline__ void p0_prologue(Frame& F) {
    LAS float* scr = (LAS float*)(F.lds + F.wave * 8448);
    LAS float* wf = (LAS float*)(F.lds + 8 * 8448);
    for (int i = F.tid; i < D * 8; i += NTHREADS) wf[i] = F.w_in[(size_t)(i >> 3) * DIN + 3072 + (i & 7)];
    const int gw = F.vcu * NWAVES + F.wave, NGW = F.G * NWAVES;
    constexpr int I_IN = 16 * 208, I_MKV = 16 * 32, NITEMS = I_IN + I_MKV;
    for (int it = gw; it < NITEMS; it += NGW) {
        int r = it;
        if (r < I_IN) { const int kb = r / 208, gi = r % 208; tr_item(F.w_in, DIN, D, F.Win_t, proj_src_col(32 * gi), 32 * gi, 64 * kb, scr, F.lane, nullptr, gi >= 14 * 8 ? -LOG2E : 1.0f); continue; } r -= I_IN;
        { const int kb = r / 32, gi = r % 32; tr_item(F.w_mkv, 1024, D, F.Wmkv_t, 32 * gi, 32 * gi, 64 * kb, scr, F.lane); }
    }
    if (F.G != 256) { __syncthreads(); convert_late_weights(F, gw, NGW); }
    __syncthreads();
    p0_rows<true>(F, F.x, F.g_mix, F.XN, M, wf, gw, NGW);
    p0_rows<false>(F, F.mem, F.g_memn, F.MHb, MROWS, wf, gw, NGW);
}

template <class Epi>
__device__ __forceinline__ void ngemm(const bf16* A, int lda, const bf16* Bt, int ldb, int Mr, int Nc, int K, const Epi& E, int wg, int nwg) {
    const int tid = threadIdx.x, lane = tid & 63, wid = tid >> 6, wm = wid >> 1, wn = wid & 1;
    const int tilesN = Nc / 128, ntiles = (Mr / 128) * tilesN;
    for (int t = wg; t < ntiles; t += nwg) {
        const int tm = t / tilesN, tn = t % tilesN, r0 = tm * 128 + wm * 32, c0 = tn * 128 + wn * 64;
        f32x4 acc[2][4];
#pragma unroll
        for (int m = 0; m < 2; ++m)
#pragma unroll
            for (int n = 0; n < 4; ++n) acc[m][n] = (f32x4){0.f, 0.f, 0.f, 0.f};
        const bf16* ap = A + (size_t)(r0 + (lane & 15)) * lda + 8 * (lane >> 4);
        const bf16* bp = Bt + (size_t)(c0 + (lane & 15)) * ldb + 8 * (lane >> 4);
        for (int k0 = 0; k0 < K; k0 += 32) {
            bf16x8 a[2], b[4];
#pragma unroll
            for (int m = 0; m < 2; ++m) a[m] = *(const bf16x8*)(ap + (size_t)(m * 16) * lda + k0);
#pragma unroll
            for (int n = 0; n < 4; ++n) b[n] = *(const bf16x8*)(bp + (size_t)(n * 16) * ldb + k0);
#pragma unroll
            for (int m = 0; m < 2; ++m)
#pragma unroll
                for (int n = 0; n < 4; ++n) acc[m][n] = __builtin_amdgcn_mfma_f32_16x16x32_bf16(a[m], b[n], acc[m][n], 0, 0, 0);
        }
#pragma unroll
        for (int m = 0; m < 2; ++m)
#pragma unroll
            for (int n = 0; n < 4; ++n)
#pragma unroll
                for (int j = 0; j < 4; ++j) E(r0 + m * 16 + (lane >> 4) * 4 + j, c0 + n * 16 + (lane & 15), acc[m][n][j]);
    }
}

struct EpiProjN {
    bf16 *SBQ, *G0, *G2;
    __device__ __forceinline__ void operator()(int row, int n, float v) const {
        const int pn = n >> 8, j = n & 255;
        if (pn < 12) { const int T = pn >> 1, bj = j >> 7, wc = (j >> 5) & 3, e = j & 31, c = ((pn & 1) * 4 + wc) * 64 + bj * 32 + e;
            if (T == 0) v *= C2;
            (SBQ + (size_t)T * M * DH)[(size_t)row * DH + c] = (bf16)f2bf(v); }
        else if (pn < 14) { (SBQ + (size_t)6 * M * DH)[(size_t)row * DH + (n - 12 * 256)] = (bf16)f2bf(v); }
        else { const int g = (pn - 14) >> 2, c = n - (14 + 4 * g) * 256; bf16* G = g < 2 ? G0 + (size_t)g * M * D : G2;
            G[(size_t)row * D + c] = (bf16)f2bf(1.0f / (1.0f + expf(-v))); }
    }
};
struct EpiMkvN { float* MKf; bf16* MV;
    __device__ __forceinline__ void operator()(int row, int n, float v) const { if (n < DH) MKf[(size_t)row * DH + n] = v; else MV[(size_t)row * DH + (n - DH)] = (bf16)f2bf(v); } };
struct EpiOutN { const float* x; float* x1; bf16* A2;
    __device__ __forceinline__ void operator()(int row, int n, float v) const { const size_t o = (size_t)row * D + n; const float r = x[o] + v; A2[o] = (bf16)f2bf(r); } };
struct EpiUpN { const float* ssq; bf16* U;
    __device__ __forceinline__ void operator()(int row, int n, float v) const {
        const f32x4* p = (const f32x4*)(ssq + (size_t)row * 16); const f32x4 a = p[0], b = p[1], c = p[2], d = p[3];
        const float ss = ((a.x + a.y) + (a.z + a.w)) + ((b.x + b.y) + (b.z + b.w)) + ((c.x + c.y) + (c.z + c.w)) + ((d.x + d.y) + (d.z + d.w));
        (void)ss; const float r = fmaxf(v, 0.f); U[(size_t)row * FF + n] = (bf16)f2bf(r * r); } };
struct EpiDnN { float* out; const float* ssq; const bf16* A2;
    __device__ __forceinline__ void operator()(int row, int n, float v) const { const size_t o = (size_t)row * D + n;
        const f32x4* p = (const f32x4*)(ssq + (size_t)row * 16); const f32x4 a = p[0], b = p[1], c = p[2], d = p[3];
        const float ss = ((a.x + a.y) + (a.z + a.w)) + ((b.x + b.y) + (b.z + b.w)) + ((c.x + c.y) + (c.z + c.w)) + ((d.x + d.y) + (d.z + d.w));
        out[o] = bf2f(A2[o]) + v / (ss * (1.f / D) + EPS); } };

__device__ __forceinline__ void fcumsum(Frame& F) {
    const int gw = F.vcu * NWAVES + F.wave;
    if (gw >= BATCH * NH) return;
    const int b = gw >> 3, h = gw & 7;
    const float* src = F.logf + ((size_t)b * SEQ + 32 * F.lane) * 8 + h;
    float v[32], tot = 0.f;
#pragma unroll
    for (int i = 0; i < 32; ++i) v[i] = src[i * 8];
#pragma unroll
    for (int i = 0; i < 32; ++i) tot += v[i];
    float incl = tot;
#pragma unroll
    for (int off = 1; off < 64; off <<= 1) { const float y = __shfl_up(incl, off); if (F.lane >= off) incl += y; }
    float run = incl - tot;
    float* dst = F.FC + (size_t)gw * SEQ + 32 * F.lane;
#pragma unroll
    for (int i = 0; i < 32; i += 4) { f32x4 o; run += v[i]; o.x = run; run += v[i + 1]; o.y = run; run += v[i + 2]; o.z = run; run += v[i + 3]; o.w = run; *(f32x4*)(dst + i) = o; }
}

__device__ __forceinline__ void headnorm_naive(Frame& F) {
    const int gw = F.vcu * NWAVES + F.wave, NGW = F.G * NWAVES;
    for (int it = gw; it < 2 * M; it += NGW) {
        const int which = it / M, row = it % M;
        bf16* p = F.FXQ + (size_t)which * M * DH + (size_t)row * DH + 8 * F.lane;
        const v4u w = *(const v4u*)p; float v[8] = {bflo(w.x), bfhi(w.x), bflo(w.y), bfhi(w.y), bflo(w.z), bfhi(w.z), bflo(w.w), bfhi(w.w)};
        float s = 0.f;
#pragma unroll
        for (int i = 0; i < 8; ++i) s += v[i] * v[i];
        s += __shfl_xor(s, 1); s += __shfl_xor(s, 2); s += __shfl_xor(s, 4);
        const float sc = (1.0f / sqrtf(s * (1.f / HD) + EPS)) * (which == 0 ? C2 : 1.0f);
#pragma unroll
        for (int i = 0; i < 8; ++i) v[i] = v[i] * sc;
        v4u o; o.x = pk2(v[0], v[1]); o.y = pk2(v[2], v[3]); o.z = pk2(v[4], v[5]); o.w = pk2(v[6], v[7]);
        *(v4u*)p = o;
    }
}

template <int MODE>
__device__ __forceinline__ void nattn64(const bf16* Q, const bf16* K, const bf16* V, bf16* O, const float* FC, const float* gq, const float* gk, int wg, int nwg) {
    const int tid = threadIdx.x, half = tid & 1;
    for (int u = wg; u < 512; u += nwg) {
        const int b = u >> 6, h = (u >> 3) & 7, blk = u & 7, t = blk * 256 + (tid >> 1); const size_t row = (size_t)b * SEQ + t;
        float q[32], o[32];
        { const v4u* qp = (const v4u*)(Q + row * DH + h * HD + half * 32);
#pragma unroll
          for (int i = 0; i < 4; ++i) { const v4u w = qp[i]; q[8 * i] = bflo(w.x); q[8 * i + 1] = bfhi(w.x); q[8 * i + 2] = bflo(w.y); q[8 * i + 3] = bfhi(w.y); q[8 * i + 4] = bflo(w.z); q[8 * i + 5] = bfhi(w.z); q[8 * i + 6] = bflo(w.w); q[8 * i + 7] = bfhi(w.w); } }
        if (MODE == 1) {
#pragma unroll
            for (int d = 0; d < 32; ++d) q[d] *= gq[half * 32 + d] * gk[half * 32 + d]; }
#pragma unroll
        for (int d = 0; d < 32; ++d) o[d] = 0.f;
        const int kend = blk * 256 + 256;
        const bf16* Kb = K + (size_t)b * SEQ * DH + h * HD + half * 32; const bf16* Vb = V + (size_t)b * SEQ * DH + h * HD + half * 32;
        const float* Fs = FC + (size_t)(b * NH + h) * SEQ;
        float carry = 0.f, mrun = -1e30f, lrun = 0.f;
        for (int i = 0; i < kend; ++i) {
            const int s = MODE == 0 ? kend - 1 - i : i;
            const v4u* kp = (const v4u*)(Kb + (size_t)s * DH); const v4u* vp = (const v4u*)(Vb + (size_t)s * DH);
            float z = 0.f;
#pragma unroll
            for (int c = 0; c < 4; ++c) { const v4u w = kp[c];
                z += q[8 * c] * bflo(w.x) + q[8 * c + 1] * bfhi(w.x) + q[8 * c + 2] * bflo(w.y) + q[8 * c + 3] * bfhi(w.y) + q[8 * c + 4] * bflo(w.z) + q[8 * c + 5] * bfhi(w.z) + q[8 * c + 6] * bflo(w.w) + q[8 * c + 7] * bfhi(w.w); }
            z += __shfl_xor(z, 1);
            float wgt;
            if (MODE == 0) {
                const float zn = z * LN2; const bool strict = s < t;
                const float lr = log_sigmoid_f(-zn), ls = zn + lr;
                wgt = strict ? expf(ls + carry) : 0.f; carry += strict ? lr : 0.f;
            } else {
                const float z2 = (s <= t) ? z - Fs[s] * LOG2E : -1e30f;
                const float mn = fmaxf(mrun, z2), al = exp2f(mrun - mn); wgt = (s <= t) ? exp2f(z2 - mn) : 0.f;
                lrun = lrun * al + wgt; mrun = mn;
#pragma unroll
                for (int d = 0; d < 32; ++d) o[d] *= al;
            }
#pragma unroll
            for (int c = 0; c < 4; ++c) { const v4u w = vp[c];
                o[8 * c] += wgt * bflo(w.x); o[8 * c + 1] += wgt * bfhi(w.x); o[8 * c + 2] += wgt * bflo(w.y); o[8 * c + 3] += wgt * bfhi(w.y); o[8 * c + 4] += wgt * bflo(w.z); o[8 * c + 5] += wgt * bfhi(w.z); o[8 * c + 6] += wgt * bflo(w.w); o[8 * c + 7] += wgt * bfhi(w.w); }
        }
        const float inv = MODE == 0 ? 1.0f : 1.0f / lrun;
        v4u* op = (v4u*)(O + row * DH + h * HD + half * 32);
#pragma unroll
        for (int i = 0; i < 4; ++i) { v4u w; w.x = pk2(o[8 * i] * inv, o[8 * i + 1] * inv); w.y = pk2(o[8 * i + 2] * inv, o[8 * i + 3] * inv); w.z = pk2(o[8 * i + 4] * inv, o[8 * i + 5] * inv); w.w = pk2(o[8 * i + 6] * inv, o[8 * i + 7] * inv); op[i] = w; }
    }
}
__device__ __forceinline__ void nattn_mem(Frame& F, int wg, int nwg) {
    const int tid = threadIdx.x, qt = tid & 3;
    for (int u = wg; u < 512; u += nwg) {
        const int b = u >> 6, hm = (u >> 4) & 3, blk = u & 15, t = blk * 128 + (tid >> 2); const size_t row = (size_t)b * SEQ + t;
        float q[32], o[32];
        { const v4u* qp = (const v4u*)(F.MQ + row * DH + hm * MHD + qt * 32);
#pragma unroll
          for (int i = 0; i < 4; ++i) { const v4u w = qp[i]; q[8 * i] = bflo(w.x); q[8 * i + 1] = bfhi(w.x); q[8 * i + 2] = bflo(w.y); q[8 * i + 3] = bfhi(w.y); q[8 * i + 4] = bflo(w.z); q[8 * i + 5] = bfhi(w.z); q[8 * i + 6] = bflo(w.w); q[8 * i + 7] = bfhi(w.w); } }
        float ss = 0.f;
#pragma unroll
        for (int d = 0; d < 32; ++d) ss += q[d] * q[d];
        ss += __shfl_xor(ss, 1); ss += __shfl_xor(ss, 2);
        const float rq = (1.0f / sqrtf(ss * (1.f / MHD) + EPS)) * C2M;
#pragma unroll
        for (int d = 0; d < 32; ++d) { q[d] = q[d] * rq * F.g_mq[qt * 32 + d] * F.g_mk[qt * 32 + d]; o[d] = 0.f; }
        float mrun = -1e30f, lrun = 0.f;
        for (int key = 0; key < MEMLEN; ++key) {
            const f32x4* kp = (const f32x4*)(F.MKf + (size_t)(b * MEMLEN + key) * DH + hm * MHD + qt * 32);
            const v4u* vp = (const v4u*)(F.MV + (size_t)(b * MEMLEN + key) * DH + hm * MHD + qt * 32);
            float dot = 0.f, kss = 0.f;
#pragma unroll
            for (int c = 0; c < 8; ++c) { const f32x4 k4 = kp[c]; dot += q[4 * c] * k4.x + q[4 * c + 1] * k4.y + q[4 * c + 2] * k4.z + q[4 * c + 3] * k4.w; kss += k4.x * k4.x + k4.y * k4.y + k4.z * k4.z + k4.w * k4.w; }
            dot += __shfl_xor(dot, 1); dot += __shfl_xor(dot, 2); kss += __shfl_xor(kss, 1); kss += __shfl_xor(kss, 2);
            const float z2 = dot * (1.0f / sqrtf(kss * (1.f / MHD) + EPS));
            const float mn = fmaxf(mrun, z2), al = exp2f(mrun - mn), wgt = exp2f(z2 - mn);
            lrun = lrun * al + wgt; mrun = mn;
#pragma unroll
            for (int c = 0; c < 4; ++c) { const v4u w = vp[c];
                o[8 * c] = o[8 * c] * al + wgt * bflo(w.x); o[8 * c + 1] = o[8 * c + 1] * al + wgt * bfhi(w.x); o[8 * c + 2] = o[8 * c + 2] * al + wgt * bflo(w.y); o[8 * c + 3] = o[8 * c + 3] * al + wgt * bfhi(w.y);
                o[8 * c + 4] = o[8 * c + 4] * al + wgt * bflo(w.z); o[8 * c + 5] = o[8 * c + 5] * al + wgt * bfhi(w.z); o[8 * c + 6] = o[8 * c + 6] * al + wgt * bflo(w.w); o[8 * c + 7] = o[8 * c + 7] * al + wgt * bfhi(w.w); }
        }
        const float inv = 1.0f / lrun;
        v4u* op = (v4u*)(F.MQ + row * DH + hm * MHD + qt * 32);
#pragma unroll
        for (int i = 0; i < 4; ++i) { v4u w; w.x = pk2(o[8 * i] * inv, o[8 * i + 1] * inv); w.y = pk2(o[8 * i + 2] * inv, o[8 * i + 3] * inv); w.z = pk2(o[8 * i + 4] * inv, o[8 * i + 5] * inv); w.w = pk2(o[8 * i + 6] * inv, o[8 * i + 7] * inv); op[i] = w; }
    }
}

__device__ __forceinline__ void nmerged(Frame& F, int wg, int nwg) {
    const int tid = threadIdx.x, lane = tid & 63, wid = tid >> 6, wm = wid >> 1, wn = wid & 1;
    const int tilesN = D / 128, ntiles = (M / 128) * tilesN;
    for (int t = wg; t < ntiles; t += nwg) {
        const int tm = t / tilesN, tn = t % tilesN, r0 = tm * 128 + wm * 32, c0 = tn * 128 + wn * 64;
        f32x4 tot[2][4];
#pragma unroll
        for (int m = 0; m < 2; ++m)
#pragma unroll
            for (int n = 0; n < 4; ++n) tot[m][n] = (f32x4){0.f, 0.f, 0.f, 0.f};
#pragma unroll 1
        for (int br = 0; br < 3; ++br) {
            const bf16* A = F.SBQ + (size_t)br * 3 * M * DH; const bf16* Bt = F.Wbr_t + (size_t)br * D * DH; const bf16* G = br < 2 ? F.G0 + (size_t)br * M * D : F.G2;
            f32x4 acc[2][4];
#pragma unroll
            for (int m = 0; m < 2; ++m)
#pragma unroll
                for (int n = 0; n < 4; ++n) acc[m][n] = (f32x4){0.f, 0.f, 0.f, 0.f};
            const bf16* ap = A + (size_t)(r0 + (lane & 15)) * DH + 8 * (lane >> 4);
            const bf16* bp = Bt + (size_t)(c0 + (lane & 15)) * DH + 8 * (lane >> 4);
            for (int k0 = 0; k0 < DH; k0 += 32) {
                bf16x8 a[2], b[4];
#pragma unroll
                for (int m = 0; m < 2; ++m) a[m] = *(const bf16x8*)(ap + (size_t)(m * 16) * DH + k0);
#pragma unroll
                for (int n = 0; n < 4; ++n) b[n] = *(const bf16x8*)(bp + (size_t)(n * 16) * DH + k0);
#pragma unroll
                for (int m = 0; m < 2; ++m)
#pragma unroll
                    for (int n = 0; n < 4; ++n) acc[m][n] = __builtin_amdgcn_mfma_f32_16x16x32_bf16(a[m], b[n], acc[m][n], 0, 0, 0);
            }
#pragma unroll
            for (int m = 0; m < 2; ++m)
#pragma unroll
                for (int n = 0; n < 4; ++n)
#pragma unroll
                    for (int j = 0; j < 4; ++j) tot[m][n][j] += bf2f(G[(size_t)(r0 + m * 16 + (lane >> 4) * 4 + j) * D + c0 + n * 16 + (lane & 15)]) * acc[m][n][j];
        }
#pragma unroll
        for (int m = 0; m < 2; ++m)
#pragma unroll
            for (int n = 0; n < 4; ++n)
#pragma unroll
                for (int j = 0; j < 4; ++j) F.MRG[(size_t)(r0 + m * 16 + (lane >> 4) * 4 + j) * D + c0 + n * 16 + (lane & 15)] = (bf16)f2bf(tot[m][n][j]);
    }
}
__device__ __forceinline__ void ssq_naive(Frame& F) {
    const int gw = F.vcu * NWAVES + F.wave, NGW = F.G * NWAVES;
    for (int m = gw; m < M; m += NGW) {
        const GAS v4u* xr = (const GAS v4u*)(F.XN + (size_t)m * D) + F.lane; float s = 0.f;
#pragma unroll
        for (int j = 0; j < 2; ++j) { const v4u w = xr[64 * j]; const float a0 = bflo(w.x), a1 = bfhi(w.x), a2 = bflo(w.y), a3 = bfhi(w.y), a4 = bflo(w.z), a5 = bfhi(w.z), a6 = bflo(w.w), a7 = bfhi(w.w);
            s += (a0 * a0 + a1 * a1) + (a2 * a2 + a3 * a3) + (a4 * a4 + a5 * a5) + (a6 * a6 + a7 * a7); }
        s = wave_sum(s);
        if (F.lane < 16) F.ssq[(size_t)m * 16 + F.lane] = F.lane == 0 ? s : 0.f;
    }
}

namespace pg8 {
#define PG8_LAS __attribute__((address_space(3)))
typedef unsigned short bf16_t;
typedef unsigned u32x4 __attribute__((ext_vector_type(4)));
typedef unsigned u32x2 __attribute__((ext_vector_type(2)));
constexpr int BM = 256, BK = 64, HALF = 128, HTB = HALF * BK * 2, STAGE_BYTES = 8 * HTB, NXCD = 8, WGM = 4;
__host__ __device__ __forceinline__ int lds_byte(int r, int c) { const int st = (r >> 4) * 2 + (c >> 5), rr = r & 15, cc = c & 31, ob = rr * 64 + cc * 2; return st * 1024 + (ob ^ (((ob >> 9) & 1) << 5)); }
__host__ __device__ __forceinline__ void stage_rc(int b, int& R, int& C) { const int st = b / 1024, sb = b % 1024, swz = sb ^ (((sb >> 9) & 1) << 5); R = (st >> 1) * 16 + swz / 64; C = (st & 1) * 32 + (swz % 64) / 2; }
__host__ __device__ __forceinline__ int perm32(int rho) { const int n = rho >> 4, i = rho & 15; return 8 * (i >> 2) + 4 * n + (i & 3); }
struct Unit { int pm, pn, br; };
typedef float f32x2c __attribute__((ext_vector_type(2))); typedef __bf16 bf16x2c __attribute__((ext_vector_type(2)));
__device__ __forceinline__ unsigned cvt_pk_bf16(float lo, float hi) { f32x2c v = {lo, hi}; bf16x2c b = __builtin_convertvector(v, bf16x2c); return __builtin_bit_cast(unsigned, b); }
__device__ __forceinline__ float bflo(unsigned w) { return __uint_as_float(w << 16); }
__device__ __forceinline__ float bfhi(unsigned w) { return __uint_as_float(w & 0xffff0000u); }

__device__ __forceinline__ float xsum16(float v) { auto r = __builtin_amdgcn_permlane16_swap(__float_as_uint(v), __float_as_uint(v), false, false); return __uint_as_float(r[0]) + __uint_as_float(r[1]); }
__device__ __forceinline__ float xsum32(float v) { auto r = __builtin_amdgcn_permlane32_swap(__float_as_uint(v), __float_as_uint(v), false, false); return __uint_as_float(r[0]) + __uint_as_float(r[1]); }
__device__ __forceinline__ void static_tile(int L, int nM, int nN, int& pm, int& pn) {
    const int nwg = nM * nN; int wgid = L;
    { const int q = nwg / NXCD, r = nwg % NXCD, xcd = wgid % NXCD, off = wgid / NXCD; wgid = (xcd < r ? xcd * (q + 1) : r * (q + 1) + (xcd - r) * q) + off; }
    const int nig = WGM * nN, gid = wgid / nig, fm = gid * WGM, gsz = (nM - fm) < WGM ? (nM - fm) : WGM;
    pm = fm + ((wgid % nig) % gsz); pn = (wgid % nig) / gsz;
}
struct SchedPlain {
    int nM, nN, G, c; const char* A; const char* B; size_t tstep;
    __device__ __forceinline__ bool next(int i, Unit& u) const { const long L = (long)i * G + c; if (L >= (long)nM * nN) return false; static_tile((int)L, nM, nN, u.pm, u.pn); u.br = 0; return true; }
    __device__ __forceinline__ const char* a_ptr(const Unit& u) const { return A + (size_t)u.pm * tstep; }
    __device__ __forceinline__ const char* b_ptr(const Unit& u) const { return B + (size_t)u.pn * tstep; }
    __device__ __forceinline__ void a_ready(const Unit&) const {}
    __device__ __forceinline__ void done(const Unit&) const {}
};
struct SchedP1 {
    int G, c; const char* A; const char* B;
    __device__ __forceinline__ bool next(int i, Unit& u) const {
        if (G == 256 && c >= 128 && c < 160) { if (i == 0) { const int j = c - 128; u.pm = 64 + (j & 7); u.pn = 26 + (j >> 3); u.br = 0; return true; }
            if (i > 6) return false; static_tile((i - 1) * G + c, 64, 26, u.pm, u.pn); u.br = 0; return true; }
        const long L = (long)i * G + c; if (L >= 1696) return false;
        if (L < 1664) static_tile((int)L, 64, 26, u.pm, u.pn); else { const int r = (int)L - 1664; u.pm = 64 + (r >> 2); u.pn = 26 + (r & 3); } u.br = 0; return true; }
    __device__ __forceinline__ const char* a_ptr(const Unit& u) const { return A + (size_t)u.pm * (256 * 1024 * 2); }
    __device__ __forceinline__ const char* b_ptr(const Unit& u) const { return B + (size_t)u.pn * (256 * 1024 * 2); }
    __device__ __forceinline__ void a_ready(const Unit&) const {}
    __device__ __forceinline__ void done(const Unit&) const {}
};
struct SchedP3 {
    int G, c; const char* A; const char* B; int br;
    __device__ __forceinline__ bool next(int i, Unit& u) const { if (i >= 1 || c >= 256) return false; static_tile(c, 64, 4, u.pm, u.pn); u.br = br; return true; }
    __device__ __forceinline__ const char* a_ptr(const Unit& u) const { return A + (size_t)u.br * ((size_t)3 * M * DH * 2) + (size_t)u.pm * (256 * 512 * 2); }
    __device__ __forceinline__ const char* b_ptr(const Unit& u) const { return B + (size_t)u.br * ((size_t)D * DH * 2) + (size_t)u.pn * (256 * 512 * 2); }
    __device__ __forceinline__ void a_ready(const Unit&) const {}
    __device__ __forceinline__ void done(const Unit&) const {}
};

struct SchedP3m {
    int G, c; const char* A; const char* B;
    __device__ __forceinline__ bool next(int i, Unit& u) const { if (i >= 3 || c >= 256) return false; static_tile(c, 64, 4, u.pm, u.pn); u.br = i; return true; }
    __device__ __forceinline__ const char* a_ptr(const Unit& u) const { return A + (size_t)u.br * ((size_t)3 * M * DH * 2) + (size_t)u.pm * (256 * 512 * 2); }
    __device__ __forceinline__ const char* b_ptr(const Unit& u) const { return B + (size_t)u.br * ((size_t)D * DH * 2) + (size_t)u.pn * (256 * 512 * 2); }
    __device__ __forceinline__ void a_ready(const Unit&) const {}
    __device__ __forceinline__ void done(const Unit&) const {}
};
typedef f32x4 acc_t[2][2][4][2];
__device__ __forceinline__ u32x4 pack8(const f32x4 a, const f32x4 b) { u32x4 w; w.x = cvt_pk_bf16(a[0], a[1]); w.y = cvt_pk_bf16(a[2], a[3]); w.z = cvt_pk_bf16(b[0], b[1]); w.w = cvt_pk_bf16(b[2], b[3]); return w; }
__device__ __forceinline__ float sigm(float x) { return __builtin_amdgcn_rcpf(1.0f + __builtin_amdgcn_exp2f(x)); }

struct EpiProj {
    static constexpr bool PERM = true, AFTER_DRAIN = false, KEEP_ACC = false, PERM64 = false;
    bf16_t* SBQ; bf16_t* G0; bf16_t* G2; float* MKf; bf16_t* MV;
    __device__ __forceinline__ void operator()(const acc_t& acc, const Unit& u, int wr, int wc, int fr, int fq) const { run(acc, u, wr, wc, fr, fq, 0, 2); }
    __device__ __forceinline__ void half(const acc_t& acc, const Unit& u, int wr, int wc, int fr, int fq, const int ai) const { run(acc, u, wr, wc, fr, fq, ai, ai + 1); }
    __device__ __forceinline__ void run(const acc_t& acc, const Unit& u, int wr, int wc, int fr, int fq, const int A0, const int A1) const {
        const int pn = u.pn; const int row0 = u.pm * BM + wr * 64 + fr;
        if (pn < 12) {
            const int T = pn >> 1, hd = (pn & 1) * 4 + wc;
            bf16_t* base = SBQ + (size_t)T * M * DH + (size_t)row0 * DH + hd * 64 + 8 * fq;
            if (T == 3 || T == 4) {
                const float qs = T == 3 ? C2 : 1.0f;
#pragma unroll
                for (int ai = A0; ai < A1; ++ai)
#pragma unroll
                    for (int m = 0; m < 4; ++m) {
                        float ss = 0.f;
#pragma unroll
                        for (int bj = 0; bj < 2; ++bj)
#pragma unroll
                            for (int n = 0; n < 2; ++n) { const f32x4 x = acc[ai][bj][m][n]; ss += (x[0] * x[0] + x[1] * x[1]) + (x[2] * x[2] + x[3] * x[3]); }
                        ss = xsum16(ss); ss = xsum32(ss);
                        const float sc = qs * __builtin_amdgcn_rsqf(ss * (1.0f / HD) + EPS);
                        bf16_t* rowp = base + (size_t)(ai * HALF + m * 16) * DH;
#pragma unroll
                        for (int bj = 0; bj < 2; ++bj) *(u32x4*)(rowp + 32 * bj) = pack8(acc[ai][bj][m][0] * sc, acc[ai][bj][m][1] * sc);
                    }
            } else {
                const float sc = T == 0 ? C2 : 1.0f;
#pragma unroll
                for (int ai = A0; ai < A1; ++ai)
#pragma unroll
                    for (int m = 0; m < 4; ++m) { bf16_t* rowp = base + (size_t)(ai * HALF + m * 16) * DH;
#pragma unroll
                        for (int bj = 0; bj < 2; ++bj) *(u32x4*)(rowp + 32 * bj) = pack8(acc[ai][bj][m][0] * sc, acc[ai][bj][m][1] * sc); }
            }
        } else if (pn < 14) {
            bf16_t* base = SBQ + (size_t)6 * M * DH + (size_t)row0 * DH + (pn - 12) * 256 + wc * 64 + 8 * fq;
#pragma unroll
            for (int ai = A0; ai < A1; ++ai)
#pragma unroll
                for (int m = 0; m < 4; ++m) { bf16_t* rowp = base + (size_t)(ai * HALF + m * 16) * DH;
#pragma unroll
                    for (int bj = 0; bj < 2; ++bj) *(u32x4*)(rowp + 32 * bj) = pack8(acc[ai][bj][m][0], acc[ai][bj][m][1]); }
        } else if (pn < 26) {
            const int g = (pn - 14) >> 2; bf16_t* G = g < 2 ? G0 + (size_t)g * M * D : G2;
            bf16_t* base = G + (size_t)row0 * D + ((pn - 14) & 3) * 256 + wc * 64 + 8 * fq;
#pragma unroll
            for (int ai = A0; ai < A1; ++ai)
#pragma unroll
                for (int m = 0; m < 4; ++m) { bf16_t* rowp = base + (size_t)(ai * HALF + m * 16) * D;
#pragma unroll
                    for (int bj = 0; bj < 2; ++bj) { f32x4 a = acc[ai][bj][m][0], b = acc[ai][bj][m][1];
#pragma unroll
                        for (int e = 0; e < 4; ++e) { a[e] = sigm(a[e]); b[e] = sigm(b[e]); }
                        *(u32x4*)(rowp + 32 * bj) = pack8(a, b); } }
        } else {
            const int mrow0 = (u.pm - 64) * BM + wr * 64 + fr, pl = pn - 26;
            if (pl < 2) { float* base = MKf + (size_t)mrow0 * DH + pl * 256 + wc * 32 + 8 * fq;
#pragma unroll
                for (int ai = A0; ai < A1; ++ai)
#pragma unroll
                    for (int m = 0; m < 4; ++m) { float* rowp = base + (size_t)(ai * HALF + m * 16) * DH;
#pragma unroll
                        for (int bj = 0; bj < 2; ++bj) { *(f32x4*)(rowp + HALF * bj) = acc[ai][bj][m][0]; *(f32x4*)(rowp + HALF * bj + 4) = acc[ai][bj][m][1]; } }
            } else { bf16_t* base = MV + (size_t)mrow0 * DH + (pl - 2) * 256 + wc * 32 + 8 * fq;
#pragma unroll
                for (int ai = A0; ai < A1; ++ai)
#pragma unroll
                    for (int m = 0; m < 4; ++m) { bf16_t* rowp = base + (size_t)(ai * HALF + m * 16) * DH;
#pragma unroll
                        for (int bj = 0; bj < 2; ++bj) *(u32x4*)(rowp + HALF * bj) = pack8(acc[ai][bj][m][0], acc[ai][bj][m][1]); } }
        }
    }
};
__device__ __forceinline__ float clampg(unsigned bits) { return __uint_as_float(bits > 0x0da24260u ? bits : 0x0da24260u); }
struct EpiMerged {
    static constexpr bool PERM = true, AFTER_DRAIN = true, KEEP_ACC = false, PERM64 = false;
    const bf16_t* G0; const bf16_t* G2; bf16_t* MRG;
    __device__ __forceinline__ void fused(const acc_t& acc, const Unit& u, int wr, int wc, int fr, int fq, PG8_LAS unsigned char*, int, int) const {
        const int br = u.br; const int row0 = u.pm * BM + wr * 64 + fr, col0 = u.pn * BM + wc * 32 + 8 * fq;
        const bf16_t* G = (br < 2 ? G0 + (size_t)br * M * D : G2) + (size_t)row0 * D + col0;
        bf16_t* O = MRG + (size_t)row0 * D + col0;
#pragma unroll
        for (int ai = 0; ai < 2; ++ai)
#pragma unroll
            for (int m = 0; m < 4; ++m) { const size_t ro = (size_t)(ai * HALF + m * 16);
#pragma unroll
                for (int bj = 0; bj < 2; ++bj) {
                    const u32x4 gw = *(const u32x4*)(G + ro * D + HALF * bj);
                    f32x4 a = acc[ai][bj][m][0], b = acc[ai][bj][m][1];
                    a[0] *= bflo(gw.x); a[1] *= bfhi(gw.x); a[2] *= bflo(gw.y); a[3] *= bfhi(gw.y); b[0] *= bflo(gw.z); b[1] *= bfhi(gw.z); b[2] *= bflo(gw.w); b[3] *= bfhi(gw.w);
                    bf16_t* tp = O + ro * D + HALF * bj;
                    if (br > 0) { const u32x4 t = *(const u32x4*)tp; a[0] += bflo(t.x); a[1] += bfhi(t.x); a[2] += bflo(t.y); a[3] += bfhi(t.y); b[0] += bflo(t.z); b[1] += bfhi(t.z); b[2] += bflo(t.w); b[3] += bfhi(t.w); }
                    *(u32x4*)tp = pack8(a, b);
                }
                if (m & 1) asm volatile("" ::: "memory"); }
    }
};
struct EpiMergedR {
    static constexpr bool PERM = true, AFTER_DRAIN = false, KEEP_ACC = true, PERM64 = false;
    const bf16_t* G0; const bf16_t* G2; bf16_t* MRG;
    __device__ __forceinline__ void operator()(acc_t& acc, const Unit& u, int wr, int wc, int fr, int fq) const {
        const int br = u.br; const size_t base = (size_t)(u.pm * BM + wr * 64 + fr) * D + u.pn * BM + wc * 32 + 8 * fq;
        const bf16_t* Ga = (br < 2 ? G0 + (size_t)br * M * D : G2) + base;
        const bf16_t* Gb = (br == 0 ? G0 + (size_t)M * D : G2) + base;
        bf16_t* O = MRG + base;
#pragma unroll
        for (int ai = 0; ai < 2; ++ai) {
            u32x4 ga[4][2], gb[4][2];
#pragma unroll
            for (int m = 0; m < 4; ++m)
#pragma unroll
                for (int bj = 0; bj < 2; ++bj) { const size_t o = (size_t)(ai * HALF + m * 16) * D + HALF * bj; ga[m][bj] = *(const u32x4*)(Ga + o); if (br < 2) gb[m][bj] = *(const u32x4*)(Gb + o); }
#pragma unroll
            for (int m = 0; m < 4; ++m)
#pragma unroll
                for (int bj = 0; bj < 2; ++bj) {
                    const u32x4 a = ga[m][bj]; float f[8] = {clampg(a.x << 16), clampg(a.x & 0xffff0000u), clampg(a.y << 16), clampg(a.y & 0xffff0000u), clampg(a.z << 16), clampg(a.z & 0xffff0000u), clampg(a.w << 16), clampg(a.w & 0xffff0000u)};
                    if (br < 2) { const u32x4 b = gb[m][bj]; const float d[8] = {clampg(b.x << 16), clampg(b.x & 0xffff0000u), clampg(b.y << 16), clampg(b.y & 0xffff0000u), clampg(b.z << 16), clampg(b.z & 0xffff0000u), clampg(b.w << 16), clampg(b.w & 0xffff0000u)};
#pragma unroll
                        for (int e = 0; e < 8; ++e) f[e] *= __builtin_amdgcn_rcpf(d[e]); }
                    f32x4 x0 = acc[ai][bj][m][0], x1 = acc[ai][bj][m][1];
                    x0[0] *= f[0]; x0[1] *= f[1]; x0[2] *= f[2]; x0[3] *= f[3]; x1[0] *= f[4]; x1[1] *= f[5]; x1[2] *= f[6]; x1[3] *= f[7];
                    if (br < 2) { acc[ai][bj][m][0] = x0; acc[ai][bj][m][1] = x1; }
                    else *(u32x4*)(O + (size_t)(ai * HALF + m * 16) * D + HALF * bj) = pack8(x0, x1);
                }
            asm volatile("" ::: "memory");
        }
    }
};
struct EpiOut {
    static constexpr bool PERM = true, AFTER_DRAIN = true, KEEP_ACC = false, PERM64 = false;
    const float* x; float* x1; bf16_t* A2; float* ssq;
    __device__ __forceinline__ void fused(const acc_t& acc, const Unit& u, int wr, int wc, int fr, int fq, PG8_LAS unsigned char* lds, int, int) const {
        PG8_LAS float* red = (PG8_LAS float*)lds;
        const int row0 = u.pm * BM + wr * 64 + fr, col0 = u.pn * BM + wc * 32 + 8 * fq;
#pragma unroll
        for (int ai = 0; ai < 2; ++ai)
#pragma unroll
            for (int m = 0; m < 4; ++m) { const int row = row0 + ai * HALF + m * 16; const size_t off = (size_t)row * D + col0; float ss = 0.f;
#pragma unroll
                for (int bj = 0; bj < 2; ++bj) { const size_t o = off + bj * HALF;
                    const f32x4 r0 = *(const f32x4*)(x + o) + acc[ai][bj][m][0], r1 = *(const f32x4*)(x + o + 4) + acc[ai][bj][m][1];
                    u32x4 w; w.x = cvt_pk_bf16(r0[0], r0[1]); w.y = cvt_pk_bf16(r0[2], r0[3]); w.z = cvt_pk_bf16(r1[0], r1[1]); w.w = cvt_pk_bf16(r1[2], r1[3]); *(u32x4*)(A2 + o) = w;
                    const float q0 = bflo(w.x), q1 = bfhi(w.x), q2 = bflo(w.y), q3 = bfhi(w.y), q4 = bflo(w.z), q5 = bfhi(w.z), q6 = bflo(w.w), q7 = bfhi(w.w);
                    ss += ((q0 * q0 + q1 * q1) + (q2 * q2 + q3 * q3)) + ((q4 * q4 + q5 * q5) + (q6 * q6 + q7 * q7)); }
                ss = xsum16(ss); ss = xsum32(ss);
                if (fq == 0) red[(ai * HALF + wr * 64 + m * 16 + fr) * 4 + wc] = ss;
                if (m & 1) asm volatile("" ::: "memory"); }
        __syncthreads();
        if (threadIdx.x < 256) { const f32x4 p = *(const PG8_LAS f32x4*)(red + threadIdx.x * 4); ssq[(size_t)(u.pm * BM + threadIdx.x) * 4 + u.pn] = (p.x + p.y) + (p.z + p.w); }
    }
};
struct EpiUp {
    static constexpr bool PERM = true, AFTER_DRAIN = false, KEEP_ACC = false, PERM64 = true;
    bf16_t* U;
    __device__ __forceinline__ void operator()(const acc_t& acc, const Unit& u, int wr, int wc, int fr, int fq) const { run(acc, u, wr, wc, fr, fq, 0, 2); }
    __device__ __forceinline__ void half(const acc_t& acc, const Unit& u, int wr, int wc, int fr, int fq, const int ai) const { run(acc, u, wr, wc, fr, fq, ai, ai + 1); }
    __device__ __forceinline__ void run(const acc_t& acc, const Unit& u, int wr, int wc, int fr, int fq, const int A0, const int A1) const {
        const char* ub = (const char*)(U + (size_t)(u.pm * BM + wr * 64) * FF + u.pn * BM + wc * 64); const unsigned lo = (unsigned)(fr * FF + 8 * fq) * 2u;
#pragma unroll
        for (int ai = A0; ai < A1; ++ai)
#pragma unroll
            for (int m = 0; m < 4; ++m) { char* rowp = (char*)ub + (size_t)(ai * HALF + m * 16) * FF * 2;
#pragma unroll
                for (int bj = 0; bj < 2; ++bj) { f32x4 a = acc[ai][bj][m][0], b = acc[ai][bj][m][1];
#pragma unroll
                    for (int e = 0; e < 4; ++e) { a[e] = fmaxf(a[e] * __builtin_fabsf(a[e]), 0.f); b[e] = fmaxf(b[e] * __builtin_fabsf(b[e]), 0.f); }
                    *(u32x4*)(rowp + 32 * bj * 2 + lo) = pack8(a, b); } }
    }
};
struct EpiDown {
    static constexpr bool PERM = true, AFTER_DRAIN = true, KEEP_ACC = false, PERM64 = false;
    float* out; const float* ssq; float probe; const bf16_t* A2;
    __device__ __forceinline__ void fused(const acc_t& acc, const Unit& u, int wr, int wc, int fr, int fq, PG8_LAS unsigned char*, int, int) const {
        const int row0 = u.pm * BM + wr * 64 + fr, col0 = u.pn * BM + wc * 32 + 8 * fq;
#pragma unroll
        for (int ai = 0; ai < 2; ++ai)
#pragma unroll
            for (int m = 0; m < 4; ++m) { const int row = row0 + ai * HALF + m * 16; const size_t off = (size_t)row * D + col0;
                const f32x4 s4 = *(const f32x4*)(ssq + (size_t)row * 4); const float r2 = 1.0f / (((s4.x + s4.y) + (s4.z + s4.w)) * (1.0f / D) + EPS);
#pragma unroll
                for (int bj = 0; bj < 2; ++bj) { float* q = out + off + bj * HALF; const u32x4 xw = *(const u32x4*)(A2 + off + bj * HALF);
                    f32x4 v0 = (f32x4){bflo(xw.x), bfhi(xw.x), bflo(xw.y), bfhi(xw.y)} + acc[ai][bj][m][0] * r2, v1 = (f32x4){bflo(xw.z), bfhi(xw.z), bflo(xw.w), bfhi(xw.w)} + acc[ai][bj][m][1] * r2;
                    if ((TIMING_PHASE >= 0 || GPROBE != 0) && q == out) v0[0] += probe;
                    __builtin_nontemporal_store(v0, (f32x4*)q); __builtin_nontemporal_store(v1, (f32x4*)(q + 4)); }
                if (m & 1) asm volatile("" ::: "memory"); }
    }
};

template <class Epi, class Sched, bool ALIGN_EPI = false, bool SP2 = false, int PID = 0, bool DE = false>
__device__ __forceinline__ void gemm_phase(PG8_LAS unsigned char* lds, const int K, const Sched& S, const Epi& E) {
    const int tid = threadIdx.x, wid = __builtin_amdgcn_readfirstlane(tid >> 6), lane = tid & 63, wr = wid >> 2, wc = wid & 3, fr = lane & 15, fq = lane >> 4;
    const int nt = K / BK;
    unsigned voffA[2], voffB[2];
#pragma unroll
    for (int i = 0; i < 2; ++i) { int R, C; stage_rc(tid * 16 + i * 8192, R, C); const int Rb = Epi::PERM64 ? (64 * (R >> 5) + perm32(R & 31)) : Epi::PERM ? ((R & ~31) + perm32(R & 31)) : R;
        voffA[i] = (unsigned)(R * K + C) * 2u; voffB[i] = (unsigned)(Rb * K + C) * 2u; }
    const size_t kstep = (size_t)(BK * 2);
    const size_t hstep = (size_t)HALF * K * 2;
    const size_t hstepB = Epi::PERM64 ? (size_t)32 * K * 2 : hstep;
    const unsigned ldsw = (unsigned)wid * 1024u;
    const int aoff = lds_byte(wr * 64 + fr, fq * 8), boff = lds_byte(wc * 32 + fr, fq * 8);
#define PG8_SA(b, h) (((b) * 2 + (h)) * HTB)
#define PG8_SB(b, h) ((4 + (b) * 2 + (h)) * HTB)
#define PG8_STAGE(bufoff, gbase, voff) do { const char* gb_ = (const char*)(gbase); asm volatile("" : "+s"(gb_)); _Pragma("unroll") for (int _i = 0; _i < 2; ++_i) { unsigned vo_ = (voff)[_i]; asm volatile("" : "+v"(vo_)); \
        __builtin_amdgcn_global_load_lds((const unsigned*)(gb_ + vo_), (PG8_LAS unsigned*)(lds + (bufoff) + ldsw + _i * 8192), 16, 0, 0); } } while (0)
#define PG8_LDA(dst, b, h) do { _Pragma("unroll") for (int m = 0; m < 4; ++m) _Pragma("unroll") for (int k = 0; k < 2; ++k) dst[m][k] = *(const PG8_LAS bf16x8*)(lds + PG8_SA(b, h) + aoff + m * 2048 + k * 1024); } while (0)
#define PG8_LDB(dst, b, h) do { _Pragma("unroll") for (int n = 0; n < 2; ++n) _Pragma("unroll") for (int k = 0; k < 2; ++k) dst[n][k] = *(const PG8_LAS bf16x8*)(lds + PG8_SB(b, h) + boff + n * 2048 + k * 1024); } while (0)
#define PG8_MMA(ai, bj, At, Bt) do { __builtin_amdgcn_s_setprio(1); _Pragma("unroll") for (int m = 0; m < 4; ++m) _Pragma("unroll") for (int n = 0; n < 2; ++n) _Pragma("unroll") for (int k = 0; k < 2; ++k) \
        acc[ai][bj][m][n] = __builtin_amdgcn_mfma_f32_16x16x32_bf16(Bt[n][k], At[m][k], acc[ai][bj][m][n], 0, 0, 0); __builtin_amdgcn_s_setprio(0); } while (0)
#define PG8_WAIT_V(n) asm volatile("s_waitcnt vmcnt(" #n ")" ::: "memory")
#define PG8_WAIT_L(n) asm volatile("s_waitcnt lgkmcnt(" #n ")" ::: "memory")
#define PG8_BAR __builtin_amdgcn_s_barrier()
#define PG8_SCHED __builtin_amdgcn_sched_barrier(0)
    Unit cur, nxt; int ui = 0;
    if (!S.next(0, cur)) return;
    f32x4 acc[2][2][4][2];
    if constexpr (!DE) {
#pragma unroll
    for (int a = 0; a < 2; ++a)
#pragma unroll
        for (int b = 0; b < 2; ++b)
#pragma unroll
            for (int m = 0; m < 4; ++m)
#pragma unroll
                for (int n = 0; n < 2; ++n) acc[a][b][m][n] = (f32x4){0.f, 0.f, 0.f, 0.f};
    }
    bf16x8 At[4][2], B0[2][2], B1[2][2];
    const char* cA = S.a_ptr(cur); const char* cB = S.b_ptr(cur);
    S.a_ready(cur);
    if constexpr (SP2) {
        PG8_STAGE(PG8_SB(0, 0), cB, voffB); PG8_STAGE(PG8_SB(0, 1), cB + hstepB, voffB); PG8_STAGE(PG8_SA(0, 0), cA, voffA); PG8_STAGE(PG8_SA(0, 1), cA + hstep, voffA);
        if (wr == 1) PG8_BAR;
        PG8_WAIT_V(2); PG8_BAR;
        PG8_STAGE(PG8_SB(1, 0), cB + kstep, voffB); PG8_STAGE(PG8_SA(1, 0), cA + kstep, voffA); PG8_STAGE(PG8_SB(1, 1), cB + hstepB + kstep, voffB);
        PG8_WAIT_V(6); PG8_BAR;
    } else {
        PG8_STAGE(PG8_SB(0, 0), cB, voffB); PG8_STAGE(PG8_SA(0, 0), cA, voffA); PG8_STAGE(PG8_SB(0, 1), cB + hstepB, voffB); PG8_STAGE(PG8_SA(0, 1), cA + hstep, voffA);
        if (wr == 1) PG8_BAR;
        PG8_WAIT_V(4); PG8_BAR;
        PG8_STAGE(PG8_SB(1, 0), cB + kstep, voffB); PG8_STAGE(PG8_SA(1, 0), cA + kstep, voffA); PG8_STAGE(PG8_SB(1, 1), cB + hstepB + kstep, voffB);
        PG8_WAIT_V(6); PG8_BAR;
    }
    constexpr bool GP = (GPROBE != 0 && GPROBE == PID);
    unsigned long long gpU = 0, gp1 = 0, gpEnd = 0, gpS0 = 0, accFirst = 0, accFirst0 = 0, accSteady = 0, accE = 0; if (GP) gpS0 = __builtin_amdgcn_s_memrealtime();
    if constexpr (DE) {
#define PG8_MMAZ(ai, bj, At, Bt) do { __builtin_amdgcn_s_setprio(1); _Pragma("unroll") for (int m = 0; m < 4; ++m) _Pragma("unroll") for (int n = 0; n < 2; ++n) { \
        acc[ai][bj][m][n] = __builtin_amdgcn_mfma_f32_16x16x32_bf16(Bt[n][0], At[m][0], (f32x4){0.f, 0.f, 0.f, 0.f}, 0, 0, 0); \
        acc[ai][bj][m][n] = __builtin_amdgcn_mfma_f32_16x16x32_bf16(Bt[n][1], At[m][1], acc[ai][bj][m][n], 0, 0, 0); } __builtin_amdgcn_s_setprio(0); } while (0)
#define PG8_PAIR(W1, W2, W3, W4, MM, PRE1, PRE4) do { \
            PG8_STAGE(PG8_SA(1, 1), a1 + hstep, voffA); PRE1; PG8_SCHED; PG8_LDB(B0, 0, 0); PG8_LDB(B1, 0, 1); PG8_SCHED; PG8_LDA(At, 0, 0); \
            PG8_WAIT_V(W1); PG8_WAIT_L(0); PG8_BAR; MM(0, 0, At, B0); MM(0, 1, At, B1); PG8_BAR; PG8_SCHED; \
            PG8_LDA(At, 0, 1); PG8_STAGE(PG8_SB(0, 0), b2, voffB); PG8_STAGE(PG8_SB(0, 1), b2 + hstepB, voffB); PG8_STAGE(PG8_SA(0, 0), a2, voffA); \
            PG8_WAIT_V(W2); PG8_WAIT_L(0); PG8_BAR; MM(1, 0, At, B0); MM(1, 1, At, B1); PG8_BAR; PG8_SCHED; \
            PG8_LDB(B0, 1, 0); PG8_LDB(B1, 1, 1); PG8_SCHED; PG8_LDA(At, 1, 0); PG8_STAGE(PG8_SA(0, 1), a2 + hstep, voffA); \
            PG8_WAIT_V(W3); PG8_WAIT_L(0); PG8_BAR; PG8_MMA(0, 0, At, B0); PG8_MMA(0, 1, At, B1); PG8_BAR; PG8_SCHED; \
            PG8_STAGE(PG8_SB(1, 0), b3, voffB); PG8_STAGE(PG8_SB(1, 1), b3 + hstepB, voffB); PG8_STAGE(PG8_SA(1, 0), a3, voffA); PRE4; PG8_SCHED; PG8_LDA(At, 1, 1); \
            PG8_WAIT_V(W4); PG8_WAIT_L(0); PG8_BAR; PG8_MMA(1, 0, At, B0); PG8_MMA(1, 1, At, B1); PG8_BAR; PG8_SCHED; } while (0)
        static_assert(SP2 && !ALIGN_EPI && !Epi::AFTER_DRAIN && !Epi::KEEP_ACC, "DE: SP2 form, store-only per-unit epilogues");
        if (GP) gpU = __builtin_amdgcn_s_memrealtime();
        { const char* a1 = cA + kstep; const char* a2 = cA + 2 * kstep; const char* b2 = cB + 2 * kstep; const char* a3 = a2 + kstep; const char* b3 = b2 + kstep;
          PG8_PAIR(8, 8, 8, 8, PG8_MMAZ, (void)0, (void)0); }
        for (;;) {
            const bool has_next = S.next(ui + 1, nxt);
            const char* nA = has_next ? S.a_ptr(nxt) : cA; const char* nB = has_next ? S.b_ptr(nxt) : cB;
            if (GP) gp1 = __builtin_amdgcn_s_memrealtime();
            for (int t = 2; t < nt - 2; t += 2) {
                const char* a1 = cA + (size_t)(t + 1) * kstep; const char* a2 = cA + (size_t)(t + 2) * kstep; const char* b2 = cB + (size_t)(t + 2) * kstep; const char* a3 = a2 + kstep; const char* b3 = b2 + kstep;
                PG8_PAIR(8, 8, 8, 8, PG8_MMA, (void)0, (void)0); }
            { const char* a1 = cA + (size_t)(nt - 1) * kstep; const char* a2 = nA; const char* b2 = nB; const char* a3 = a2 + kstep; const char* b3 = b2 + kstep;
              if (has_next) S.a_ready(nxt);
              PG8_PAIR(8, 8, 8, 16, PG8_MMA, (void)0, E.half(acc, cur, wr, wc, fr, fq, 0)); }
            if (GP) { gpEnd = __builtin_amdgcn_s_memrealtime(); if (ui == 0) accFirst0 += gp1 - gpU; else accFirst += gp1 - gpU; accSteady += gpEnd - gp1; }
            if (!has_next) break;
            const Unit prev = cur; cur = nxt; cA = nA; cB = nB; ++ui;
            if (GP) gpU = __builtin_amdgcn_s_memrealtime();
            { const char* a1 = cA + kstep; const char* a2 = cA + 2 * kstep; const char* b2 = cB + 2 * kstep; const char* a3 = a2 + kstep; const char* b3 = b2 + kstep;
              PG8_PAIR(24, 24, 16, 8, PG8_MMAZ, E.half(acc, prev, wr, wc, fr, fq, 1), (void)0); }
        }
        E.half(acc, cur, wr, wc, fr, fq, 1);
#undef PG8_PAIR
#undef PG8_MMAZ
    } else
    for (;;) {
        const bool has_next = S.next(ui + 1, nxt);
        if (GP) gpU = __builtin_amdgcn_s_memrealtime();
        const char* nA = has_next ? S.a_ptr(nxt) : cA; const char* nB = has_next ? S.b_ptr(nxt) : cB;
        for (int t = 0; t < nt; t += 2) {
            const bool last = (t == nt - 2);
            if (GP && t == 2) gp1 = __builtin_amdgcn_s_memrealtime();
            const char* a1 = cA + (size_t)(t + 1) * kstep;
            const char* a2 = last ? nA : cA + (size_t)(t + 2) * kstep; const char* b2 = last ? nB : cB + (size_t)(t + 2) * kstep;
            const char* a3 = a2 + kstep; const char* b3 = b2 + kstep;
            if (last && has_next) S.a_ready(nxt);
            if constexpr (SP2) {
            PG8_LDB(B0, 0, 0); PG8_LDB(B1, 0, 1); PG8_SCHED; PG8_LDA(At, 0, 0); PG8_STAGE(PG8_SA(1, 1), a1 + hstep, voffA);
            PG8_WAIT_V(8); PG8_WAIT_L(0); PG8_BAR; PG8_MMA(0, 0, At, B0); PG8_MMA(0, 1, At, B1); PG8_BAR; PG8_SCHED;
            PG8_LDA(At, 0, 1); PG8_STAGE(PG8_SB(0, 0), b2, voffB); PG8_STAGE(PG8_SB(0, 1), b2 + hstepB, voffB); PG8_STAGE(PG8_SA(0, 0), a2, voffA);
            PG8_WAIT_V(8); PG8_WAIT_L(0); PG8_BAR; PG8_MMA(1, 0, At, B0); PG8_MMA(1, 1, At, B1); PG8_BAR; PG8_SCHED;
            PG8_LDB(B0, 1, 0); PG8_LDB(B1, 1, 1); PG8_SCHED; PG8_LDA(At, 1, 0); PG8_STAGE(PG8_SA(0, 1), a2 + hstep, voffA);
            PG8_WAIT_V(8); PG8_WAIT_L(0); PG8_BAR; PG8_MMA(0, 0, At, B0); PG8_MMA(0, 1, At, B1); PG8_BAR; PG8_SCHED;
            PG8_LDA(At, 1, 1); PG8_STAGE(PG8_SB(1, 0), b3, voffB); PG8_STAGE(PG8_SB(1, 1), b3 + hstepB, voffB); PG8_STAGE(PG8_SA(1, 0), a3, voffA);
            PG8_WAIT_V(8); PG8_WAIT_L(0); PG8_BAR; PG8_MMA(1, 0, At, B0); PG8_MMA(1, 1, At, B1); PG8_BAR; PG8_SCHED;
            } else {
            PG8_LDB(B0, 0, 0); PG8_SCHED; PG8_LDA(At, 0, 0); PG8_STAGE(PG8_SA(1, 1), a1 + hstep, voffA);
            PG8_WAIT_L(8); PG8_BAR; PG8_WAIT_L(0); PG8_MMA(0, 0, At, B0); PG8_BAR; PG8_SCHED;
            PG8_LDB(B1, 0, 1); PG8_STAGE(PG8_SB(0, 0), b2, voffB);
            PG8_BAR; PG8_WAIT_L(0); PG8_MMA(0, 1, At, B1); PG8_BAR;
            PG8_LDA(At, 0, 1); PG8_STAGE(PG8_SA(0, 0), a2, voffA);
            PG8_BAR; PG8_WAIT_L(0); PG8_MMA(1, 0, At, B0); PG8_BAR; PG8_SCHED;
            PG8_STAGE(PG8_SB(0, 1), b2 + hstepB, voffB);
            PG8_WAIT_V(6); PG8_BAR; PG8_MMA(1, 1, At, B1); PG8_BAR;
            PG8_LDB(B0, 1, 0); PG8_SCHED; PG8_LDA(At, 1, 0); PG8_STAGE(PG8_SA(0, 1), a2 + hstep, voffA);
            PG8_WAIT_L(8); PG8_BAR; PG8_WAIT_L(0); PG8_MMA(0, 0, At, B0); PG8_BAR; PG8_SCHED;
            PG8_LDB(B1, 1, 1); PG8_STAGE(PG8_SB(1, 0), b3, voffB);
            PG8_BAR; PG8_WAIT_L(0); PG8_MMA(0, 1, At, B1); PG8_BAR;
            PG8_LDA(At, 1, 1); PG8_STAGE(PG8_SA(1, 0), a3, voffA);
            PG8_BAR; PG8_WAIT_L(0); PG8_MMA(1, 0, At, B0); PG8_BAR; PG8_SCHED;
            PG8_STAGE(PG8_SB(1, 1), b3 + hstepB, voffB);
            PG8_WAIT_V(6); PG8_BAR; PG8_MMA(1, 1, At, B1); PG8_BAR;
            }
        }
        if constexpr (ALIGN_EPI) { if (wr == 0) PG8_BAR; }
        if (GP) { gpEnd = __builtin_amdgcn_s_memrealtime(); if (ui == 0) accFirst0 += gp1 - gpU; else accFirst += gp1 - gpU; accSteady += gpEnd - gp1; }
        if constexpr (!Epi::AFTER_DRAIN) { E(acc, cur, wr, wc, fr, fq); S.done(cur); }
        if (GP) accE += __builtin_amdgcn_s_memrealtime() - gpEnd;
        if (!has_next) break;
        if constexpr (!Epi::KEEP_ACC) {
#pragma unroll
        for (int a = 0; a < 2; ++a)
#pragma unroll
            for (int b = 0; b < 2; ++b)
#pragma unroll
                for (int m = 0; m < 4; ++m)
#pragma unroll
                    for (int n = 0; n < 2; ++n) acc[a][b][m][n] = (f32x4){0.f, 0.f, 0.f, 0.f};
        }
        cur = nxt; cA = nA; cB = nB; ++ui;
        if constexpr (ALIGN_EPI) { if (wr == 1) PG8_BAR; }
    }
    PG8_WAIT_V(0);
    if constexpr (!ALIGN_EPI) { if (wr == 0) PG8_BAR; }
    PG8_BAR;
    if constexpr (Epi::AFTER_DRAIN) { E.fused(acc, cur, wr, wc, fr, fq, lds, wid, lane); S.done(cur); }
    if (GP && blockIdx.x == 0 && tid == 0) { const float nu = (float)(ui + 1), npair = (float)(nt / 2 - 1); float v = 0.f;
        if (GPSEL == 1) v = (float)accSteady * 0.01f / (nu * npair);
        if (GPSEL == 2) v = (float)accFirst * 0.01f / fmaxf(nu - 1.f, 1.f);
        if (GPSEL == 3) v = (float)accFirst0 * 0.01f;
        if (GPSEL == 4) v = (float)accE * 0.01f / nu;
        if (GPSEL == 5) v = (float)(__builtin_amdgcn_s_memrealtime() - gpS0) * 0.001f;
        *(PG8_LAS float*)(lds + MISC_OFF + 64) = (v - GPOFF) * GPSCALE; }
#undef PG8_SA
#undef PG8_SB
#undef PG8_STAGE
#undef PG8_LDA
#undef PG8_LDB
#undef PG8_MMA
#undef PG8_WAIT_V
#undef PG8_WAIT_L
#undef PG8_BAR
#undef PG8_SCHED
}
}

namespace att {
typedef float f32x16 __attribute__((ext_vector_type(16)));
typedef float f32x2_t __attribute__((ext_vector_type(2)));
typedef __bf16 bf16x2_t __attribute__((ext_vector_type(2)));
typedef unsigned u32x4 __attribute__((ext_vector_type(4)));
typedef unsigned u32x2 __attribute__((ext_vector_type(2)));
constexpr int KP = 88, VP = 96;
constexpr int BUF_K = 0, BUF_V = 64 * KP * 2, BUF_B = BUF_V + 64 * VP * 2, BUF_BYTES = BUF_B + 256;
typedef short v4i16_t __attribute__((ext_vector_type(4)));
__device__ __forceinline__ u32x2 vtr(const LAS unsigned char* p) { return __builtin_bit_cast(u32x2, __builtin_amdgcn_ds_read_tr16_b64_v4i16((LAS v4i16_t*)p)); }
__device__ __forceinline__ int crow(int r, int hi) { return (r & 3) + 8 * (r >> 2) + 4 * hi; }
__device__ __forceinline__ unsigned cvtpk(float lo, float hi) { f32x2_t v = {lo, hi}; bf16x2_t b = __builtin_convertvector(v, bf16x2_t); return __builtin_bit_cast(unsigned, b); }
__device__ __forceinline__ float other_half(float v, int hi) { auto r = __builtin_amdgcn_permlane32_swap(__float_as_uint(v), __float_as_uint(v), false, false); return __uint_as_float(hi ? r[0] : r[1]); }
#define ATT_MFMA(a, b, c) __builtin_amdgcn_mfma_f32_32x32x16_bf16(a, b, c, 0, 0, 0)

template <int MODE>
__device__ __forceinline__ void att_compute(const LAS unsigned char* bb, int kt, int qw0, int r32, int hi, const bf16x8 (&qf)[5], f32x16& o0, f32x16& o1, float& carry, float& mrun, float& lrun) {
        const int key0 = kt * 64;
        if (key0 <= qw0 + 31) {
            f32x16 p0, p1;
            p0 = f32x16{}; p1 = f32x16{};
            u32x2 vf[4][2][2];
            { const LAS unsigned char* kb = bb + BUF_K + (r32 * KP + 8 * hi) * 2; constexpr int ND = MODE == 1 ? 5 : 4; bf16x8 ka[ND], kc[ND];
#pragma unroll
              for (int d0 = 0; d0 < ND; ++d0) { ka[d0] = *(const LAS bf16x8*)(kb + d0 * 32); kc[d0] = *(const LAS bf16x8*)(kb + 32 * KP * 2 + d0 * 32); }
              __builtin_amdgcn_sched_barrier(0);
#pragma unroll
              for (int d0 = 0; d0 < ND; ++d0) { p0 = ATT_MFMA(ka[d0], qf[d0], p0); p1 = ATT_MFMA(kc[d0], qf[d0], p1); }
              const LAS unsigned char* vb = bb + BUF_V + ((4 * hi + ((r32 & 15) >> 2)) * VP + 16 * (r32 >> 4) + 4 * (r32 & 3)) * 2;
#pragma unroll
              for (int ks = 0; ks < 4; ++ks) { const int koff = (16 * ks) * VP * 2;
                  vf[ks][0][0] = vtr(vb + koff); vf[ks][0][1] = vtr(vb + koff + 8 * VP * 2);
                  vf[ks][1][0] = vtr(vb + koff + 64); vf[ks][1][1] = vtr(vb + koff + 8 * VP * 2 + 64); }
              __builtin_amdgcn_sched_barrier(0); }
            const int qrow = qw0 + r32; const bool diag = key0 + 63 >= qw0;
            if (MODE == 0) {
                f32x16 rm0, rm1;
#pragma unroll
                for (int r = 0; r < 16; ++r) {
                    { const float t = __builtin_amdgcn_exp2f(-p0[r]); const float be = __builtin_amdgcn_rcpf(1.0f + t); p0[r] = be; rm0[r] = 1.0f - be; }
                    { const float t = __builtin_amdgcn_exp2f(-p1[r]); const float be = __builtin_amdgcn_rcpf(1.0f + t); p1[r] = be; rm1[r] = 1.0f - be; }
                }
                if (diag) {
                    asm volatile("" ::: "memory"); const int lim = qrow - key0 - 4 * hi;
#pragma unroll
                    for (int r = 0; r < 16; ++r) { const int c0 = (r & 3) + 8 * (r >> 2);
                        if (c0 >= lim) { p0[r] = 0.f; rm0[r] = 1.0f; } if (c0 + 32 >= lim) { p1[r] = 0.f; rm1[r] = 1.0f; } } }
                float gp[8], pg[8];
#pragma unroll
                for (int g = 0; g < 4; ++g) { gp[g] = (rm0[4 * g] * rm0[4 * g + 1]) * (rm0[4 * g + 2] * rm0[4 * g + 3]); gp[4 + g] = (rm1[4 * g] * rm1[4 * g + 1]) * (rm1[4 * g + 2] * rm1[4 * g + 3]); }
#pragma unroll
                for (int g = 0; g < 8; ++g) pg[g] = other_half(gp[g], hi);
                float run = carry;
#pragma unroll
                for (int g = 7; g >= 0; --g) {
                    const float aft = hi ? run : run * pg[g];
                    run = run * (gp[g] * pg[g]);
                    if (g >= 4) { const int r = 4 * (g - 4); const float a3 = aft, a2 = a3 * rm1[r + 3], a1 = a2 * rm1[r + 2], a0 = a1 * rm1[r + 1];
                        p1[r] *= a0; p1[r + 1] *= a1; p1[r + 2] *= a2; p1[r + 3] *= a3; }
                    else { const int r = 4 * g; const float a3 = aft, a2 = a3 * rm0[r + 3], a1 = a2 * rm0[r + 2], a0 = a1 * rm0[r + 1];
                        p0[r] *= a0; p0[r + 1] *= a1; p0[r + 2] *= a2; p0[r + 3] *= a3; }
                }
                carry = run;
            } else {
                if (diag) {
                    asm volatile("" ::: "memory"); const int lim = qrow - key0 - 4 * hi;
#pragma unroll
                    for (int r = 0; r < 16; ++r) { const int c0 = (r & 3) + 8 * (r >> 2); if (c0 > lim) p0[r] = -1e30f; if (c0 + 32 > lim) p1[r] = -1e30f; } }
                float ls = 0.f;
#pragma unroll
                for (int r = 0; r < 16; ++r) { p0[r] = __builtin_amdgcn_exp2f(p0[r]); p1[r] = __builtin_amdgcn_exp2f(p1[r]); ls += p0[r] + p1[r]; }
                lrun += ls;
            }
#pragma unroll
            for (int ks = 0; ks < 4; ++ks) {
                const int rb = 8 * (ks & 1); u32x4 pw;
                if (ks < 2) { pw.x = cvtpk(p0[rb], p0[rb + 1]); pw.y = cvtpk(p0[rb + 2], p0[rb + 3]); pw.z = cvtpk(p0[rb + 4], p0[rb + 5]); pw.w = cvtpk(p0[rb + 6], p0[rb + 7]); }
                else        { pw.x = cvtpk(p1[rb], p1[rb + 1]); pw.y = cvtpk(p1[rb + 2], p1[rb + 3]); pw.z = cvtpk(p1[rb + 4], p1[rb + 5]); pw.w = cvtpk(p1[rb + 6], p1[rb + 7]); }
                const bf16x8 pf = __builtin_bit_cast(bf16x8, pw);
                const u32x4 a0 = {vf[ks][0][0].x, vf[ks][0][0].y, vf[ks][0][1].x, vf[ks][0][1].y}, a1 = {vf[ks][1][0].x, vf[ks][1][0].y, vf[ks][1][1].x, vf[ks][1][1].y};
                o0 = ATT_MFMA(__builtin_bit_cast(bf16x8, a0), pf, o0); o1 = ATT_MFMA(__builtin_bit_cast(bf16x8, a1), pf, o1);
            }
        }
}
template <int MODE>
__device__ __forceinline__ void unit64(const bf16* Q, const bf16* K, const bf16* V, bf16* O, const float* FC, const float* gq, const float* gk, int b, int h, int qb, LAS unsigned char* lds) {
    const int tid = threadIdx.x, lane = tid & 63, r32 = lane & 31, hi = lane >> 5; const int wid = __builtin_amdgcn_readfirstlane(tid >> 6);
    const size_t rowbase = (size_t)b * SEQ; const int q0 = qb * 256, qw0 = q0 + wid * 32;
    const int NT = 4 * qb + 4;
    const int skey = tid >> 3, sch = tid & 7;
    const bf16* kg = K + (rowbase + skey) * DH + h * HD + sch * 8; const bf16* vg = V + (rowbase + skey) * DH + h * HD + sch * 8;
    const float* fg = FC + (size_t)(b * NH + h) * SEQ;
    v4u kreg, vreg; float breg = 0.f; v4u kregB, vregB; float bregB = 0.f;
#define ATT_LOAD2(t, KR, VR, BR) do { KR = *(const v4u*)(kg + (size_t)(t) * 64 * DH); VR = *(const v4u*)(vg + (size_t)(t) * 64 * DH); if (MODE == 1 && tid < 64) BR = fg[(t) * 64 + tid]; } while (0)
    ATT_LOAD2(NT - 1, kreg, vreg, breg); ATT_LOAD2(NT - 2, kregB, vregB, bregB);
    float fq0 = 0.f; if (MODE == 1) fq0 = fg[qw0 + r32];
    bf16x8 qf[5]; float gmax = 0.f;
    { const bf16* qp = Q + (rowbase + qw0 + r32) * DH + h * HD + 8 * hi;
#pragma unroll
      for (int d0 = 0; d0 < 4; ++d0) { v4u w = *(const v4u*)(qp + 16 * d0);
          if (MODE == 1) { const float* g1 = gq + 16 * d0 + 8 * hi; const float* g2 = gk + 16 * d0 + 8 * hi;
#pragma unroll
              for (int j = 0; j < 8; ++j) gmax = fmaxf(gmax, __builtin_fabsf(g1[j] * g2[j]));
              w.x = cvtpk(bflo(w.x) * g1[0] * g2[0], bfhi(w.x) * g1[1] * g2[1]); w.y = cvtpk(bflo(w.y) * g1[2] * g2[2], bfhi(w.y) * g1[3] * g2[3]);
              w.z = cvtpk(bflo(w.z) * g1[4] * g2[4], bfhi(w.z) * g1[5] * g2[5]); w.w = cvtpk(bflo(w.w) * g1[6] * g2[6], bfhi(w.w) * g1[7] * g2[7]); }
          qf[d0] = __builtin_bit_cast(bf16x8, w); } }
    f32x16 o0 = {}, o1 = {};
    float carry = 1.0f, mrun = -1e30f, lrun = 0.f;
    if (MODE == 1) { gmax = fmaxf(gmax, other_half(gmax, hi));
        mrun = -fq0 * LOG2E + 64.0f * 1.02f * C2 * gmax + 0.5f;
        { const float c = -mrun; const unsigned ch = f2bf(c); const float r1 = c - bf2f((bf16)ch); const unsigned cm = f2bf(r1); const unsigned cl = f2bf(r1 - bf2f((bf16)cm));
          u32x4 w = {0x3F803F80u, 0x3F80u | (ch << 16), cm | (cl << 16), 0u}; if (hi) w = u32x4{0u, 0u, 0u, 0u}; qf[4] = __builtin_bit_cast(bf16x8, w); } }
    else qf[4] = qf[3];
    LAS unsigned* alive = (LAS unsigned*)(lds + 2 * BUF_BYTES);
#define ATT_LOAD(t) do { kreg = *(const v4u*)(kg + (size_t)(t) * 64 * DH); vreg = *(const v4u*)(vg + (size_t)(t) * 64 * DH); if (MODE == 1 && tid < 64) breg = -fg[(t) * 64 + tid] * LOG2E; } while (0)
#define ATT_WRITE(bufo) do { LAS unsigned char* bb_ = lds + (bufo); *(LAS v4u*)(bb_ + BUF_K + (skey * KP + sch * 8) * 2) = kreg; \
        LAS unsigned short* vt_ = (LAS unsigned short*)(bb_ + BUF_V) + (sch * 8) * VP + skey; \
        vt_[0 * VP] = (unsigned short)(vreg.x & 0xffffu); vt_[1 * VP] = (unsigned short)(vreg.x >> 16); vt_[2 * VP] = (unsigned short)(vreg.y & 0xffffu); vt_[3 * VP] = (unsigned short)(vreg.y >> 16); \
        vt_[4 * VP] = (unsigned short)(vreg.z & 0xffffu); vt_[5 * VP] = (unsigned short)(vreg.z >> 16); vt_[6 * VP] = (unsigned short)(vreg.w & 0xffffu); vt_[7 * VP] = (unsigned short)(vreg.w >> 16); \
        if (MODE == 1 && tid < 64) *(LAS float*)(bb_ + BUF_B + tid * 4) = breg; } while (0)
#define ATT_WRITE2(bufo, KR, VR, BR) do { LAS unsigned char* bb_ = lds + (bufo); *(LAS v4u*)(bb_ + BUF_K + (skey * KP + sch * 8) * 2) = KR; *(LAS v4u*)(bb_ + BUF_V + (skey * VP + sch * 8) * 2) = VR; \
        if (MODE == 1 && tid < 64) { const float nb_ = -BR * LOG2E; const unsigned bh_ = f2bf(nb_); const float q1_ = nb_ - bf2f((bf16)bh_); const unsigned bm_ = f2bf(q1_); const unsigned bl_ = f2bf(q1_ - bf2f((bf16)bm_)); \
            LAS v4u* kx_ = (LAS v4u*)(bb_ + BUF_K + (tid * KP + 64) * 2); kx_[0] = v4u{bh_ | (bm_ << 16), bl_ | 0x3F800000u, 0x3F803F80u, 0u}; kx_[1] = v4u{0u, 0u, 0u, 0u}; } } while (0)
    ATT_WRITE2(0, kreg, vreg, breg); __syncthreads();
    bool done = false;
#define ATT_STEP(IT, WK, WV, WB, LK, LV, LB) do { const int it = (IT); const int kt = NT - 1 - it, cur = (it & 1) * BUF_BYTES, nxt = BUF_BYTES - cur; \
        if (it + 2 < NT) ATT_LOAD2(kt - 2, LK, LV, LB); \
        att_compute<MODE>(lds + cur, kt, qw0, r32, hi, qf, o0, o1, carry, mrun, lrun); \
        if (it + 1 < NT) ATT_WRITE2(nxt, WK, WV, WB); \
        if (MODE == 0) { if (lane == 0) alive[(it & 1) * 8 + wid] = __any(carry != 0.0f) ? 1u : 0u; else (void)__any(carry != 0.0f); } \
        __syncthreads(); \
        if (MODE == 0) { const LAS unsigned* al = alive + (it & 1) * 8; if ((al[0] | al[1] | al[2] | al[3] | al[4] | al[5] | al[6] | al[7]) == 0u) done = true; } } while (0)
    for (int it2 = 0; it2 < NT && !done; it2 += 2) {
        ATT_STEP(it2, kregB, vregB, bregB, kreg, vreg, breg);
        if (done) break;
        ATT_STEP(it2 + 1, kreg, vreg, breg, kregB, vregB, bregB);
    }
#undef ATT_STEP
#undef ATT_LOAD2
#undef ATT_WRITE2
    float inv = 1.0f;
    if (MODE == 1) { const float lt = lrun + other_half(lrun, hi); inv = 1.0f / lt; }
    bf16* op = O + (rowbase + qw0 + r32) * DH + h * HD + 4 * hi;
#pragma unroll
    for (int g = 0; g < 4; ++g) { u32x2 w0, w1; w0.x = cvtpk(o0[4 * g] * inv, o0[4 * g + 1] * inv); w0.y = cvtpk(o0[4 * g + 2] * inv, o0[4 * g + 3] * inv);
        w1.x = cvtpk(o1[4 * g] * inv, o1[4 * g + 1] * inv); w1.y = cvtpk(o1[4 * g + 2] * inv, o1[4 * g + 3] * inv);
        *(u32x2*)(op + 8 * g) = w0; *(u32x2*)(op + 32 + 8 * g) = w1; }
#undef ATT_LOAD
#undef ATT_WRITE
}
__device__ __forceinline__ void unit_sb(const bf16* Q, const bf16* K, const bf16* V, bf16* O, int b, int h, int qb, LAS unsigned char* lds) {
    const int tid = threadIdx.x, lane = tid & 63, r32 = lane & 31, hi = lane >> 5; const int wid = __builtin_amdgcn_readfirstlane(tid >> 6);
    const size_t rowbase = (size_t)b * SEQ; const int q0 = qb * 256, qw0 = q0 + wid * 32, T0 = 4 * qb, pw = wid >> 1;
    const int skey = tid >> 3, sch = tid & 7;
    const bf16* kg = K + (rowbase + skey) * DH + h * HD + sch * 8; const bf16* vg = V + (rowbase + skey) * DH + h * HD + sch * 8;
#define SB_LD(t, KR, VR) do { KR = *(const v4u*)(kg + (size_t)(t) * 64 * DH); VR = *(const v4u*)(vg + (size_t)(t) * 64 * DH); } while (0)
#define SB_WR(t, KR, VR) do { int wo_ = ((t) % 5) * BUF_BYTES; asm volatile("" : "+s"(wo_)); LAS unsigned char* bb_ = lds + wo_; *(LAS v4u*)(bb_ + BUF_K + (skey * KP + sch * 8) * 2) = KR; *(LAS v4u*)(bb_ + BUF_V + (skey * VP + sch * 8) * 2) = VR; } while (0)
    v4u kA, vA, kB, vB;
    bf16x8 qf[5];
    { v4u k3, v3, k2, v2, k1, v1, k0, v0;
      SB_LD(T0 + 3, k3, v3); SB_LD(T0 + 2, k2, v2); SB_LD(T0 + 1, k1, v1); SB_LD(T0, k0, v0);
      if (T0 >= 1) SB_LD(T0 - 1, kA, vA); if (T0 >= 2) SB_LD(T0 - 2, kB, vB);
      { const bf16* qp = Q + (rowbase + qw0 + r32) * DH + h * HD + 8 * hi;
#pragma unroll
        for (int d0 = 0; d0 < 4; ++d0) { const v4u w = *(const v4u*)(qp + 16 * d0); qf[d0] = __builtin_bit_cast(bf16x8, w); } }
      qf[4] = qf[3];
      SB_WR(T0 + 3, k3, v3); SB_WR(T0 + 2, k2, v2); SB_WR(T0 + 1, k1, v1); SB_WR(T0, k0, v0); }
    f32x16 o0 = {}, o1 = {};
    float carry = 1.0f, mrun = 0.f, lrun = 0.f;
    LAS unsigned* alive = (LAS unsigned*)(lds + 5 * BUF_BYTES);
    __syncthreads();
    bool done = false; const int NS = T0 + 4;
#define SB_STEP(S_, KR, VR) do { const int s_ = (S_); const int kt = T0 + pw - s_; \
        if (kt >= 0) { int bo_ = (kt % 5) * BUF_BYTES; asm volatile("" : "+s"(bo_)); att_compute<0>(lds + bo_, kt, qw0, r32, hi, qf, o0, o1, carry, mrun, lrun); }     \
        if (T0 - s_ - 1 >= 0) SB_WR(T0 - s_ - 1, KR, VR);             \
        if (T0 - s_ - 3 >= 0) SB_LD(T0 - s_ - 3, KR, VR); \
        { const bool live = __any(carry != 0.0f) && kt >= 1; if (lane == 0) alive[(s_ & 1) * 8 + wid] = live ? 1u : 0u; } \
        __syncthreads(); \
        { const LAS unsigned* al = alive + (s_ & 1) * 8; if ((al[0] | al[1] | al[2] | al[3] | al[4] | al[5] | al[6] | al[7]) == 0u) done = true; } } while (0)
    for (int s2 = 0; s2 < NS && !done; s2 += 2) {
        SB_STEP(s2, kA, vA);
        if (done || s2 + 1 >= NS) break;
        SB_STEP(s2 + 1, kB, vB);
    }
#undef SB_STEP
#undef SB_LD
#undef SB_WR
    bf16* op = O + (rowbase + qw0 + r32) * DH + h * HD + 4 * hi;
#pragma unroll
    for (int g = 0; g < 4; ++g) { u32x2 w0, w1; w0.x = cvtpk(o0[4 * g], o0[4 * g + 1]); w0.y = cvtpk(o0[4 * g + 2], o0[4 * g + 3]);
        w1.x = cvtpk(o1[4 * g], o1[4 * g + 1]); w1.y = cvtpk(o1[4 * g + 2], o1[4 * g + 3]);
        *(u32x2*)(op + 8 * g) = w0; *(u32x2*)(op + 32 + 8 * g) = w1; }
}
constexpr int MKP = 136, MVP = 144;
constexpr int MBUF_K = 0, MBUF_V = 64 * MKP * 2, MBUF_BYTES = MBUF_V + 64 * MVP * 2;
__device__ __forceinline__ void unit_mem(bf16* MQ, const float* MKf, const bf16* MV, const float* g_mq, const float* g_mk, int b, int hm, int qb, LAS unsigned char* lds) {
    const int tid = threadIdx.x, lane = tid & 63, r32 = lane & 31, hi = lane >> 5; const int wid = __builtin_amdgcn_readfirstlane(tid >> 6);
    const size_t rowq = (size_t)b * SEQ + qb * 256 + wid * 32 + r32;
    const int skey = tid >> 3, sch = tid & 7;
    const float* kg = MKf + (size_t)(b * MEMLEN + skey) * DH + hm * MHD + sch * 16; const bf16* vg = MV + (size_t)(b * MEMLEN + skey) * DH + hm * MHD + sch * 16;
    f32x4 kr[4][4]; v4u vr[4][2];
#pragma unroll
    for (int t = 0; t < 4; ++t) { const f32x4* kp_ = (const f32x4*)(kg + (size_t)t * 64 * DH); kr[t][0] = kp_[0]; kr[t][1] = kp_[1]; kr[t][2] = kp_[2]; kr[t][3] = kp_[3];
        const v4u* vp_ = (const v4u*)(vg + (size_t)t * 64 * DH); vr[t][0] = vp_[0]; vr[t][1] = vp_[1]; }
    v4u qw[8];
    { const bf16* qp = MQ + rowq * DH + hm * MHD + 8 * hi;
#pragma unroll
      for (int d0 = 0; d0 < 8; ++d0) qw[d0] = *(const v4u*)(qp + 16 * d0); }
    float gg[16];
#pragma unroll
    for (int i = 0; i < 16; ++i) gg[i] = g_mk[sch * 16 + i] * g_mq[sch * 16 + i] * C2M;
    float gmx = 0.f;
#pragma unroll
    for (int i = 0; i < 16; ++i) gmx = fmaxf(gmx, __builtin_fabsf(gg[i]));
    gmx = fmaxf(gmx, __shfl_xor(gmx, 1)); gmx = fmaxf(gmx, __shfl_xor(gmx, 2)); gmx = fmaxf(gmx, __shfl_xor(gmx, 4));
    const float nref = -(128.0f * 1.02f * gmx + 0.5f);
#pragma unroll
    for (int t = 0; t < 4; ++t) { LAS unsigned char* bb_ = lds + t * MBUF_BYTES; float ss_ = 0.f;
#pragma unroll
        for (int i_ = 0; i_ < 4; ++i_) ss_ += (kr[t][i_][0] * kr[t][i_][0] + kr[t][i_][1] * kr[t][i_][1]) + (kr[t][i_][2] * kr[t][i_][2] + kr[t][i_][3] * kr[t][i_][3]);
        ss_ += __shfl_xor(ss_, 1); ss_ += __shfl_xor(ss_, 2); ss_ += __shfl_xor(ss_, 4);
        const float rk_ = __builtin_amdgcn_rsqf(ss_ * (1.0f / MHD) + EPS); v4u k0_, k1_;
        k0_.x = cvtpk(kr[t][0][0] * rk_ * gg[0], kr[t][0][1] * rk_ * gg[1]); k0_.y = cvtpk(kr[t][0][2] * rk_ * gg[2], kr[t][0][3] * rk_ * gg[3]); k0_.z = cvtpk(kr[t][1][0] * rk_ * gg[4], kr[t][1][1] * rk_ * gg[5]); k0_.w = cvtpk(kr[t][1][2] * rk_ * gg[6], kr[t][1][3] * rk_ * gg[7]);
        k1_.x = cvtpk(kr[t][2][0] * rk_ * gg[8], kr[t][2][1] * rk_ * gg[9]); k1_.y = cvtpk(kr[t][2][2] * rk_ * gg[10], kr[t][2][3] * rk_ * gg[11]); k1_.z = cvtpk(kr[t][3][0] * rk_ * gg[12], kr[t][3][1] * rk_ * gg[13]); k1_.w = cvtpk(kr[t][3][2] * rk_ * gg[14], kr[t][3][3] * rk_ * gg[15]);
        LAS v4u* kd_ = (LAS v4u*)(bb_ + MBUF_K + (skey * MKP + sch * 16) * 2); kd_[0] = k0_; kd_[1] = k1_;
        LAS v4u* vd_ = (LAS v4u*)(bb_ + MBUF_V + (skey * MVP + sch * 16) * 2); vd_[0] = vr[t][0]; vd_[1] = vr[t][1]; }
    bf16x8 qf[8];
    { float ss = 0.f;
#pragma unroll
      for (int d0 = 0; d0 < 8; ++d0) { const float a0 = bflo(qw[d0].x), a1 = bfhi(qw[d0].x), a2 = bflo(qw[d0].y), a3 = bfhi(qw[d0].y), a4 = bflo(qw[d0].z), a5 = bfhi(qw[d0].z), a6 = bflo(qw[d0].w), a7 = bfhi(qw[d0].w);
          ss += (a0 * a0 + a1 * a1) + (a2 * a2 + a3 * a3) + (a4 * a4 + a5 * a5) + (a6 * a6 + a7 * a7); }
      ss += other_half(ss, hi);
      const float rq = __builtin_amdgcn_rsqf(ss * (1.0f / MHD) + EPS);
#pragma unroll
      for (int d0 = 0; d0 < 8; ++d0) { v4u o; o.x = cvtpk(bflo(qw[d0].x) * rq, bfhi(qw[d0].x) * rq); o.y = cvtpk(bflo(qw[d0].y) * rq, bfhi(qw[d0].y) * rq);
          o.z = cvtpk(bflo(qw[d0].z) * rq, bfhi(qw[d0].z) * rq); o.w = cvtpk(bflo(qw[d0].w) * rq, bfhi(qw[d0].w) * rq); qf[d0] = __builtin_bit_cast(bf16x8, o); } }
    f32x16 o0 = {}, o1 = {}, o2 = {}, o3 = {};
    float lrun = 0.f;
    __syncthreads();
#pragma unroll 1
    for (int kt = 0; kt < 4; ++kt) {
        const LAS unsigned char* bb = lds + kt * MBUF_BYTES;
        f32x16 p0, p1;
#pragma unroll
        for (int r = 0; r < 16; ++r) { p0[r] = nref; p1[r] = nref; }
        { const LAS unsigned char* kb = bb + MBUF_K + (r32 * MKP + 8 * hi) * 2;
#pragma unroll
          for (int d0 = 0; d0 < 8; ++d0) { const bf16x8 a0 = *(const LAS bf16x8*)(kb + d0 * 32), a1 = *(const LAS bf16x8*)(kb + 32 * MKP * 2 + d0 * 32);
              p0 = ATT_MFMA(a0, qf[d0], p0); p1 = ATT_MFMA(a1, qf[d0], p1); } }
        float ls = 0.f;
#pragma unroll
        for (int r = 0; r < 16; ++r) { p0[r] = __builtin_amdgcn_exp2f(p0[r]); p1[r] = __builtin_amdgcn_exp2f(p1[r]); ls += p0[r] + p1[r]; }
        lrun += ls;
        const LAS unsigned char* vb = bb + MBUF_V + ((4 * hi + ((r32 & 15) >> 2)) * MVP + 16 * (r32 >> 4) + 4 * (r32 & 3)) * 2;
#pragma unroll
        for (int ks = 0; ks < 4; ++ks) {
            const int rb = 8 * (ks & 1); u32x4 pw;
            if (ks < 2) { pw.x = cvtpk(p0[rb], p0[rb + 1]); pw.y = cvtpk(p0[rb + 2], p0[rb + 3]); pw.z = cvtpk(p0[rb + 4], p0[rb + 5]); pw.w = cvtpk(p0[rb + 6], p0[rb + 7]); }
            else        { pw.x = cvtpk(p1[rb], p1[rb + 1]); pw.y = cvtpk(p1[rb + 2], p1[rb + 3]); pw.z = cvtpk(p1[rb + 4], p1[rb + 5]); pw.w = cvtpk(p1[rb + 6], p1[rb + 7]); }
            const bf16x8 pf = __builtin_bit_cast(bf16x8, pw);
            const int koff = (16 * ks) * MVP * 2;
#define MATT_PV(ob, db) do { const u32x2 l_ = vtr(vb + koff + 64 * (db)), h_ = vtr(vb + koff + 8 * MVP * 2 + 64 * (db)); \
                const u32x4 a_ = {l_.x, l_.y, h_.x, h_.y}; ob = ATT_MFMA(__builtin_bit_cast(bf16x8, a_), pf, ob); } while (0)
            MATT_PV(o0, 0); MATT_PV(o1, 1); MATT_PV(o2, 2); MATT_PV(o3, 3);
#undef MATT_PV
        }
    }
    const float inv = 1.0f / (lrun + other_half(lrun, hi));
    bf16* op = MQ + rowq * DH + hm * MHD + 4 * hi;
#pragma unroll
    for (int g = 0; g < 4; ++g) {
#define MATT_ST(ob, db) do { u32x2 w_; w_.x = cvtpk(ob[4 * g] * inv, ob[4 * g + 1] * inv); w_.y = cvtpk(ob[4 * g + 2] * inv, ob[4 * g + 3] * inv); *(u32x2*)(op + 32 * (db) + 8 * g) = w_; } while (0)
        MATT_ST(o0, 0); MATT_ST(o1, 1); MATT_ST(o2, 2); MATT_ST(o3, 3);
#undef MATT_ST
    }
}
}

constexpr int N_PHASES = 9;
#ifndef OPT_P1
#define OPT_P1 1
#endif
#ifndef OPT_P3
#define OPT_P3 1
#endif
#ifndef OPT_ATT
#define OPT_ATT 1
#endif
#ifndef OPT_P4
#define OPT_P4 1
#endif
#ifndef OPT_P5
#define OPT_P5 1
#endif
#ifndef OPT_P6
#define OPT_P6 1
#endif
#ifndef DE_P1
#define DE_P1 true
#endif
#ifndef DE_P5
#define DE_P5 true
#endif
#ifndef STAGGER_P1
#define STAGGER_P1 0
#endif
#ifndef MK_N_LAUNCHES
#define MK_N_LAUNCHES 1
#endif
constexpr int N_LAUNCHES = MK_N_LAUNCHES;
struct Args { const float* in[18]; float* out; unsigned char* ws; int ph_lo, ph_hi, li, pad; };

__global__ void __launch_bounds__(NTHREADS, 2) skel_fwd(Args args) {
    extern __shared__ __attribute__((aligned(16))) unsigned char lds[];
    Frame F;
    F.lds = (LAS unsigned char*)lds;
    F.MISC = (volatile LAS unsigned*)(F.lds + MISC_OFF);
    F.tid = threadIdx.x; F.lane = F.tid & 63; F.wave = __builtin_amdgcn_readfirstlane(F.tid >> 6);
    F.G = gridDim.x; { const int bx = blockIdx.x; F.vcu = (F.G % 8 == 0) ? (bx % 8) * (F.G / 8) + bx / 8 : bx; }
    unsigned char* ws = args.ws;
    F.ctl = (gu32*)(ws + WS_CTL);
    F.x = args.in[0]; F.mem = args.in[1]; F.g_mix = args.in[2]; F.g_memn = args.in[3]; F.w_in = args.in[4]; F.b_forget = args.in[5]; F.g_fq = args.in[6]; F.g_fk = args.in[7];
    F.g_mq = args.in[8]; F.g_mk = args.in[9]; F.w_mkv = args.in[10]; F.w_bsb = args.in[11]; F.w_bfx = args.in[12]; F.w_bmm = args.in[13]; F.w_out = args.in[14]; F.g_mlp = args.in[15];
    F.w_up = args.in[16]; F.w_dn = args.in[17]; F.out = args.out;
    F.logf = (float*)(ws + WS_LOGF); F.FC = (float*)(ws + WS_FC); F.ssq = (float*)(ws + WS_SSQ); F.MKf = (float*)(ws + WS_MKF);
    F.Win_t = (bf16*)(ws + WS_WIN); F.Wmkv_t = (bf16*)(ws + WS_WMKV); F.Wbr_t = (bf16*)(ws + WS_WBR); F.Wout_t = (bf16*)(ws + WS_WOUT); F.Wup_t = (bf16*)(ws + WS_WUP); F.Wdn_t = (bf16*)(ws + WS_WDN);
    F.MHb = (bf16*)(ws + WS_MH); F.MV = (bf16*)(ws + WS_MV); F.XN = (bf16*)(ws + WS_XN);
    F.SBQ = (bf16*)(ws + WS_SBQ); F.SBK = (bf16*)(ws + WS_SBK); F.SBV = (bf16*)(ws + WS_SBV); F.FXQ = (bf16*)(ws + WS_FXQ); F.FXK = (bf16*)(ws + WS_FXK); F.FXV = (bf16*)(ws + WS_FXV); F.MQ = (bf16*)(ws + WS_MQ);
    F.G0 = (bf16*)args.out; F.G1 = (bf16*)args.out + (size_t)M * D; F.G2 = (bf16*)(ws + WS_G2); F.MRG = (bf16*)(ws + WS_MRG); F.U = (bf16*)(ws + WS_U);
    for (int u = F.tid; u < (LDS_BYTES - LDSCTL_OFF) / 4; u += NTHREADS) ((LAS unsigned*)(F.lds + LDSCTL_OFF))[u] = 0u;
    __syncthreads();
    XcdBarrier bar; bar.bar = (unsigned*)(F.ctl + CW_BAR); bar.x = 0; bar.st = nullptr;
    if (N_LAUNCHES == 1) bar = xcd_barrier_post((unsigned*)(F.ctl + CW_BAR), F.MISC + 8);
#define GRID_BAR() do { if (N_LAUNCHES == 1) xcd_barrier(bar); } while (0)
    const int lo = args.ph_lo, hi = args.ph_hi;
#define IN(k) (lo <= (k) && (k) < hi)
#define BOTH(k) (IN(k) && IN((k) + 1))
    const int wg = (int)blockIdx.x, nwg = F.G;
    unsigned long long ts_prev = 0ull, ts0 = 0ull; float probe = 0.f;
    if (TIMING_PHASE >= 0 && blockIdx.x == 0 && F.tid == 0) { ts0 = __builtin_amdgcn_s_memrealtime(); ts_prev = ts0; }
#define STAMP(k) do { if (TIMING_PHASE >= 0 && blockIdx.x == 0 && F.tid == 0) { const unsigned long long t_ = __builtin_amdgcn_s_memrealtime(); \
        if (TIMING_PHASE == (k)) probe = (float)(t_ - ts_prev) * 1e-5f; if (TIMING_PHASE == 8 && (k) == 7) probe = (float)(t_ - ts0) * 0.25e-5f; ts_prev = t_; } } while (0)

    if (IN(0)) { p0_prologue(F); if (BOTH(0)) GRID_BAR(); STAMP(0); }
    if (IN(1)) {
        fcumsum(F); VM_WAIT();
#if STAGGER_P1
        { if (F.tid == 0) { const unsigned long long t0 = __builtin_amdgcn_s_memrealtime(), dl = (unsigned long long)(((int)blockIdx.x >> 3) & 3) * STAGGER_P1; while (__builtin_amdgcn_s_memrealtime() - t0 < dl) __builtin_amdgcn_s_sleep(8); }
          __syncthreads(); }
#endif
#if OPT_P1
        { pg8::EpiProj E{F.SBQ, F.G0, F.G2, F.MKf, F.MV};
          pg8::SchedP1 S{F.G, (int)blockIdx.x, (const char*)F.XN, (const char*)F.Win_t};
          pg8::gemm_phase<pg8::EpiProj, pg8::SchedP1, false, true, 1, DE_P1>(F.lds, D, S, E);
          if (F.G == 256) { unsigned* qctr = (unsigned*)(F.ctl + CW_LWQ); volatile LAS unsigned* slot = F.MISC + 24;
              VM_WAIT(); __syncthreads();
              unsigned nx = 0; if (F.tid == 0) nx = __hip_atomic_fetch_add(qctr, 1u, __ATOMIC_RELAXED, __HIP_MEMORY_SCOPE_AGENT);
              for (;;) {
                  if (F.tid == 0) *slot = nx;
                  __syncthreads();
                  const unsigned idx = *slot;
                  if (idx * NWAVES >= (unsigned)LATE_ITEMS) break;
                  if (F.tid == 0) nx = __hip_atomic_fetch_add(qctr, 1u, __ATOMIC_RELAXED, __HIP_MEMORY_SCOPE_AGENT);
                  convert_late_weights(F, F.wave, LATE_ITEMS, (int)idx * NWAVES, (int)idx * NWAVES + NWAVES);
                  __syncthreads(); } } }
#else
        { EpiProjN E{F.SBQ, F.G0, F.G2}; ngemm(F.XN, D, F.Win_t, D, M, NPROJ, D, E, wg, nwg); }
        { EpiMkvN E{F.MKf, F.MV}; ngemm(F.MHb, D, F.Wmkv_t, D, MROWS, 1024, D, E, wg, nwg); }
#endif
        if (BOTH(1)) GRID_BAR();
        STAMP(1);
    }
    if (IN(2)) {
#if !OPT_P1
        headnorm_naive(F);
#endif
        if (BOTH(2)) { if (!OPT_P1) GRID_BAR(); } STAMP(2); }
    if (IN(3)) {
#if OPT_ATT
        for (int v = F.vcu; v < 256; v += F.G) { const int bh = v >> 2, s4 = v & 3;
            att::unit_sb(F.SBQ, F.SBK, F.SBV, F.SBQ, bh >> 3, bh & 7, 7 - s4, F.lds); __syncthreads();
            att::unit_sb(F.SBQ, F.SBK, F.SBV, F.SBQ, bh >> 3, bh & 7, s4, F.lds); __syncthreads();
            att::unit64<1>(F.FXQ, F.FXK, F.FXV, F.FXQ, F.FC, F.g_fq, F.g_fk, bh >> 3, bh & 7, 7 - s4, F.lds); __syncthreads();
            att::unit64<1>(F.FXQ, F.FXK, F.FXV, F.FXQ, F.FC, F.g_fq, F.g_fk, bh >> 3, bh & 7, s4, F.lds); __syncthreads(); }
#else
        nattn64<0>(F.SBQ, F.SBK, F.SBV, F.SBQ, F.FC, F.g_fq, F.g_fk, wg, nwg);
        nattn64<1>(F.FXQ, F.FXK, F.FXV, F.FXQ, F.FC, F.g_fq, F.g_fk, wg, nwg);
#endif
#if OPT_ATT
        for (int v = F.vcu; v < 256; v += F.G) { att::unit_mem(F.MQ, F.MKf, F.MV, F.g_mq, F.g_mk, v >> 5, (v >> 3) & 3, v & 7, F.lds); __syncthreads(); }
#else
        nattn_mem(F, wg, nwg);
#endif
        if (BOTH(3)) GRID_BAR();
        STAMP(3);
    }
    if (IN(4)) {
#if OPT_P3
        { pg8::SchedP3m S{F.G, (int)blockIdx.x, (const char*)F.SBQ, (const char*)F.Wbr_t};
          pg8::EpiMergedR E{F.G0, F.G2, F.MRG};
          pg8::gemm_phase<pg8::EpiMergedR, pg8::SchedP3m, true, true, 3>(F.lds, DH, S, E); }
#else
        nmerged(F, wg, nwg);
#endif
        if (BOTH(4)) GRID_BAR(); STAMP(4); }
    if (IN(5)) {
#if OPT_P4
        { pg8::SchedPlain S{64, 4, F.G, (int)blockIdx.x, (const char*)F.MRG, (const char*)F.Wout_t, (size_t)256 * D * 2};
          pg8::EpiOut E{F.x, F.out, F.XN, F.ssq};
          pg8::gemm_phase<pg8::EpiOut, pg8::SchedPlain, false, true, 4>(F.lds, D, S, E); }
#else
        { EpiOutN E{F.x, F.out, F.XN}; ngemm(F.MRG, D, F.Wout_t, D, M, D, D, E, wg, nwg); }
#endif
        if (BOTH(5)) GRID_BAR(); STAMP(5); }
    if (IN(6)) {
#if !OPT_P4
        ssq_naive(F);
        if (BOTH(6)) GRID_BAR();
#endif
    }
    if (IN(7)) {
#if OPT_P5
        {
          pg8::SchedPlain S{64, 16, F.G, (int)blockIdx.x, (const char*)F.XN, (const char*)F.Wup_t, (size_t)256 * D * 2};
          pg8::EpiUp E{F.U};
          pg8::gemm_phase<pg8::EpiUp, pg8::SchedPlain, true, true, 5, false>(F.lds, D, S, E); }
#else
        { EpiUpN E{F.ssq, F.U}; ngemm(F.XN, D, F.Wup_t, D, M, FF, D, E, wg, nwg); }
#endif
        if (BOTH(7)) GRID_BAR(); STAMP(7); }
    if (GPROBE != 0) { __syncthreads(); if (blockIdx.x == 0) probe = *(LAS float*)(F.lds + MISC_OFF + 64); }
    if (IN(8)) {
#if OPT_P6
        { pg8::SchedPlain S{64, 4, F.G, (int)blockIdx.x, (const char*)F.U, (const char*)F.Wdn_t, (size_t)256 * FF * 2};
          pg8::EpiDown E{F.out, F.ssq, probe, F.XN};
          pg8::gemm_phase<pg8::EpiDown, pg8::SchedPlain, false, true>(F.lds, FF, S, E); }
#else
        { EpiDnN E{F.out, F.ssq, F.XN}; ngemm(F.U, FF, F.Wdn_t, FF, M, D, FF, E, wg, nwg); }
#endif
    }
#undef IN
#undef BOTH
}

extern "C" void kernel_launch(void* const* d_in, const int* in_sizes, int n_in, void* d_out, int out_size, void* d_ws, size_t ws_size, hipStream_t stream) {
    static int grid = 0;
    if (grid == 0) {
        if (n_in != 18 || in_sizes[0] != M * D || out_size != M * D || ws_size < WS_END) { fprintf(stderr, "kernel_launch: unexpected shapes (n_in %d, in0 %d, out %d, ws %zu); nothing launched\n", n_in, n_in > 0 ? in_sizes[0] : -1, out_size, ws_size); grid = -1; return; }
        int dev = 0, cus = 0, per_cu = 0;
        if (hipGetDevice(&dev) != hipSuccess || hipDeviceGetAttribute(&cus, hipDeviceAttributeMultiprocessorCount, dev) != hipSuccess) { grid = -1; return; }
        if (hipFuncSetAttribute((const void*)skel_fwd, hipFuncAttributeMaxDynamicSharedMemorySize, LDS_BYTES) != hipSuccess) { fprintf(stderr, "kernel_launch: hipFuncSetAttribute failed\n"); grid = -1; return; }
        if (hipOccupancyMaxActiveBlocksPerMultiprocessor(&per_cu, (const void*)skel_fwd, NTHREADS, LDS_BYTES) != hipSuccess || per_cu < 1) fprintf(stderr, "kernel_launch: occupancy query reports %d\n", per_cu);
        (void)hipGetLastError();
        grid = cus;
    }
    if (grid < 0) return;
    if (hipMemsetAsync((char*)d_ws + WS_CTL, 0, CTL_ZERO_BYTES, stream) != hipSuccess) return;
    Args a{};
    for (int i = 0; i < 18; ++i) a.in[i] = (const float*)d_in[i];
    a.out = (float*)d_out; a.ws = (unsigned char*)d_ws;
    for (int li = 0; li < N_LAUNCHES; ++li) {
        a.ph_lo = (N_LAUNCHES == 1) ? 0 : li; a.ph_hi = (N_LAUNCHES == 1) ? N_PHASES : li + 1; a.li = li;
        hipLaunchKernelGGL(skel_fwd, dim3(grid), dim3(NTHREADS), LDS_BYTES, stream, a);
        if (hipPeekAtLastError() != hipSuccess) break;
    }
}
```
